# Optimizing an MI355X kernel written in HIP

```python
import jax, jax.numpy as jnp
from jax import lax
import numpy as np

D_MODEL = 1024
BATCH = 2
SEQ = 16384
DEPTH = 1

N_MEM = 256
EPS = 1e-6
QBLK = 128
MLA_HEADS = 4
MLA_NOPE = 128
MLA_ROPE = 64
MLA_V = 128
MLA_Q_RANK = 256
MLA_KV_RANK = 128
ROPE_THETA = 10000.0
SWA_HEADS = 8
SWA_KV_HEADS = 2
SWA_HD = 64
WINDOW = 128
X_HEADS = 4
X_HD = 128
PEER_HEADS = 8
N_KEYS = 128
N_EXPERTS = N_KEYS * N_KEYS
PEER_QDIM = 256
PEER_HALF = PEER_QDIM // 2
PEER_TOPK = 16
PEER_CHUNK = 128

MLA_WIDTH = MLA_HEADS * MLA_V
SWA_WIDTH = SWA_HEADS * SWA_HD
MIX_WIDTH = MLA_WIDTH + SWA_WIDTH
SWA_KV_WIDTH = SWA_KV_HEADS * SWA_HD
IN_COLS = MLA_Q_RANK + MLA_KV_RANK + MLA_ROPE + SWA_WIDTH + 2 * SWA_KV_WIDTH
SPLITS = (MLA_Q_RANK,
          MLA_Q_RANK + MLA_KV_RANK,
          MLA_Q_RANK + MLA_KV_RANK + MLA_ROPE,
          MLA_Q_RANK + MLA_KV_RANK + MLA_ROPE + SWA_WIDTH,
          MLA_Q_RANK + MLA_KV_RANK + MLA_ROPE + SWA_WIDTH + SWA_KV_WIDTH)

kernel_name = 'hymba_mla_swa_peer_block'


def rmsnorm(x, g):
    xf = x.astype(jnp.float32)
    y = xf * lax.rsqrt(jnp.mean(xf * xf, axis=-1, keepdims=True) + EPS)
    return (y * g.astype(jnp.float32)).astype(x.dtype)


def rope(x, positions):
    half = x.shape[-1] // 2
    inv = ROPE_THETA ** (-jnp.arange(half, dtype=jnp.float32) / half)
    ang = positions.astype(jnp.float32)[..., None] * inv
    ang = ang.reshape(ang.shape[:2] + (1,) * (x.ndim - 3) + (half,))
    cos, sin = jnp.cos(ang), jnp.sin(ang)
    x1 = x[..., :half].astype(jnp.float32)
    x2 = x[..., half:].astype(jnp.float32)
    out = jnp.concatenate([x1 * cos - x2 * sin, x2 * cos + x1 * sin], axis=-1)
    return out.astype(x.dtype)


def alibi_slopes(n_heads):
    return 2.0 ** (-(8.0 / n_heads) * jnp.arange(1, n_heads + 1, dtype=jnp.float32))


def mla_attention(c_q, c_kv, k_rope, positions, q_a_norm, w_q_b, kv_a_norm, w_kv_b):
    B, S, _ = c_q.shape
    q = (rmsnorm(c_q, q_a_norm) @ w_q_b).reshape(B, S, MLA_HEADS, MLA_NOPE + MLA_ROPE)
    q_nope, q_rope = q[..., :MLA_NOPE], rope(q[..., MLA_NOPE:], positions)
    c = rmsnorm(c_kv, kv_a_norm)
    k_r = rope(k_rope, positions)
    w = w_kv_b.reshape(MLA_KV_RANK, MLA_HEADS, MLA_NOPE + MLA_V)
    w_uk, w_uv = w[..., :MLA_NOPE], w[..., MLA_NOPE:]
    q_lat = jnp.einsum('bshd,rhd->bshr', q_nope, w_uk)
    q_cat = jnp.concatenate([q_lat, q_rope], axis=-1)
    k_cat = jnp.concatenate([c, k_r], axis=-1)
    scale = (MLA_NOPE + MLA_ROPE) ** -0.5
    nblk = S // QBLK
    qb = q_cat.reshape(B, nblk, QBLK, MLA_HEADS, -1).transpose(1, 0, 2, 3, 4)
    k_idx = jnp.arange(S)

    def block(args):
        i, q_i = args
        s = jnp.einsum('bqhd,bkd->bhqk', q_i, k_cat).astype(jnp.float32) * scale
        q_idx = i * QBLK + jnp.arange(QBLK)
        s = jnp.where(k_idx[None, :] <= q_idx[:, None], s, -jnp.inf)
        p = jax.nn.softmax(s, axis=-1).astype(c.dtype)
        return jnp.einsum('bhqk,bkr->bqhr', p, c)

    o_lat = lax.map(block, (jnp.arange(nblk), qb))
    o_lat = o_lat.transpose(1, 0, 2, 3, 4).reshape(B, S, MLA_HEADS, MLA_KV_RANK)
    return jnp.einsum('bshr,rhd->bshd', o_lat, w_uv).reshape(B, S, MLA_WIDTH)


def swa_attention(q, k, v, sinks):
    B, S, _ = q.shape
    nblk = S // QBLK
    G = SWA_HEADS // SWA_KV_HEADS
    q = q.reshape(B, nblk, QBLK, SWA_KV_HEADS, G, SWA_HD)
    k = k.reshape(B, S, SWA_KV_HEADS, SWA_HD)
    v = v.reshape(B, S, SWA_KV_HEADS, SWA_HD)
    pad = jnp.zeros((B, QBLK, SWA_KV_HEADS, SWA_HD), k.dtype)
    kp = jnp.concatenate([pad, k], axis=1).reshape(B, nblk + 1, QBLK, SWA_KV_HEADS, SWA_HD)
    vp = jnp.concatenate([pad, v], axis=1).reshape(B, nblk + 1, QBLK, SWA_KV_HEADS, SWA_HD)
    k_band = jnp.concatenate([kp[:, :-1], kp[:, 1:]], axis=2)
    v_band = jnp.concatenate([vp[:, :-1], vp[:, 1:]], axis=2)
    s = jnp.einsum('bnqkgd,bnjkd->bnkgqj', q, k_band).astype(jnp.float32) * (SWA_HD ** -0.5)
    a = jnp.arange(QBLK)[:, None]
    j = jnp.arange(2 * QBLK)[None, :]
    dist = a + QBLK - j
    key_abs = jnp.arange(nblk)[:, None] * QBLK - QBLK + jnp.arange(2 * QBLK)[None, :]
    valid = ((dist >= 0) & (dist < WINDOW))[None] & (key_abs >= 0)[:, None, :]
    slopes = alibi_slopes(SWA_HEADS).reshape(SWA_KV_HEADS, G)
    s = s - slopes[:, :, None, None] * dist.astype(jnp.float32)
    s = jnp.where(valid[None, :, None, None], s, -jnp.inf)
    sink = sinks.astype(jnp.float32).reshape(SWA_KV_HEADS, G)[:, :, None, None]
    m = jnp.maximum(jnp.max(s, axis=-1, keepdims=True), sink)
    e = jnp.exp(s - m)
    p = e / (jnp.sum(e, axis=-1, keepdims=True) + jnp.exp(sink - m))
    o = jnp.einsum('bnkgqj,bnjkd->bnqkgd', p.astype(v.dtype), v_band)
    return o.reshape(B, S, SWA_WIDTH)


def cross_attention(h, mem, norm_mem, w_cq, w_ck, w_cv, w_co):
    B, S, _ = h.shape
    mn = rmsnorm(mem, norm_mem)
    q = (h @ w_cq).reshape(B, S, X_HEADS, X_HD)
    k = (mn @ w_ck).reshape(B, -1, X_HEADS, X_HD)
    v = (mn @ w_cv).reshape(B, -1, X_HEADS, X_HD)
    s = jnp.einsum('bshd,bmhd->bhsm', q, k).astype(jnp.float32) * (X_HD ** -0.5)
    p = jax.nn.softmax(s, axis=-1).astype(v.dtype)
    o = jnp.einsum('bhsm,bmhd->bshd', p, v).reshape(B, S, X_HEADS * X_HD)
    return o @ w_co


def peer_ffn(h, w_q, keys, u, v):
    B, S, D = h.shape
    q = (h @ w_q).reshape(B, S, PEER_HEADS, 2, PEER_HALF)
    sc = jnp.einsum('bshcd,hcnd->bshcn', q, keys).astype(jnp.float32)
    top_s, top_i = lax.top_k(sc, PEER_TOPK)
    cand_s = (top_s[..., 0, :, None] + top_s[..., 1, None, :]).reshape(B, S, PEER_HEADS, PEER_TOPK * PEER_TOPK)
    cand_i = (top_i[..., 0, :, None] * N_KEYS + top_i[..., 1, None, :]).reshape(B, S, PEER_HEADS, PEER_TOPK * PEER_TOPK)
    best_s, best_pos = lax.top_k(cand_s, PEER_TOPK)
    idx = jnp.take_along_axis(cand_i, best_pos, axis=-1)
    g = jax.nn.softmax(best_s, axis=-1).astype(h.dtype)
    nch = S // PEER_CHUNK
    h_c = h.reshape(B, nch, PEER_CHUNK, D).swapaxes(0, 1)
    idx_c = idx.reshape(B, nch, PEER_CHUNK, PEER_HEADS, PEER_TOPK).swapaxes(0, 1)
    g_c = g.reshape(B, nch, PEER_CHUNK, PEER_HEADS, PEER_TOPK).swapaxes(0, 1)

    def chunk(args):
        hc, ic, gc = args
        act = jax.nn.gelu(jnp.einsum('bcd,bchkd->bchk', hc, u[ic]), approximate=False)
        return jnp.einsum('bchk,bchkd->bcd', gc * act, v[ic])

    y = lax.map(chunk, (h_c, idx_c, g_c))
    return y.swapaxes(0, 1).reshape(B, S, D)


def setup_inputs(seed: int = 0) -> dict:
    key = jax.random.key(seed)
    ks = jax.random.split(key, 26)
    L, D = DEPTH, D_MODEL

    def nrm(k, shape, scale):
        return jax.random.normal(k, shape, jnp.float32) * scale

    def gain(k, shape):
        return 1.0 + 0.05 * jax.random.normal(k, shape, jnp.float32)

    start = jax.random.randint(ks[2], (BATCH, 1), 0, 4096, dtype=jnp.int32)
    positions = start + jnp.arange(SEQ, dtype=jnp.int32)[None, :]
    return {
        'x': nrm(ks[0], (BATCH, SEQ, D), 1.0),
        'mem': nrm(ks[1], (BATCH, N_MEM, D), 1.0),
        'positions': positions,
        'norm_mix': gain(ks[3], (L, D)),
        'w_in': nrm(ks[4], (L, D, IN_COLS), D ** -0.5),
        'q_a_norm': gain(ks[5], (L, MLA_Q_RANK)),
        'w_q_b': nrm(ks[6], (L, MLA_Q_RANK, MLA_HEADS * (MLA_NOPE + MLA_ROPE)), MLA_Q_RANK ** -0.5),
        'kv_a_norm': gain(ks[7], (L, MLA_KV_RANK)),
        'w_kv_b': nrm(ks[8], (L, MLA_KV_RANK, MLA_HEADS * (MLA_NOPE + MLA_V)), MLA_KV_RANK ** -0.5),
        'swa_sinks': nrm(ks[9], (L, SWA_HEADS), 1.0),
        'out_norm_mla': gain(ks[10], (L, MLA_WIDTH)),
        'out_norm_swa': gain(ks[11], (L, SWA_WIDTH)),
        'w_out': nrm(ks[12], (L, MIX_WIDTH, D), MIX_WIDTH ** -0.5),
        'norm_cross': gain(ks[13], (L, D)),
        'norm_mem': gain(ks[14], (L, D)),
        'w_cq': nrm(ks[15], (L, D, X_HEADS * X_HD), D ** -0.5),
        'w_ck': nrm(ks[16], (L, D, X_HEADS * X_HD), D ** -0.5),
        'w_cv': nrm(ks[17], (L, D, X_HEADS * X_HD), D ** -0.5),
        'w_co': nrm(ks[18], (L, X_HEADS * X_HD, D), (X_HEADS * X_HD) ** -0.5),
        'norm_ffn': gain(ks[19], (L, D)),
        'peer_w_q': nrm(ks[20], (L, D, PEER_HEADS * PEER_QDIM), D ** -0.5),
        'peer_keys': nrm(ks[21], (L, PEER_HEADS, 2, N_KEYS, PEER_HALF), PEER_HALF ** -0.5),
        'peer_u': nrm(ks[22], (L, N_EXPERTS, D), D ** -0.5),
        'peer_v': nrm(ks[23], (L, N_EXPERTS, D), 0.5),
        'norm_final': gain(ks[24], (D,)),
    }


def reference(x, mem, positions, norm_mix, w_in, q_a_norm, w_q_b, kv_a_norm, w_kv_b,
              swa_sinks, out_norm_mla, out_norm_swa, w_out, norm_cross, norm_mem,
              w_cq, w_ck, w_cv, w_co, norm_ffn, peer_w_q, peer_keys, peer_u, peer_v,
              norm_final):
    for l in range(DEPTH):
        h = rmsnorm(x, norm_mix[l])
        c_q, c_kv, k_rope, q_s, k_s, v_s = jnp.split(h @ w_in[l], list(SPLITS), axis=-1)
        o_a = mla_attention(c_q, c_kv, k_rope, positions, q_a_norm[l], w_q_b[l], kv_a_norm[l], w_kv_b[l])
        o_b = swa_attention(q_s, k_s, v_s, swa_sinks[l])
        mix = jnp.concatenate([rmsnorm(o_a, out_norm_mla[l]), rmsnorm(o_b, out_norm_swa[l])], axis=-1)
        x = x + mix @ w_out[l]
        x = x + cross_attention(rmsnorm(x, norm_cross[l]), mem, norm_mem[l], w_cq[l], w_ck[l], w_cv[l], w_co[l])
        x = x + peer_ffn(rmsnorm(x, norm_ffn[l]), peer_w_q[l], peer_keys[l], peer_u[l], peer_v[l])
    return rmsnorm(x, norm_final)
```

```cpp
#include <hip/hip_runtime.h>
#include <hip/hip_cooperative_groups.h>
#include <cstdint>
#include <cstdio>
namespace cg = cooperative_groups;

#ifndef MK_SINGLE_LAUNCH
#define MK_SINGLE_LAUNCH 1
#endif

#ifndef DUP
#define DUP -1
#endif
#ifndef DBG
#define DBG 0
#endif
#define DBG_MIX ((DBG == 1) ? 0.0f : 1.0f)
#define DBG_XAT ((DBG == 1 || DBG == 2) ? 0.0f : 1.0f)
#define DBG_PEER ((DBG >= 1 && DBG <= 3) ? 0.0f : (DBG == 4 ? -0.5f : 1.0f))
#define DI __device__ __forceinline__
typedef unsigned short bf16_t;
typedef short bf16x8 __attribute__((ext_vector_type(8)));
typedef short s16x4 __attribute__((ext_vector_type(4)));
typedef float f32x16 __attribute__((ext_vector_type(16)));
typedef float f32x4 __attribute__((ext_vector_type(4)));
typedef float f32x2 __attribute__((ext_vector_type(2)));
typedef unsigned u32x4 __attribute__((ext_vector_type(4)));
typedef unsigned u32x2 __attribute__((ext_vector_type(2)));
typedef int i32x4 __attribute__((ext_vector_type(4)));
typedef __bf16 bf2_t __attribute__((ext_vector_type(2)));

constexpr int NB = 2, SEQ = 16384, DM = 1024, T = NB * SEQ;
constexpr int NTHREADS = 512;
constexpr float LOG2E = 1.4426950408889634f;
constexpr float EPS = 1e-6f;
constexpr int IN_COLS = 1216, IN_COLS_PAD = 1280;
constexpr float MLA_QSCALE = 0.07216878364870322f * LOG2E * 8.0f;
constexpr float SWA_QSCALE = 0.125f * LOG2E;
constexpr float X_QSCALE = 0.08838834764831845f * LOG2E;
constexpr float SM_THR = 8.0f;
constexpr float V_FP8_SCALE = 64.0f;

#define XB_TMO      128
#define XB_XCNT(j)  (256  + 64 * (j))
#define XB_XSUB(j)  (1280 + 64 * (j))
#define XB_XGEN(j)  (2304 + 64 * (j))
#define XB_TOP      3328
#define XB_TOPGEN   3392
#define XCD_BAR_WORDS 3456
#define XB_SPIN_CAP (1u << 22)
#define LAS __attribute__((address_space(3)))
DI unsigned xb_ld(unsigned* p)              { return __hip_atomic_load(p, __ATOMIC_RELAXED, __HIP_MEMORY_SCOPE_AGENT); }
DI unsigned xb_add(unsigned* p, unsigned v) { return __hip_atomic_fetch_add(p, v, __ATOMIC_RELAXED, __HIP_MEMORY_SCOPE_AGENT); }
DI unsigned xb_xcc_id() { return (unsigned)__builtin_amdgcn_s_getreg((3 << 11) | 20) & 0xFu; }
#define XB_SPIN(cond, bar) do { unsigned _sp = 0; while (cond) { __builtin_amdgcn_s_sleep(1); \
    if ((++_sp & 255u) == 0u) { if (xb_ld(&(bar)[XB_TMO])) break; if (_sp > XB_SPIN_CAP) { atomicAdd(&(bar)[XB_TMO], 1u); break; } } } } while (0)
struct XcdBarrier { unsigned* bar; unsigned x; volatile LAS unsigned* st; };
DI XcdBarrier xcd_barrier_post(unsigned* bar, volatile LAS unsigned* st) {
  XcdBarrier b; b.bar = bar; b.x = xb_xcc_id(); b.st = st;
  if (threadIdx.x == 0) (void)xb_add(&bar[XB_XCNT(b.x)], 1u);
  return b;
}
DI void xcd_barrier_complete(unsigned* bar, unsigned x, unsigned& nloc, unsigned& nx) {
  const unsigned G = gridDim.x * gridDim.y * gridDim.z;
  unsigned sum, cnt, mine, sp = 0u;
  for (;;) {
    sum = 0u; cnt = 0u; mine = 0u;
#pragma unroll
    for (unsigned j = 0; j < 16; ++j) { const unsigned c = xb_ld(&bar[XB_XCNT(j)]); sum += c; cnt += (c > 0u) ? 1u : 0u; mine = (j == x) ? c : mine; }
    if (sum == G) break;
    __builtin_amdgcn_s_sleep(1);
    if ((++sp & 255u) == 0u) { if (xb_ld(&bar[XB_TMO])) break; if (sp > XB_SPIN_CAP) { atomicAdd(&bar[XB_TMO], 1u); break; } }
  }
  nloc = mine > 0u ? mine : 1u; nx = cnt > 0u ? cnt : 1u;
}
DI void xcd_barrier(const XcdBarrier& b) {
  asm volatile("s_waitcnt vmcnt(0)" ::: "memory");
  __syncthreads();
  if (threadIdx.x == 0) {
    unsigned* bar = b.bar;
    __builtin_amdgcn_s_waitcnt(0);
    unsigned nloc = b.st[0], nx = b.st[1];
    if (nloc == 0u) { xcd_barrier_complete(bar, b.x, nloc, nx); b.st[0] = nloc; b.st[1] = nx; }
    const unsigned old = xb_add(&bar[XB_XSUB(b.x)], 1u);
    const unsigned gen = old / nloc;
    if (old + 1u == (gen + 1u) * nloc) {
      __builtin_amdgcn_fence(__ATOMIC_RELEASE, "agent");
      asm volatile("s_waitcnt vmcnt(0)" ::: "memory");
      const unsigned og = xb_add(&bar[XB_TOP], 1u);
      const unsigned tg = og / nx;
      if (og + 1u == (tg + 1u) * nx) xb_add(&bar[XB_TOPGEN], 1u);
      else XB_SPIN(xb_ld(&bar[XB_TOPGEN]) == tg, bar);
      __builtin_amdgcn_fence(__ATOMIC_ACQUIRE, "agent");
      xb_add(&bar[XB_XGEN(b.x)], 1u);
      asm volatile("s_waitcnt vmcnt(0)" ::: "memory");
    } else {
      XB_SPIN(xb_ld(&bar[XB_XGEN(b.x)]) == gen, bar);
      __builtin_amdgcn_fence(__ATOMIC_ACQUIRE, "agent");
      asm volatile("s_waitcnt vmcnt(0)" ::: "memory");
    }
  }
  __syncthreads();
}

struct Params {
  const float* x; const float* mem; const int* positions; const float* norm_mix; const float* w_in; const float* q_a_norm; const float* w_q_b;
  const float* kv_a_norm; const float* w_kv_b; const float* swa_sinks; const float* out_norm_mla; const float* out_norm_swa; const float* w_out;
  const float* norm_cross; const float* norm_mem; const float* w_cq; const float* w_ck; const float* w_cv; const float* w_co; const float* norm_ffn;
  const float* peer_w_q; const float* peer_keys; const float* peer_u; const float* peer_v; const float* norm_final;
  float* X;
  bf16_t* wt_in; bf16_t* wt_qc; bf16_t* wt_uv; bf16_t* wt_out; bf16_t* wt_cq; bf16_t* wt_ckv; bf16_t* wt_co; bf16_t* a_pq; bf16_t* keys_bf; bf16_t* wt_sc;
  unsigned char* u_q; unsigned char* v_q; unsigned char* k8; unsigned char* vt8; float* su; float* sv; unsigned* bar; bf16_t* mn; bf16_t* kvc; float* rope; bf16_t* xn; bf16_t* lat; bf16_t* cqn; bf16_t* qcat; bf16_t* kcat;
  bf16_t* qs; bf16_t* ks; bf16_t* vs; bf16_t* olat; bf16_t* ob; bf16_t* oa; bf16_t* qx; bf16_t* ox; int* top1; int* pidx; float* pg; unsigned char* hq; float* sh; int* dpartA; int* dpartB; float* cbuf; bf16_t* X16;
};

DI unsigned pk2(float lo, float hi) { f32x2 v = {lo, hi}; bf2_t b = __builtin_convertvector(v, bf2_t); return __builtin_bit_cast(unsigned, b); }
DI bf16_t f2bf(float x) { __bf16 b = (__bf16)x; return __builtin_bit_cast(bf16_t, b); }
DI float bf2f(bf16_t b) { return __uint_as_float(((unsigned)b) << 16); }
DI float bflo(unsigned w) { return __uint_as_float(w << 16); }
DI float bfhi(unsigned w) { return __uint_as_float(w & 0xffff0000u); }
DI float dot2bf(unsigned a, unsigned b, float c) { return __builtin_amdgcn_fdot2_f32_bf16(__builtin_bit_cast(bf2_t, a), __builtin_bit_cast(bf2_t, b), c, false); }
DI int crow(int r, int hi) { return (r & 3) + 8 * (r >> 2) + 4 * hi; }
DI float wave_sum(float v) {
#pragma unroll
  for (int o = 32; o >= 1; o >>= 1) v += __shfl_xor(v, o);
  return v;
}
#define MFMA32(a, b, c) __builtin_amdgcn_mfma_f32_32x32x16_bf16((a), (b), (c), 0, 0, 0)
#define SBAR() __builtin_amdgcn_sched_barrier(0)

constexpr int G_BM = 256, G_BN = 128, G_BK = 64;
constexpr int G_A_BYTES = G_BM * 128, G_B_BYTES = G_BN * 128, G_STAGE = G_A_BYTES + G_B_BYTES;
constexpr int G_NSTAGE = 3;
constexpr int SMEM_BYTES = 160768 + 256;
#define LDSP(p) ((__attribute__((address_space(3))) unsigned*)(p))

template <int V>
DI void gemm_mainloop(const bf16_t* __restrict__ A, int lda, const bf16_t* __restrict__ Bt, int ldb, int K, int row0, int col0, f32x16 (&acc)[4], char* smem) {
  const int tid = threadIdx.x, lane = tid & 63, wid = tid >> 6, r32 = lane & 31, hi = lane >> 5;
  const int srow = tid >> 3, spc = tid & 7, slc = spc ^ ((srow >> 1) & 7);
  const bf16_t* Ag = A + (size_t)(row0 + srow) * lda + slc * 8;
  const bf16_t* Bg = Bt + (size_t)(col0 + srow) * ldb + slc * 8;
  const size_t a64 = (size_t)64 * lda, b64 = (size_t)64 * ldb;
#pragma unroll
  for (int i = 0; i < 4; ++i) acc[i] = f32x16{};
  const int nk = K / G_BK;
  auto stage = [&](int kt, int slot) {
    char* sa = smem + slot * G_STAGE + tid * 16;
    const bf16_t* ag = Ag + kt * G_BK; const bf16_t* bg = Bg + kt * G_BK;
#pragma unroll
    for (int i = 0; i < 4; ++i) __builtin_amdgcn_global_load_lds((const unsigned*)(ag + i * a64), LDSP(sa + i * 8192), 16, 0, 0);
#pragma unroll
    for (int i = 0; i < 2; ++i) __builtin_amdgcn_global_load_lds((const unsigned*)(bg + i * b64), LDSP(sa + G_A_BYTES + i * 8192), 16, 0, 0);
  };
  stage(0, 0);
  if (nk > 1) stage(1, 1);
  const int x = (r32 >> 1) & 7;
  int so[4];
#pragma unroll
  for (int s = 0; s < 4; ++s) so[s] = ((2 * s + hi) ^ x) * 16;
  int aoff, boff;
  if (V == 0) { aoff = ((wid >> 1) * 64 + r32) * 128; boff = G_A_BYTES + ((wid & 1) * 64 + r32) * 128; }
  else        { aoff = ((wid >> 2) * 128 + r32) * 128; boff = G_A_BYTES + ((wid & 3) * 32 + r32) * 128; }
  int slot = 0;
  for (int kt = 0; kt < nk; ++kt) {
    if (kt + 1 < nk) asm volatile("s_waitcnt vmcnt(6) lgkmcnt(0)" ::: "memory"); else asm volatile("s_waitcnt vmcnt(0) lgkmcnt(0)" ::: "memory");
    __builtin_amdgcn_s_barrier();
    if (kt + 2 < nk) { int ns = slot + 2; if (ns >= G_NSTAGE) ns -= G_NSTAGE; stage(kt + 2, ns); }
    const char* cs = smem + slot * G_STAGE;
    if (V == 0) {
      bf16x8 af[4][2], bf[4][2];
#pragma unroll
      for (int s = 0; s < 4; ++s) {
        af[s][0] = *(const bf16x8*)(cs + aoff + so[s]); af[s][1] = *(const bf16x8*)(cs + aoff + 32 * 128 + so[s]);
        bf[s][0] = *(const bf16x8*)(cs + boff + so[s]); bf[s][1] = *(const bf16x8*)(cs + boff + 32 * 128 + so[s]);
      }
#pragma unroll
      for (int s = 0; s < 4; ++s) {
        acc[0] = MFMA32(af[s][0], bf[s][0], acc[0]); acc[1] = MFMA32(af[s][0], bf[s][1], acc[1]);
        acc[2] = MFMA32(af[s][1], bf[s][0], acc[2]); acc[3] = MFMA32(af[s][1], bf[s][1], acc[3]);
      }
    } else {
      bf16x8 af[4][4], bf[4];
#pragma unroll
      for (int s = 0; s < 4; ++s) {
        bf[s] = *(const bf16x8*)(cs + boff + so[s]);
#pragma unroll
        for (int mi = 0; mi < 4; ++mi) af[s][mi] = *(const bf16x8*)(cs + aoff + mi * 32 * 128 + so[s]);
      }
#pragma unroll
      for (int s = 0; s < 4; ++s)
#pragma unroll
        for (int mi = 0; mi < 4; ++mi) acc[mi] = MFMA32(af[s][mi], bf[s], acc[mi]);
    }
    slot = (slot + 1 == G_NSTAGE) ? 0 : slot + 1;
  }
  __syncthreads();
}

constexpr int EP_STR = 132;
template <class Epi>
DI void gemm_epi_rows(const f32x16 (&acc)[4], int row0, int col0, const Epi& epi, char* smem) {
  const int tid = threadIdx.x, lane = tid & 63, wid = tid >> 6, r32 = lane & 31, hi = lane >> 5;
  float* tile = (float*)smem;
  const int rb = (wid >> 1) * 64, cb = (wid & 1) * 64 + r32;
  const int rr = tid >> 5, c4 = (tid & 31) * 4;
  if constexpr (Epi::HAS_BASE) {
    f32x4 bs[16];
#pragma unroll
    for (int it = 0; it < 16; ++it) bs[it] = epi.load_base(row0 + it * 16 + rr, col0 + c4);
#pragma unroll
    for (int mi = 0; mi < 2; ++mi)
#pragma unroll
      for (int ni = 0; ni < 2; ++ni)
#pragma unroll
        for (int r = 0; r < 16; ++r) tile[(rb + mi * 32 + crow(r, hi)) * EP_STR + cb + ni * 32] = acc[mi * 2 + ni][r];
    __syncthreads();
#pragma unroll
    for (int it = 0; it < 16; ++it) {
      const int row = it * 16 + rr;
      const f32x4 v = *(const f32x4*)(tile + row * EP_STR + c4);
      epi.store(row0 + row, col0 + c4, v, bs[it]);
    }
  } else {
#pragma unroll
    for (int mi = 0; mi < 2; ++mi)
#pragma unroll
      for (int ni = 0; ni < 2; ++ni)
#pragma unroll
        for (int r = 0; r < 16; ++r) tile[(rb + mi * 32 + crow(r, hi)) * EP_STR + cb + ni * 32] = acc[mi * 2 + ni][r];
    __syncthreads();
#pragma unroll 4
    for (int it = 0; it < 16; ++it) {
      const int row = it * 16 + rr;
      const f32x4 v = *(const f32x4*)(tile + row * EP_STR + c4);
      epi(row0 + row, col0 + c4, v);
    }
  }
  __syncthreads();
}

template <class Epi>
DI void gemm_phase(const bf16_t* A, int lda, int a_kstride, const bf16_t* Bt, int ldb, int M, int N, int K, const Epi& epi, char* smem, int bid = -1, int nb = 0) {
  if (bid < 0) { bid = (int)blockIdx.x; nb = (int)gridDim.x; }
  const int ntn = N / G_BN, total = (M / G_BM) * ntn;
  for (int L = bid; L < total; L += nb) {
    const int wg = (L & 7) * (total >> 3) + (L >> 3);
    const int pm = wg / ntn, pn = wg - pm * ntn;
    f32x16 acc[4];
    gemm_mainloop<0>(A + (size_t)pn * a_kstride, lda, Bt, ldb, K, pm * G_BM, pn * G_BN, acc, smem);
    gemm_epi_rows(acc, pm * G_BM, pn * G_BN, epi, smem);
  }
}

DI u32x2 pk4(const f32x4& v, float s) { return u32x2{pk2(v[0] * s, v[1] * s), pk2(v[2] * s, v[3] * s)}; }
struct EpiInproj {
  static constexpr bool HAS_BASE = false;
  bf16_t* lat; bf16_t* qs; bf16_t* ks; bf16_t* vs;
  DI void operator()(int row, int col, const f32x4& v) const {
    if (col < 448) *(u32x2*)(lat + (size_t)row * 448 + col) = pk4(v, 1.0f);
    else if (col < 960) *(u32x2*)(qs + (size_t)row * 512 + (col - 448)) = pk4(v, SWA_QSCALE);
    else if (col < 1088) *(u32x2*)(ks + (size_t)row * 128 + (col - 960)) = pk4(v, 1.0f);
    else if (col < 1216) *(u32x2*)(vs + (size_t)row * 128 + (col - 1088)) = pk4(v, 1.0f);
  }
};
struct EpiBf16 { static constexpr bool HAS_BASE = false; bf16_t* out; int ld; float scale; DI void operator()(int row, int col, const f32x4& v) const { *(u32x2*)(out + (size_t)row * ld + col) = pk4(v, scale); } };
struct EpiBf16T { static constexpr bool HAS_BASE = false; bf16_t* out; int ld; DI void operator()(int row, int col, const f32x4& v) const {
#pragma unroll
  for (int j = 0; j < 4; ++j) out[(size_t)(col + j) * ld + row] = f2bf(v[j]); } };
struct EpiResid { static constexpr bool HAS_BASE = true; const float* base; float* out; int ld; float scale;
  DI f32x4 load_base(int row, int col) const { return *(const f32x4*)(base + (size_t)row * ld + col); }
  DI void store(int row, int col, const f32x4& v, const f32x4& b) const { *(f32x4*)(out + (size_t)row * ld + col) = b + v * scale; } };

namespace g8 {
#define PG8_LAS __attribute__((address_space(3)))
constexpr int BM = 256, BK = 64, HALF = 128, HTB = HALF * BK * 2, NXCD = 8, WGM = 8;
DI int lds_byte(int r, int c) { const int st = (r >> 4) * 2 + (c >> 5), rr = r & 15, cc = c & 31, ob = rr * 64 + cc * 2; return st * 1024 + (ob ^ (((ob >> 9) & 1) << 5)); }
DI void stage_rc(int b, int& R, int& C) { const int st = b / 1024, sb = b % 1024, swz = sb ^ (((sb >> 9) & 1) << 5); R = (st >> 1) * 16 + swz / 64; C = (st & 1) * 32 + (swz % 64) / 2; }
DI int perm32(int rho) { const int n = rho >> 4, i = rho & 15; return 8 * (i >> 2) + 4 * n + (i & 3); }
struct Unit { int pm, pn; };
struct Gemm { const bf16_t* A; const bf16_t* Bt; int M, N, K; };
struct StaticOrder {
  int nM, nN, nwg, G, c;
  DI void init(int M, int N, int G_, int c_) { nM = M / BM; nN = N / BM; nwg = nM * nN; G = G_; c = c_; }
  DI bool next(int i, Unit& u) const {
    const long L = (long)i * G + c; if (L >= nwg) return false;
    int wgid = (int)L; { const int q = nwg / NXCD, r = nwg % NXCD, xcd = wgid % NXCD, off = wgid / NXCD; wgid = (xcd < r ? xcd * (q + 1) : r * (q + 1) + (xcd - r) * q) + off; }
    const int nig = WGM * nN, gid = wgid / nig, fm = gid * WGM, gsz = (nM - fm) < WGM ? (nM - fm) : WGM;
    u.pm = fm + ((wgid % nig) % gsz); u.pn = (wgid % nig) / gsz; return true;
  }
};
template <class Epi>
DI void gemm_phase(PG8_LAS unsigned char* lds, const Gemm g, const StaticOrder& S, const Epi& E) {
  int tid = threadIdx.x; asm volatile("" : "+v"(tid));
  const int wid = __builtin_amdgcn_readfirstlane(tid >> 6), lane = tid & 63, wr = wid >> 2, wc = wid & 3, fr = lane & 15, fq = lane >> 4;
  const int K = g.K, nt = K / BK;
  unsigned voffA[2], voffB[2];
#pragma unroll
  for (int i = 0; i < 2; ++i) { int R, C; stage_rc(tid * 16 + i * 8192, R, C); const int Rb = Epi::PERM ? ((R & ~31) + perm32(R & 31)) : R;
    voffA[i] = (unsigned)(R * K + C) * 2u; voffB[i] = (unsigned)(Rb * K + C) * 2u; }
  const size_t kstep = (size_t)(BK * 2), hstep = (size_t)HALF * K * 2, tstep = 2 * hstep;
  const unsigned ldsw = (unsigned)wid * 1024u;
  const int aoff = lds_byte(wr * 64 + fr, fq * 8), boff = lds_byte(wc * 32 + fr, fq * 8);
#define PG8_SA(b, h) (((b) * 2 + (h)) * HTB)
#define PG8_SB(b, h) ((4 + (b) * 2 + (h)) * HTB)
#define PG8_STAGE(bufoff, gbase, voff) do { _Pragma("unroll") for (int _i = 0; _i < 2; ++_i) \
    __builtin_amdgcn_global_load_lds((const unsigned*)((const char*)(gbase) + (voff)[_i]), (PG8_LAS unsigned*)(lds + (bufoff) + ldsw + _i * 8192), 16, 0, 0); } while (0)
#define PG8_LDA(dst, b, h) do { _Pragma("unroll") for (int m = 0; m < 4; ++m) _Pragma("unroll") for (int k = 0; k < 2; ++k) dst[m][k] = *(const PG8_LAS bf16x8*)(lds + PG8_SA(b, h) + aoff + m * 2048 + k * 1024); } while (0)
#define PG8_LDB(dst, b, h) do { _Pragma("unroll") for (int n = 0; n < 2; ++n) _Pragma("unroll") for (int k = 0; k < 2; ++k) dst[n][k] = *(const PG8_LAS bf16x8*)(lds + PG8_SB(b, h) + boff + n * 2048 + k * 1024); } while (0)
#define PG8_MMA(ai, bj, At, Bt) do { __builtin_amdgcn_s_setprio(1); _Pragma("unroll") for (int m = 0; m < 4; ++m) _Pragma("unroll") for (int n = 0; n < 2; ++n) _Pragma("unroll") for (int k = 0; k < 2; ++k) \
    acc[ai][bj][m][n] = __builtin_amdgcn_mfma_f32_16x16x32_bf16(Bt[n][k], At[m][k], acc[ai][bj][m][n], 0, 0, 0); __builtin_amdgcn_s_setprio(0); } while (0)
#define PG8_WAIT_V(n) asm volatile("s_waitcnt vmcnt(" #n ")" ::: "memory")
#define PG8_WAIT_L(n) asm volatile("s_waitcnt lgkmcnt(" #n ")" ::: "memory")
#define PG8_BAR __builtin_amdgcn_s_barrier()
#define PG8_SCHED __builtin_amdgcn_sched_barrier(0)
  Unit cur, nxt; int ui = 0;
  if (!S.next(0, cur)) return;
  f32x4 acc[2][2][4][2];
#pragma unroll
  for (int a = 0; a < 2; ++a)
#pragma unroll
    for (int b = 0; b < 2; ++b)
#pragma unroll
      for (int m = 0; m < 4; ++m)
#pragma unroll
        for (int n = 0; n < 2; ++n) acc[a][b][m][n] = (f32x4){0.f, 0.f, 0.f, 0.f};
  bf16x8 At[4][2], B0[2][2], B1[2][2];
  const char* cA = (const char*)g.A + (size_t)cur.pm * tstep; const char* cB = (const char*)g.Bt + (size_t)cur.pn * tstep;
  PG8_STAGE(PG8_SB(0, 0), cB, voffB); PG8_STAGE(PG8_SA(0, 0), cA, voffA); PG8_STAGE(PG8_SB(0, 1), cB + hstep, voffB); PG8_STAGE(PG8_SA(0, 1), cA + hstep, voffA);
  if (wr == 1) PG8_BAR;
  PG8_WAIT_V(4); PG8_BAR;
  PG8_STAGE(PG8_SB(1, 0), cB + kstep, voffB); PG8_STAGE(PG8_SA(1, 0), cA + kstep, voffA); PG8_STAGE(PG8_SB(1, 1), cB + hstep + kstep, voffB);
  PG8_WAIT_V(6); PG8_BAR;
  for (;;) {
    const bool has_next = S.next(ui + 1, nxt);
    const char* nA = has_next ? (const char*)g.A + (size_t)nxt.pm * tstep : cA; const char* nB = has_next ? (const char*)g.Bt + (size_t)nxt.pn * tstep : cB;
    for (int t = 0; t < nt; t += 2) {
      const bool last = (t == nt - 2);
      const char* a1 = cA + (size_t)(t + 1) * kstep;
      const char* a2 = last ? nA : cA + (size_t)(t + 2) * kstep; const char* b2 = last ? nB : cB + (size_t)(t + 2) * kstep;
      const char* a3 = a2 + kstep; const char* b3 = b2 + kstep;
      PG8_LDB(B0, 0, 0); PG8_SCHED; PG8_LDA(At, 0, 0); PG8_STAGE(PG8_SA(1, 1), a1 + hstep, voffA);
      PG8_WAIT_L(8); PG8_BAR; PG8_WAIT_L(0); PG8_MMA(0, 0, At, B0); PG8_BAR; PG8_SCHED;
      PG8_LDB(B1, 0, 1); PG8_STAGE(PG8_SB(0, 0), b2, voffB);
      PG8_BAR; PG8_WAIT_L(0); PG8_MMA(0, 1, At, B1); PG8_BAR;
      PG8_LDA(At, 0, 1); PG8_STAGE(PG8_SA(0, 0), a2, voffA);
      PG8_BAR; PG8_WAIT_L(0); PG8_MMA(1, 0, At, B0); PG8_BAR; PG8_SCHED;
      PG8_STAGE(PG8_SB(0, 1), b2 + hstep, voffB);
      PG8_WAIT_V(6); PG8_BAR; PG8_MMA(1, 1, At, B1); PG8_BAR;
      PG8_LDB(B0, 1, 0); PG8_SCHED; PG8_LDA(At, 1, 0); PG8_STAGE(PG8_SA(0, 1), a2 + hstep, voffA);
      PG8_WAIT_L(8); PG8_BAR; PG8_WAIT_L(0); PG8_MMA(0, 0, At, B0); PG8_BAR; PG8_SCHED;
      PG8_LDB(B1, 1, 1); PG8_STAGE(PG8_SB(1, 0), b3, voffB);
      PG8_BAR; PG8_WAIT_L(0); PG8_MMA(0, 1, At, B1); PG8_BAR;
      PG8_LDA(At, 1, 1); PG8_STAGE(PG8_SA(1, 0), a3, voffA);
      PG8_BAR; PG8_WAIT_L(0); PG8_MMA(1, 0, At, B0); PG8_BAR; PG8_SCHED;
      PG8_STAGE(PG8_SB(1, 1), b3 + hstep, voffB);
      PG8_WAIT_V(6); PG8_BAR; PG8_MMA(1, 1, At, B1); PG8_BAR;
    }
    E(acc, cur, wr, wc, fr, fq);
    if (!has_next) break;
#pragma unroll
    for (int a = 0; a < 2; ++a)
#pragma unroll
      for (int b = 0; b < 2; ++b)
#pragma unroll
        for (int m = 0; m < 4; ++m)
#pragma unroll
          for (int n = 0; n < 2; ++n) acc[a][b][m][n] = (f32x4){0.f, 0.f, 0.f, 0.f};
    cur = nxt; cA = nA; cB = nB; ++ui;
  }
  PG8_WAIT_V(0);
  if (wr == 0) PG8_BAR;
  PG8_BAR;
#undef PG8_SA
#undef PG8_SB
#undef PG8_STAGE
#undef PG8_LDA
#undef PG8_LDB
#undef PG8_MMA
#undef PG8_WAIT_V
#undef PG8_WAIT_L
#undef PG8_BAR
#undef PG8_SCHED
}
DI u32x4 pk8(const f32x4& v0, const f32x4& v1, float s) { return u32x4{pk2(v0[0] * s, v0[1] * s), pk2(v0[2] * s, v0[3] * s), pk2(v1[0] * s, v1[1] * s), pk2(v1[2] * s, v1[3] * s)}; }
struct EpiBf16 {
  static constexpr bool PERM = true;
  bf16_t* out; int ld; float scale;
  DI void operator()(const f32x4 (&acc)[2][2][4][2], const Unit& u, int wr, int wc, int fr, int fq) const {
    const int row0 = u.pm * BM + wr * 64 + fr, col0 = u.pn * BM + wc * 32 + 8 * fq;
#pragma unroll
    for (int ai = 0; ai < 2; ++ai)
#pragma unroll
      for (int m = 0; m < 4; ++m) { bf16_t* rowp = out + (size_t)(row0 + ai * HALF + m * 16) * ld + col0;
#pragma unroll
        for (int bj = 0; bj < 2; ++bj) *(u32x4*)(rowp + bj * HALF) = pk8(acc[ai][bj][m][0], acc[ai][bj][m][1], scale); }
  }
};
struct EpiInproj {
  static constexpr bool PERM = true;
  bf16_t* lat; bf16_t* qs; bf16_t* ks; bf16_t* vs;
  DI void operator()(const f32x4 (&acc)[2][2][4][2], const Unit& u, int wr, int wc, int fr, int fq) const {
    const int row0 = u.pm * BM + wr * 64 + fr;
#pragma unroll
    for (int bj = 0; bj < 2; ++bj) {
      const int cw = u.pn * BM + bj * HALF + wc * 32;
      bf16_t* dst; int ld; float sc = 1.0f;
      if (cw < 448) { dst = lat + cw; ld = 448; } else if (cw < 960) { dst = qs + (cw - 448); ld = 512; sc = SWA_QSCALE; }
      else if (cw < 1088) { dst = ks + (cw - 960); ld = 128; } else if (cw < 1216) { dst = vs + (cw - 1088); ld = 128; } else continue;
#pragma unroll
      for (int ai = 0; ai < 2; ++ai)
#pragma unroll
        for (int m = 0; m < 4; ++m) *(u32x4*)(dst + (size_t)(row0 + ai * HALF + m * 16) * ld + 8 * fq) = pk8(acc[ai][bj][m][0], acc[ai][bj][m][1], sc);
    }
  }
};
template <bool BASE_F32>
struct EpiResid16 {
  static constexpr bool PERM = true;
  const void* base; bf16_t* out; int ld; float scale;
  DI void operator()(const f32x4 (&acc)[2][2][4][2], const Unit& u, int wr, int wc, int fr, int fq) const {
    const int row0 = u.pm * BM + wr * 64 + fr, col0 = u.pn * BM + wc * 32 + 8 * fq;
#pragma unroll
    for (int ai = 0; ai < 2; ++ai)
#pragma unroll
      for (int m = 0; m < 4; ++m) { const size_t ro = (size_t)(row0 + ai * HALF + m * 16) * ld + col0;
        f32x4 b[2][2];
#pragma unroll
        for (int bj = 0; bj < 2; ++bj) {
          if (BASE_F32) { b[bj][0] = *(const f32x4*)((const float*)base + ro + bj * HALF); b[bj][1] = *(const f32x4*)((const float*)base + ro + bj * HALF + 4); }
          else { const u32x4 w = *(const u32x4*)((const bf16_t*)base + ro + bj * HALF);
            b[bj][0] = f32x4{bflo(w[0]), bfhi(w[0]), bflo(w[1]), bfhi(w[1])}; b[bj][1] = f32x4{bflo(w[2]), bfhi(w[2]), bflo(w[3]), bfhi(w[3])}; }
        }
#pragma unroll
        for (int bj = 0; bj < 2; ++bj) *(u32x4*)(out + ro + bj * HALF) = pk8(b[bj][0] + acc[ai][bj][m][0] * scale, b[bj][1] + acc[ai][bj][m][1] * scale, 1.0f);
        if (m & 1) asm volatile("" ::: "memory"); }
  }
};
template <class Epi>
DI void run_on(const bf16_t* A, const bf16_t* Bt, int M, int N, int K, const Epi& E, char* smem, int c, int G) {
  StaticOrder S; S.init(M, N, G, c);
  gemm_phase<Epi>((PG8_LAS unsigned char*)smem, Gemm{A, Bt, M, N, K}, S, E);
  __syncthreads();
}
template <class Epi>
DI void run(const bf16_t* A, const bf16_t* Bt, int M, int N, int K, const Epi& E, char* smem) { run_on(A, Bt, M, N, K, E, smem, (int)blockIdx.x, (int)gridDim.x); }
}

DI int tokey(float f) { const int u = __float_as_int(f); return u ^ ((u >> 31) & 0x7fffffff); }
DI float fromkey(int k) { return __int_as_float(k ^ ((k >> 31) & 0x7fffffff)); }
DI void ins16(int (&top)[16], int key) {
#pragma unroll
  for (int j = 0; j < 16; ++j) { const int h = max(top[j], key); key = min(top[j], key); top[j] = h; }
}

DI void score_phase(const Params& p, char* smem) {
  const int ntn = T / G_BN, total = (2048 / G_BM) * ntn;
  for (int L = blockIdx.x; L < total; L += gridDim.x) {
    const int wg = (L & 7) * (total >> 3) + (L >> 3);
    const int pn = wg >> 3, pm = wg & 7;
    f32x16 acc[4];
    gemm_mainloop<1>(p.wt_sc, DM, p.xn, DM, DM, pm * G_BM, pn * G_BN, acc, smem);
    SBAR();
    const int tid = threadIdx.x, lane = tid & 63, wid = tid >> 6, r32 = lane & 31, hi = lane >> 5;
    const int group = pm * 2 + (wid >> 2);
    const int tok = pn * G_BN + (wid & 3) * 32 + r32;
    int top[16];
    {
      int g[4][16];
#pragma unroll
      for (int mi = 0; mi < 4; ++mi)
#pragma unroll
        for (int r = 0; r < 16; ++r) { const int n = 32 * mi + crow(r, hi); g[mi][r] = (tokey(acc[mi][r]) & ~127) | (127 - n); }
#pragma unroll
      for (int mi = 0; mi < 4; ++mi)
#pragma unroll
        for (int k = 2; k <= 16; k <<= 1)
#pragma unroll
          for (int j = k >> 1; j >= 1; j >>= 1)
#pragma unroll
            for (int i = 0; i < 16; ++i) { const int l = i ^ j; if (l > i) { const int a = g[mi][i], b = g[mi][l]; const bool desc = (k == 16) || ((i & k) == 0);
              g[mi][i] = desc ? max(a, b) : min(a, b); g[mi][l] = desc ? min(a, b) : max(a, b); } }
      auto merge16 = [](int (&a)[16], const int (&b)[16]) {
#pragma unroll
        for (int i = 0; i < 16; ++i) a[i] = max(a[i], b[15 - i]);
#pragma unroll
        for (int d = 8; d >= 1; d >>= 1)
#pragma unroll
          for (int i = 0; i < 16; ++i) if ((i & d) == 0) { const int x = max(a[i], a[i + d]), y = min(a[i], a[i + d]); a[i] = x; a[i + d] = y; }
      };
      merge16(g[0], g[1]); merge16(g[2], g[3]); merge16(g[0], g[2]);
#pragma unroll
      for (int i = 0; i < 16; ++i) top[i] = g[0][i];
    }
    int c[16];
#pragma unroll
    for (int j = 0; j < 16; ++j) {
      auto rr = __builtin_amdgcn_permlane32_swap((unsigned)top[15 - j], (unsigned)top[15 - j], false, false);
      const int other = hi ? (int)rr[0] : (int)rr[1];
      c[j] = max(top[j], other);
    }
#pragma unroll
    for (int d = 8; d >= 1; d >>= 1)
#pragma unroll
      for (int i = 0; i < 16; ++i) if ((i & d) == 0) { const int a = max(c[i], c[i + d]), b = min(c[i], c[i + d]); c[i] = a; c[i + d] = b; }
    int* dst = p.top1 + ((size_t)tok * 16 + group) * 16 + hi * 8;
    if (hi == 0) { *(i32x4*)dst = i32x4{c[0], c[1], c[2], c[3]}; *(i32x4*)(dst + 4) = i32x4{c[4], c[5], c[6], c[7]}; }
    else         { *(i32x4*)dst = i32x4{c[8], c[9], c[10], c[11]}; *(i32x4*)(dst + 4) = i32x4{c[12], c[13], c[14], c[15]}; }
    SBAR();
  }
}

DI void ins16v(float (&bv)[16], int (&bp)[16], float v, int pl) {
#pragma unroll
  for (int j = 0; j < 16; ++j) { const bool c = v > bv[j]; const float nv = c ? bv[j] : v; const int np = c ? bp[j] : pl; bv[j] = c ? v : bv[j]; bp[j] = c ? pl : bp[j]; v = nv; pl = np; }
}
DI void topk2_phase(const Params& p) {
  const int nitems = T * 8;
  for (int it = blockIdx.x * NTHREADS + threadIdx.x; it < nitems; it += gridDim.x * NTHREADS) {
    const int* src = p.top1 + (size_t)it * 32;
    int ka[16], kb[16];
#pragma unroll
    for (int q = 0; q < 4; ++q) { const i32x4 v = *(const i32x4*)(src + 4 * q); ka[4 * q] = v[0]; ka[4 * q + 1] = v[1]; ka[4 * q + 2] = v[2]; ka[4 * q + 3] = v[3]; }
#pragma unroll
    for (int q = 0; q < 4; ++q) { const i32x4 v = *(const i32x4*)(src + 16 + 4 * q); kb[4 * q] = v[0]; kb[4 * q + 1] = v[1]; kb[4 * q + 2] = v[2]; kb[4 * q + 3] = v[3]; }
    float av[16], bvv[16]; int ia[16], ib[16];
#pragma unroll
    for (int i = 0; i < 16; ++i) { av[i] = fromkey(ka[i] & ~127); ia[i] = (127 - (ka[i] & 127)) << 7; bvv[i] = fromkey(kb[i] & ~127); ib[i] = 127 - (kb[i] & 127); }
    int best[16];
#pragma unroll
    for (int j = 0; j < 16; ++j) best[j] = (int)0x80000000;
#pragma unroll
    for (int i = 0; i < 16; ++i)
#pragma unroll
      for (int j = 0; j < 16; ++j)
        if ((i + 1) * (j + 1) <= 16) ins16(best, (tokey(av[i] + bvv[j]) & ~0x3fff) | ia[i] | ib[j]);
    float bv[16]; int bp[16];
#pragma unroll
    for (int j = 0; j < 16; ++j) { bv[j] = fromkey(best[j] & ~0x3fff); bp[j] = best[j] & 0x3fff; }
    const float m = bv[0];
    float w[16], sum = 0.f;
#pragma unroll
    for (int j = 0; j < 16; ++j) { w[j] = __builtin_amdgcn_exp2f((bv[j] - m) * LOG2E); sum += w[j]; }
    const float inv = 1.0f / sum;
    int* di = p.pidx + (size_t)it * 16; float* dg = p.pg + (size_t)it * 16;
#pragma unroll
    for (int q = 0; q < 4; ++q) {
      *(i32x4*)(di + 4 * q) = i32x4{bp[4 * q], bp[4 * q + 1], bp[4 * q + 2], bp[4 * q + 3]};
#if DBG == 5
      *(f32x4*)(dg + 4 * q) = f32x4{0.0625f, 0.0625f, 0.0625f, 0.0625f};
#else
      *(f32x4*)(dg + 4 * q) = f32x4{w[4 * q] * inv, w[4 * q + 1] * inv, w[4 * q + 2] * inv, w[4 * q + 3] * inv};
#endif
    }
  }
}

template <int NDB> DI int v_st(int k, int c) { const int kk = (k & ~0xC) | ((k & 4) << 1) | ((k & 8) >> 1); return ((kk >> 3) * NDB + (c >> 5)) * 512 + ((kk & 7) * 32 + (c & 31)) * 2; }
DI int v_rd_base(int lane) { return ((lane & 3) << 3) | (((lane >> 2) & 3) << 6) | (((lane >> 4) & 1) << 5) | (((lane >> 5) & 1) << 8); }
template <int OFF> DI s16x4 tr_read(int vb) { s16x4 r; asm volatile("ds_read_b64_tr_b16 %0, %1 offset:%2" : "=&v"(r) : "v"(vb), "i"(OFF) : "memory"); return r; }
template <int NDB, int D0> DI void pv_one(f32x16& od, int vb, bf16x8 pa0, bf16x8 pa1, bf16x8 pa2, bf16x8 pa3) {
  constexpr int KS = 2 * NDB * 512, HF = NDB * 512;
  const s16x4 l0 = tr_read<D0 * 512 + 0 * KS>(vb), h0 = tr_read<D0 * 512 + 0 * KS + HF>(vb), l1 = tr_read<D0 * 512 + 1 * KS>(vb), h1 = tr_read<D0 * 512 + 1 * KS + HF>(vb);
  const s16x4 l2 = tr_read<D0 * 512 + 2 * KS>(vb), h2 = tr_read<D0 * 512 + 2 * KS + HF>(vb), l3 = tr_read<D0 * 512 + 3 * KS>(vb), h3 = tr_read<D0 * 512 + 3 * KS + HF>(vb);
  asm volatile("s_waitcnt lgkmcnt(0)" ::: "memory"); SBAR();
#define PKV(L, H) (bf16x8){L[0], L[1], L[2], L[3], H[0], H[1], H[2], H[3]}
  od = MFMA32(pa0, PKV(l0, h0), od); od = MFMA32(pa1, PKV(l1, h1), od); od = MFMA32(pa2, PKV(l2, h2), od); od = MFMA32(pa3, PKV(l3, h3), od);
#undef PKV
}

template <int OFF> DI void pv_rd4(int vb, s16x4 (&l)[2], s16x4 (&h)[2]) {
  constexpr int KS = 2 * 4 * 512, HF = 4 * 512;
  l[0] = tr_read<OFF>(vb); h[0] = tr_read<OFF + HF>(vb); l[1] = tr_read<OFF + KS>(vb); h[1] = tr_read<OFF + KS + HF>(vb);
}
#define PKV(L, H) (bf16x8){L[0], L[1], L[2], L[3], H[0], H[1], H[2], H[3]}
DI void pv_all4(f32x16 (&o)[4], int vb, bf16x8 pa0, bf16x8 pa1, bf16x8 pa2, bf16x8 pa3) {
  constexpr int KS2 = 2 * 2 * 4 * 512;
  s16x4 la[2], ha[2], lb[2], hb[2];
  pv_rd4<0 * 512>(vb, la, ha); pv_rd4<0 * 512 + KS2>(vb, lb, hb);
#define PV_STEP(D, NEXTA, NEXTB) \
  asm volatile("s_waitcnt lgkmcnt(4)" ::: "memory"); SBAR(); \
  o[D] = MFMA32(pa0, PKV(la[0], ha[0]), o[D]); o[D] = MFMA32(pa1, PKV(la[1], ha[1]), o[D]); SBAR(); \
  NEXTA; \
  asm volatile("s_waitcnt lgkmcnt(4)" ::: "memory"); SBAR(); \
  o[D] = MFMA32(pa2, PKV(lb[0], hb[0]), o[D]); o[D] = MFMA32(pa3, PKV(lb[1], hb[1]), o[D]); SBAR(); \
  NEXTB;
  PV_STEP(0, (pv_rd4<1 * 512>(vb, la, ha)), (pv_rd4<1 * 512 + KS2>(vb, lb, hb)))
  PV_STEP(1, (pv_rd4<2 * 512>(vb, la, ha)), (pv_rd4<2 * 512 + KS2>(vb, lb, hb)))
  PV_STEP(2, (pv_rd4<3 * 512>(vb, la, ha)), (pv_rd4<3 * 512 + KS2>(vb, lb, hb)))
  asm volatile("s_waitcnt lgkmcnt(4)" ::: "memory"); SBAR();
  o[3] = MFMA32(pa0, PKV(la[0], ha[0]), o[3]); o[3] = MFMA32(pa1, PKV(la[1], ha[1]), o[3]); SBAR();
  asm volatile("s_waitcnt lgkmcnt(0)" ::: "memory"); SBAR();
  o[3] = MFMA32(pa2, PKV(lb[0], hb[0]), o[3]); o[3] = MFMA32(pa3, PKV(lb[1], hb[1]), o[3]);
#undef PV_STEP
}
#undef PKV

template <int DQK, int DV, int MODE>
struct AttnArgs {
  const bf16_t* Kb; int ldk;
  const bf16_t* Vb; int ldv;
  int jt0, NT;
  int tq;
  int diag_tile;
  int tw0;
  float slope2, sink2;
  bf16_t* Ow; int ldo;
};

template <int DQK, int DV, int MODE, int QL>
DI void attn_unit(const bf16x8 (&qr)[DQK / 16 - QL], const AttnArgs<DQK, DV, MODE>& a, char* smem) {
  constexpr int NKS = DQK / 16, NDB = DV / 32, KSTR = DQK * 2 + 16, KBUF = 64 * KSTR, VBUF = 64 * DV * 2, BUF = KBUF + VBUF, NKC = DQK / 64, NVC = DV / 64;
  const int tid = threadIdx.x, wid = __builtin_amdgcn_readfirstlane(tid >> 6), lane = tid & 63, r32 = lane & 31, hi = lane >> 5;
  const bool rot = (wid >= 4);
  float* wsf = (float*)(smem + 3 * BUF) + wid * 64; float* li_l = wsf; float* al_l = wsf + 32;
  const char* qlds = smem + 3 * BUF + 2048 + wid * 4096 + r32 * 128;
  const int qx = (r32 >> 1) & 7;
  float m_reg = -1e30f, l_reg = 0.f; f32x16 o[NDB];
#pragma unroll
  for (int d = 0; d < NDB; ++d) o[d] = f32x16{};
  const int srow = tid >> 3, c8 = tid & 7;
  const int vb0 = (int)(uintptr_t)smem + v_rd_base(lane);
  bf16x8 kst[NKC], vst[(MODE == 0) ? 1 : NVC];
  auto sload = [&](int jt) {
    const size_t krow = (size_t)(jt * 64 + srow);
#pragma unroll
    for (int i = 0; i < NKC; ++i) kst[i] = *(const bf16x8*)(a.Kb + krow * a.ldk + 64 * i + 8 * c8);
    if (MODE != 0) {
#pragma unroll
      for (int i = 0; i < NVC; ++i) vst[i] = *(const bf16x8*)(a.Vb + krow * a.ldv + 64 * i + 8 * c8);
    }
  };
  auto swrite = [&](int b) {
    char* bp = smem + b * BUF;
#pragma unroll
    for (int i = 0; i < NKC; ++i) *(bf16x8*)(bp + VBUF + srow * KSTR + (64 * i + 8 * c8) * 2) = kst[i];
    if (MODE == 0) {
#pragma unroll
      for (int i = 0; i < NVC; ++i) *(bf16x8*)(bp + v_st<NDB>(srow, 64 * i + 8 * c8)) = kst[i];
    } else {
#pragma unroll
      for (int i = 0; i < NVC; ++i) *(bf16x8*)(bp + v_st<NDB>(srow, 64 * i + 8 * c8)) = vst[i];
    }
  };
  auto tile_active = [&](int jt) -> bool { if (MODE == 2) return (jt * 64 + 63 >= a.tw0 - 127) && (jt * 64 <= a.tw0 + 31); return true; };
  f32x16 p0, p1;
  auto qkt = [&](int b) {
    p0 = f32x16{}; p1 = f32x16{};
    const char* Kc = smem + b * BUF + VBUF + r32 * KSTR + hi * 16;
    __builtin_amdgcn_s_setprio(1);
#pragma unroll
    for (int s = 0; s < NKS - QL; ++s) {
      const bf16x8 b0 = *(const bf16x8*)(Kc + s * 32), b1 = *(const bf16x8*)(Kc + 32 * KSTR + s * 32);
      p0 = MFMA32(b0, qr[s], p0); p1 = MFMA32(b1, qr[s], p1);
    }
#pragma unroll
    for (int s = NKS - QL; s < NKS; ++s) {
      const bf16x8 b0 = *(const bf16x8*)(Kc + s * 32), b1 = *(const bf16x8*)(Kc + 32 * KSTR + s * 32);
      const bf16x8 qf = *(const bf16x8*)(qlds + (((2 * (s - (NKS - QL)) + hi) ^ qx) << 4));
      p0 = MFMA32(b0, qf, p0); p1 = MFMA32(b1, qf, p1);
    }
    __builtin_amdgcn_s_setprio(0);
  };
  sload(a.jt0); swrite(0);
  if (a.NT > 1) { sload(a.jt0 + 1); swrite(1); }
  __syncthreads();
  if (rot && tile_active(a.jt0)) qkt(0);
  int cur = 0;
  for (int j = 0; j < a.NT; ++j) {
    const int jt = a.jt0 + j;
    int nxt = cur + 1; if (nxt == 3) nxt = 0;
    int nx2 = nxt + 1; if (nx2 == 3) nx2 = 0;
    if (j + 2 < a.NT) sload(jt + 2);
    const bool active = tile_active(jt);
    if (active) {
      if (!rot) qkt(cur);
      if (MODE == 0) {
        if (jt == a.diag_tile) {
          const int tl = a.tq & 63;
#pragma unroll
          for (int r = 0; r < 16; ++r) { const int kl = crow(r, hi); if (kl > tl) p0[r] = -INFINITY; if (kl + 32 > tl) p1[r] = -INFINITY; }
        }
      } else if (MODE == 2) {
#pragma unroll
        for (int r = 0; r < 16; ++r) {
          const int d0 = a.tq - (jt * 64 + crow(r, hi)), d1 = d0 - 32;
          p0[r] = (d0 >= 0 && d0 < 128) ? p0[r] - a.slope2 * (float)d0 : -INFINITY;
          p1[r] = (d1 >= 0 && d1 < 128) ? p1[r] - a.slope2 * (float)d1 : -INFINITY;
        }
      }
      float pmax = p0[0];
#pragma unroll
      for (int r = 1; r < 16; ++r) pmax = fmaxf(pmax, p0[r]);
#pragma unroll
      for (int r = 0; r < 16; ++r) pmax = fmaxf(pmax, p1[r]);
      { auto rr = __builtin_amdgcn_permlane32_swap(__float_as_uint(pmax), __float_as_uint(pmax), false, false); pmax = fmaxf(__uint_as_float(rr[0]), __uint_as_float(rr[1])); }
      float mn, alpha;
      if (__all(pmax - m_reg <= SM_THR)) { mn = m_reg; alpha = 1.f; }
      else { mn = fmaxf(m_reg, pmax); alpha = __builtin_amdgcn_exp2f(m_reg - mn); m_reg = mn; }
#pragma unroll
      for (int r = 0; r < 16; ++r) { p0[r] = __builtin_amdgcn_exp2f(p0[r] - mn); p1[r] = __builtin_amdgcn_exp2f(p1[r] - mn); }
      float ps = 0.f;
#pragma unroll
      for (int r = 0; r < 16; ++r) ps += p0[r] + p1[r];
      { auto rr = __builtin_amdgcn_permlane32_swap(__float_as_uint(ps), __float_as_uint(ps), false, false); ps = __uint_as_float(rr[0]) + __uint_as_float(rr[1]); }
      l_reg = l_reg * alpha + ps;
      if (__any(alpha < 1.f)) {
        if (hi == 0) al_l[r32] = alpha;
        asm volatile("s_waitcnt lgkmcnt(0)" ::: "memory");
#pragma unroll
        for (int r = 0; r < 16; ++r) { const float al = al_l[crow(r, hi)];
#pragma unroll
          for (int d = 0; d < NDB; ++d) o[d][r] *= al; }
      }
      bf16x8 pa0, pa1, pa2, pa3;
#define PK4(P, BASE, OUT) do { const unsigned a0 = pk2(P[BASE + 0], P[BASE + 1]), a1 = pk2(P[BASE + 2], P[BASE + 3]);   \
      const unsigned b0_ = pk2(P[BASE + 4], P[BASE + 5]), b1_ = pk2(P[BASE + 6], P[BASE + 7]);                          \
      auto r0 = __builtin_amdgcn_permlane32_swap(a0, b0_, false, false); auto r1 = __builtin_amdgcn_permlane32_swap(a1, b1_, false, false); \
      u32x4 w = {r0[0], r1[0], r0[1], r1[1]}; OUT = __builtin_bit_cast(bf16x8, w); } while (0)
      PK4(p0, 0, pa0); PK4(p0, 8, pa1); PK4(p1, 0, pa2); PK4(p1, 8, pa3);
#undef PK4
      const int vb = vb0 + cur * BUF;
      __builtin_amdgcn_s_setprio(1);
      pv_one<NDB, 0>(o[0], vb, pa0, pa1, pa2, pa3);
      pv_one<NDB, 1>(o[1], vb, pa0, pa1, pa2, pa3);
      if constexpr (NDB > 2) { pv_one<NDB, 2>(o[2], vb, pa0, pa1, pa2, pa3); pv_one<NDB, 3>(o[3], vb, pa0, pa1, pa2, pa3); }
      __builtin_amdgcn_s_setprio(0);
    }
    if (j + 2 < a.NT) swrite(nx2);
    if (rot && j + 1 < a.NT && tile_active(jt + 1)) qkt(nxt);
    __syncthreads();
    cur = nxt;
  }
  if (MODE == 2) l_reg += __builtin_amdgcn_exp2f(a.sink2 - m_reg);
  if (hi == 0) li_l[r32] = l_reg;
  asm volatile("s_waitcnt lgkmcnt(0)" ::: "memory");
#pragma unroll
  for (int r = 0; r < 16; ++r) {
    const int orow = crow(r, hi); const float rl = 1.0f / li_l[orow];
#pragma unroll
    for (int d = 0; d < NDB; ++d) a.Ow[(size_t)orow * a.ldo + d * 32 + r32] = f2bf(o[d][r] * rl);
  }
  __syncthreads();
}

#define MFMA32F8(a, b, c) __builtin_amdgcn_mfma_f32_32x32x16_fp8_fp8((a), (b), (c), 0, 0, 0)
typedef int i32x8u __attribute__((ext_vector_type(8)));
DI void mla_unit(const i32x8u (&q8)[3], const unsigned char* __restrict__ K8b, const unsigned char* __restrict__ Vt8b, int NT, int tl, bf16_t* Ow, char* smem) {
  constexpr int NDB = 4, KSTR = 192, VBUF = 8192, KBUF = 64 * KSTR, BUF = VBUF + KBUF;
  const int tid = threadIdx.x, wid = __builtin_amdgcn_readfirstlane(tid >> 6), lane = tid & 63, r32 = lane & 31, hi = lane >> 5;
  const bool rot = (wid >= 4);
  float* li_l = (float*)(smem + 3 * BUF) + wid * 64;
  float l_reg = 0.f; f32x16 o[NDB];
#pragma unroll
  for (int d = 0; d < NDB; ++d) o[d] = f32x16{};
  unsigned ksrc[2];
#pragma unroll
  for (int i = 0; i < 2; ++i) { const int q = i * 512 + tid, row = q / 12, pc = q - 12 * row, c = (pc & 12) | ((pc & 3) ^ ((row >> 2) & 3)); ksrc[i] = (unsigned)(row * 192 + c * 16); }
  const unsigned vsrc = (unsigned)((tid >> 2) * SEQ + 16 * ((tid & 3) ^ ((tid >> 4) & 3)));
  const char* K8base = (const char*)K8b; const char* Vbase = (const char*)Vt8b;
  auto stage = [&](int jt, int b) {
    const char* tk = K8base + (size_t)jt * (64 * 192); const char* tv = Vbase + (size_t)jt * 64; char* bp = smem + b * BUF + tid * 16;
    { unsigned off = vsrc; asm volatile("" : "+v"(off));
      __builtin_amdgcn_global_load_lds((const unsigned*)(tv + off), LDSP(bp), 16, 0, 0); }
    { unsigned off = ksrc[0]; asm volatile("" : "+v"(off)); __builtin_amdgcn_global_load_lds((const unsigned*)(tk + off), LDSP(bp + VBUF), 16, 0, 0); }
    if (wid < 4) { unsigned off = ksrc[1]; asm volatile("" : "+v"(off)); __builtin_amdgcn_global_load_lds((const unsigned*)(tk + off), LDSP(bp + VBUF + 8192), 16, 0, 0); }
  };
  f32x16 p0, p1;
#define DSR(dst, addr, OFF) asm volatile("ds_read_b128 %0, %1 offset:%2" : "=&v"(dst) : "v"(addr), "i"(OFF) : "memory")
#define QK_WAIT(n) do { asm volatile("s_waitcnt lgkmcnt(" #n ")" ::: "memory"); SBAR(); } while (0)
#define QK_RD(A0, A1, B0, B1, pb) do { DSR(A0, ka0, (pb) * 64); DSR(A1, ka1, (pb) * 64); DSR(B0, ka0, 32 * KSTR + (pb) * 64); DSR(B1, ka1, 32 * KSTR + (pb) * 64); } while (0)
#define CAT8(X, Y) (i32x8u){(int)(X)[0], (int)(X)[1], (int)(X)[2], (int)(X)[3], (int)(Y)[0], (int)(Y)[1], (int)(Y)[2], (int)(Y)[3]}
#define QK_MMA(A0, A1, B0, B1, pb) do { p0 = __builtin_amdgcn_mfma_scale_f32_32x32x64_f8f6f4(CAT8(A0, A1), q8[pb], p0, 0, 0, 0, 0x7f7f7f7f, 0, 0x7f7f7f7f); \
    p1 = __builtin_amdgcn_mfma_scale_f32_32x32x64_f8f6f4(CAT8(B0, B1), q8[pb], p1, 0, 0, 0, 0x7f7f7f7f, 0, 0x7f7f7f7f); SBAR(); } while (0)
  const int swz = (r32 >> 2) & 3;
  auto qkt = [&](int b) {
    const int kb = (int)(uintptr_t)(smem + b * BUF + VBUF) + r32 * KSTR;
    const int ka0 = kb + (((2 * hi) ^ swz) << 4), ka1 = kb + (((2 * hi + 1) ^ swz) << 4);
    p0 = f32x16{}; p1 = f32x16{};
    u32x4 a0, a1, a2, a3, b0, b1, b2, b3;
    __builtin_amdgcn_s_setprio(1);
    QK_RD(a0, a1, a2, a3, 0); QK_RD(b0, b1, b2, b3, 1);
    QK_WAIT(4); QK_MMA(a0, a1, a2, a3, 0); QK_RD(a0, a1, a2, a3, 2);
    QK_WAIT(4); QK_MMA(b0, b1, b2, b3, 1);
    QK_WAIT(0); QK_MMA(a0, a1, a2, a3, 2);
    __builtin_amdgcn_s_setprio(0);
  };
#define MLA_SYNC() do { asm volatile("s_waitcnt vmcnt(0) lgkmcnt(0)" ::: "memory"); __builtin_amdgcn_s_barrier(); asm volatile("" ::: "memory"); } while (0)
  stage(0, 0);
  if (NT > 1) stage(1, 1);
  MLA_SYNC();
  if (rot) qkt(0);
  int cur = 0;
  for (int j = 0; j < NT; ++j) {
    int nxt = cur + 1; if (nxt == 3) nxt = 0;
    int nx2 = nxt + 1; if (nx2 == 3) nx2 = 0;
    if (j + 2 < NT) stage(j + 2, nx2);
    if (!rot) qkt(cur);
    if (j == NT - 1) {
#pragma unroll
      for (int r = 0; r < 16; ++r) { const int kl = crow(r, hi); if (kl > tl) p0[r] = -INFINITY; if (kl + 32 > tl) p1[r] = -INFINITY; }
    }
    float mx = fmaxf(p0[0], p1[0]);
#pragma unroll
    for (int r = 1; r < 16; ++r) mx = fmaxf(mx, fmaxf(p0[r], p1[r]));
    { auto rr = __builtin_amdgcn_permlane32_swap(__float_as_uint(mx), __float_as_uint(mx), false, false); mx = fmaxf(__uint_as_float(rr[0]), __uint_as_float(rr[1])); }
    const float ef = __builtin_ceilf(fmaxf(mx, -100.f)) - 7.f;
    const int ei = (int)ef;
#pragma unroll
    for (int r = 0; r < 16; ++r) { p0[r] = __builtin_amdgcn_exp2f(p0[r] - ef); p1[r] = __builtin_amdgcn_exp2f(p1[r] - ef); }
    float ps = 0.f;
#pragma unroll
    for (int r = 0; r < 16; ++r) ps += p0[r] + p1[r];
    asm volatile("" : "+v"(ps));
    l_reg += __builtin_ldexpf(ps, ei);
    i32x8u pa;
#pragma unroll
    for (int c = 0; c < 4; ++c) {
      int w0 = __builtin_amdgcn_cvt_pk_fp8_f32(p0[4 * c], p0[4 * c + 1], 0, false); w0 = __builtin_amdgcn_cvt_pk_fp8_f32(p0[4 * c + 2], p0[4 * c + 3], w0, true);
      int w1 = __builtin_amdgcn_cvt_pk_fp8_f32(p1[4 * c], p1[4 * c + 1], 0, false); w1 = __builtin_amdgcn_cvt_pk_fp8_f32(p1[4 * c + 2], p1[4 * c + 3], w1, true);
      auto rr = __builtin_amdgcn_permlane32_swap((unsigned)w0, (unsigned)w1, false, false);
      pa[c] = (int)rr[0]; pa[4 + c] = (int)rr[1];
    }
    const int sc = ei + 127;
    if (rot && j + 1 < NT) qkt(nxt);
    u32x4 v0a, v0b, v1a, v1b, v2a, v2b, v3a, v3b;
    {
      const int vbs = (int)(uintptr_t)(smem + cur * BUF) + r32 * 64;
      const int va0 = vbs + (((2 * hi) ^ swz) << 4), va1 = vbs + (((2 * hi + 1) ^ swz) << 4);
      DSR(v0a, va0, 0); DSR(v0b, va1, 0); DSR(v1a, va0, 2048); DSR(v1b, va1, 2048); DSR(v2a, va0, 4096); DSR(v2b, va1, 4096); DSR(v3a, va0, 6144); DSR(v3b, va1, 6144);
      SBAR();
    }
    __builtin_amdgcn_s_setprio(1);
#define PV_MMA(D, X, Y) o[D] = __builtin_amdgcn_mfma_scale_f32_32x32x64_f8f6f4(pa, CAT8(X, Y), o[D], 0, 0, 0, sc, 0, 0x7f7f7f7f)
    QK_WAIT(6); PV_MMA(0, v0a, v0b); QK_WAIT(4); PV_MMA(1, v1a, v1b); QK_WAIT(2); PV_MMA(2, v2a, v2b); QK_WAIT(0); PV_MMA(3, v3a, v3b);
    SBAR();
#undef PV_MMA
    __builtin_amdgcn_s_setprio(0);
    MLA_SYNC();
    cur = nxt;
  }
  { auto rr = __builtin_amdgcn_permlane32_swap(__float_as_uint(l_reg), __float_as_uint(l_reg), false, false); l_reg = __uint_as_float(rr[0]) + __uint_as_float(rr[1]); }
  if (hi == 0) li_l[r32] = l_reg;
  asm volatile("s_waitcnt lgkmcnt(0)" ::: "memory");
  {
    int lo = hi * (4 * 512) + r32; asm volatile("" : "+v"(lo));
    bf16_t* Op = Ow + lo;
#pragma unroll
    for (int r = 0; r < 16; ++r) {
      const float rl = __builtin_amdgcn_rcpf(li_l[crow(r, hi)]);
#pragma unroll
      for (int d = 0; d < NDB; ++d) Op[((r & 3) + 8 * (r >> 2)) * 512 + d * 32] = f2bf(o[d][r] * rl);
    }
  }
  __syncthreads();
#undef MLA_SYNC
#undef DSR
#undef QK_WAIT
#undef CAT8
#undef QK_MMA
#undef QK_RD
}

typedef int i32x8 __attribute__((ext_vector_type(8)));
DI void mla_phase(const Params& p, char* smem) {
  const int tid = threadIdx.x, wid = __builtin_amdgcn_readfirstlane(tid >> 6), lane = tid & 63, r32 = lane & 31, hi = lane >> 5;
  for (int k = blockIdx.x; k < 256; k += gridDim.x) {
#pragma unroll 1
    for (int half = 0; half < 2; ++half) {
      const int b = k & 1, i0 = k >> 1, i = half ? (255 - i0) : i0;
      const int head = wid >> 1, tq = i * 64 + (wid & 1) * 32 + r32;
      const size_t trow = (size_t)b * SEQ + tq;
      i32x8 q8[3];
      const bf16_t* qrow = p.qcat + trow * 768 + head * 192;
      auto pack4 = [](float a, float b, float c, float d) -> int { int w = 0; w = __builtin_amdgcn_cvt_pk_fp8_f32(a, b, w, false); w = __builtin_amdgcn_cvt_pk_fp8_f32(c, d, w, true); return w; };
#pragma unroll
      for (int pb = 0; pb < 2; ++pb) {
        const bf16_t* qp = qrow + 64 * pb + 32 * hi;
#pragma unroll
        for (int c = 0; c < 4; ++c) { const bf16x8 x = *(const bf16x8*)(qp + 8 * c);
          q8[pb][2 * c] = pack4(bf2f((bf16_t)x[0]), bf2f((bf16_t)x[1]), bf2f((bf16_t)x[2]), bf2f((bf16_t)x[3]));
          q8[pb][2 * c + 1] = pack4(bf2f((bf16_t)x[4]), bf2f((bf16_t)x[5]), bf2f((bf16_t)x[6]), bf2f((bf16_t)x[7])); }
      }
      {
        const float* rp = p.rope + trow * 64;
#pragma unroll
        for (int c = 0; c < 4; ++c) {
          const bf16x8 x1 = *(const bf16x8*)(qrow + 128 + 8 * c), x2 = *(const bf16x8*)(qrow + 160 + 8 * c);
          float v[8];
#pragma unroll
          for (int j = 0; j < 8; ++j) {
            const f32x2 cs = *(const f32x2*)(rp + 2 * (8 * c + j));
            const float a1 = bf2f((bf16_t)x1[j]), a2 = bf2f((bf16_t)x2[j]);
            v[j] = hi ? (a2 * cs[0] + a1 * cs[1]) : (a1 * cs[0] - a2 * cs[1]);
          }
          q8[2][2 * c] = pack4(v[0], v[1], v[2], v[3]); q8[2][2 * c + 1] = pack4(v[4], v[5], v[6], v[7]);
        }
      }
      mla_unit(q8, p.k8 + (size_t)b * SEQ * 192, p.vt8 + (size_t)b * SEQ * 128, i + 1, tq & 63, p.olat + ((size_t)b * SEQ + i * 64 + (wid & 1) * 32) * 512 + head * 128, smem);
    }
  }
}

DI void swa_phase(const Params& p, char* smem) {
  constexpr int KSTR = 144, KBUF = 64 * KSTR, VBUF = 64 * 64 * 2, BUF = KBUF + VBUF, NDB = 2;
  const int tid = threadIdx.x, wid = __builtin_amdgcn_readfirstlane(tid >> 6), lane = tid & 63, r32 = lane & 31, hi = lane >> 5;
  float* wsf = (float*)(smem + 6 * BUF) + wid * 64; float* li_l = wsf; float* al_l = wsf + 32;
  const int srow = tid >> 3, c8 = tid & 7;
  const int vb0 = (int)(uintptr_t)smem + v_rd_base(lane);
  for (int u = blockIdx.x; u < 256; u += gridDim.x) {
    const int kvh = u & 1, i = (u >> 1) & 63, b = u >> 7;
    const int jt0 = (i == 0) ? 0 : (4 * i - 2), NT = 4 * i + 4 - jt0;
    const bf16_t* Kb = p.ks + (size_t)b * SEQ * 128 + kvh * 64; const bf16_t* Vb = p.vs + (size_t)b * SEQ * 128 + kvh * 64;
    {
      bf16x8 kst[6], vst[6];
#pragma unroll
      for (int j = 0; j < 6; ++j) if (j < NT) { const size_t krow = (size_t)((jt0 + j) * 64 + srow) * 128 + 8 * c8; kst[j] = *(const bf16x8*)(Kb + krow); vst[j] = *(const bf16x8*)(Vb + krow); }
#pragma unroll
      for (int j = 0; j < 6; ++j) if (j < NT) { char* bp = smem + j * BUF; *(bf16x8*)(bp + VBUF + srow * KSTR + 16 * c8) = kst[j]; *(bf16x8*)(bp + v_st<NDB>(srow, 8 * c8)) = vst[j]; }
    }
    __syncthreads();
    const int tw0 = i * 256 + wid * 32, tq = tw0 + r32;
    const size_t trow = (size_t)b * SEQ + tq;
#pragma unroll 1
    for (int g = 0; g < 4; ++g) {
      const int h = kvh * 4 + g;
      bf16x8 qr[4];
      const bf16_t* qp = p.qs + trow * 512 + h * 64 + hi * 8;
#pragma unroll
      for (int s = 0; s < 4; ++s) qr[s] = *(const bf16x8*)(qp + s * 16);
      const float slope2 = exp2f(-(float)(h + 1)) * LOG2E, sink2 = p.swa_sinks[h] * LOG2E;
      float m_reg = -1e30f, l_reg = 0.f; f32x16 o[NDB];
#pragma unroll
      for (int d = 0; d < NDB; ++d) o[d] = f32x16{};
      for (int j = 0; j < NT; ++j) {
        const int jt = jt0 + j;
        if (!((jt * 64 + 63 >= tw0 - 127) && (jt * 64 <= tw0 + 31))) continue;
        f32x16 p0 = f32x16{}, p1 = f32x16{};
        const char* Kc = smem + j * BUF + VBUF + r32 * KSTR + hi * 16;
#pragma unroll
        for (int s = 0; s < 4; ++s) {
          const bf16x8 b0 = *(const bf16x8*)(Kc + s * 32), b1 = *(const bf16x8*)(Kc + 32 * KSTR + s * 32);
          p0 = MFMA32(b0, qr[s], p0); p1 = MFMA32(b1, qr[s], p1);
        }
#pragma unroll
        for (int r = 0; r < 16; ++r) {
          const int d0 = tq - (jt * 64 + crow(r, hi)), d1 = d0 - 32;
          p0[r] = (d0 >= 0 && d0 < 128) ? p0[r] - slope2 * (float)d0 : -INFINITY;
          p1[r] = (d1 >= 0 && d1 < 128) ? p1[r] - slope2 * (float)d1 : -INFINITY;
        }
        float pmax = p0[0];
#pragma unroll
        for (int r = 1; r < 16; ++r) pmax = fmaxf(pmax, p0[r]);
#pragma unroll
        for (int r = 0; r < 16; ++r) pmax = fmaxf(pmax, p1[r]);
        { auto rr = __builtin_amdgcn_permlane32_swap(__float_as_uint(pmax), __float_as_uint(pmax), false, false); pmax = fmaxf(__uint_as_float(rr[0]), __uint_as_float(rr[1])); }
        float mn, alpha;
        if (__all(pmax - m_reg <= SM_THR)) { mn = m_reg; alpha = 1.f; }
        else { mn = fmaxf(m_reg, pmax); alpha = __builtin_amdgcn_exp2f(m_reg - mn); m_reg = mn; }
#pragma unroll
        for (int r = 0; r < 16; ++r) { p0[r] = __builtin_amdgcn_exp2f(p0[r] - mn); p1[r] = __builtin_amdgcn_exp2f(p1[r] - mn); }
        float ps = 0.f;
#pragma unroll
        for (int r = 0; r < 16; ++r) ps += p0[r] + p1[r];
        { auto rr = __builtin_amdgcn_permlane32_swap(__float_as_uint(ps), __float_as_uint(ps), false, false); ps = __uint_as_float(rr[0]) + __uint_as_float(rr[1]); }
        l_reg = l_reg * alpha + ps;
        if (__any(alpha < 1.f)) {
          if (hi == 0) al_l[r32] = alpha;
          asm volatile("s_waitcnt lgkmcnt(0)" ::: "memory");
#pragma unroll
          for (int r = 0; r < 16; ++r) { const float al = al_l[crow(r, hi)];
#pragma unroll
            for (int d = 0; d < NDB; ++d) o[d][r] *= al; }
        }
        bf16x8 pa0, pa1, pa2, pa3;
#define PK4(P, BASE, OUT) do { const unsigned a0 = pk2(P[BASE + 0], P[BASE + 1]), a1 = pk2(P[BASE + 2], P[BASE + 3]);   \
        const unsigned b0_ = pk2(P[BASE + 4], P[BASE + 5]), b1_ = pk2(P[BASE + 6], P[BASE + 7]);                          \
        auto r0 = __builtin_amdgcn_permlane32_swap(a0, b0_, false, false); auto r1 = __builtin_amdgcn_permlane32_swap(a1, b1_, false, false); \
        u32x4 w = {r0[0], r1[0], r0[1], r1[1]}; OUT = __builtin_bit_cast(bf16x8, w); } while (0)
        PK4(p0, 0, pa0); PK4(p0, 8, pa1); PK4(p1, 0, pa2); PK4(p1, 8, pa3);
#undef PK4
        const int vb = vb0 + j * BUF;
        pv_one<NDB, 0>(o[0], vb, pa0, pa1, pa2, pa3);
        pv_one<NDB, 1>(o[1], vb, pa0, pa1, pa2, pa3);
      }
      l_reg += __builtin_amdgcn_exp2f(sink2 - m_reg);
      if (hi == 0) li_l[r32] = l_reg;
      asm volatile("s_waitcnt lgkmcnt(0)" ::: "memory");
      bf16_t* Ow = p.ob + ((size_t)b * SEQ + tw0) * 512 + h * 64;
#pragma unroll
      for (int r = 0; r < 16; ++r) {
        const int orow = crow(r, hi); const float rl = __builtin_amdgcn_rcpf(li_l[orow]);
#pragma unroll
        for (int d = 0; d < NDB; ++d) Ow[(size_t)orow * 512 + d * 32 + r32] = f2bf(o[d][r] * rl);
      }
      asm volatile("s_waitcnt lgkmcnt(0)" ::: "memory");
    }
    __syncthreads();
  }
}

DI void xattn_phase(const Params& p, char* smem) {
  const int tid = threadIdx.x, wid = __builtin_amdgcn_readfirstlane(tid >> 6), lane = tid & 63, r32 = lane & 31, hi = lane >> 5;
  for (int u = blockIdx.x; u < 512; u += gridDim.x) {
    const int h = u & 3, i = (u >> 2) & 63, b = u >> 8;
    const int tq = i * 256 + wid * 32 + r32;
    const size_t trow = (size_t)b * SEQ + tq;
    bf16x8 qr[8];
    const bf16_t* qp = p.qx + trow * 512 + h * 128 + hi * 8;
#pragma unroll
    for (int s = 0; s < 8; ++s) qr[s] = *(const bf16x8*)(qp + s * 16);
    AttnArgs<128, 128, 1> a;
    a.Kb = p.kvc + (size_t)b * 256 * 1024 + h * 128; a.ldk = 1024; a.Vb = a.Kb + 512; a.ldv = 1024;
    a.jt0 = 0; a.NT = 4; a.tq = tq; a.diag_tile = -1; a.tw0 = 0; a.slope2 = 0.f; a.sink2 = 0.f;
    a.Ow = p.ox + ((size_t)b * SEQ + i * 256 + wid * 32) * 512 + h * 128; a.ldo = 512;
    attn_unit<128, 128, 1, 0>(qr, a, smem);
  }
}

DI void norm_rows_1024(const float* in, const float* gain, bf16_t* out, int nrows) {
  const int lane = threadIdx.x & 63, gw = (blockIdx.x * NTHREADS + threadIdx.x) >> 6, nw = gridDim.x * (NTHREADS / 64);
  for (int t = gw; t < nrows; t += nw) {
    const float* xr = in + (size_t)t * 1024;
    f32x4 v[4]; float ss = 0.f;
#pragma unroll
    for (int i = 0; i < 4; ++i) { v[i] = *(const f32x4*)(xr + 256 * i + 4 * lane); ss += v[i][0] * v[i][0] + v[i][1] * v[i][1] + v[i][2] * v[i][2] + v[i][3] * v[i][3]; }
    ss = wave_sum(ss);
    const float rstd = rsqrtf(ss * (1.0f / 1024.0f) + EPS);
#pragma unroll
    for (int i = 0; i < 4; ++i) {
      const f32x4 g = *(const f32x4*)(gain + 256 * i + 4 * lane);
      u32x2 w = {pk2(v[i][0] * rstd * g[0], v[i][1] * rstd * g[1]), pk2(v[i][2] * rstd * g[2], v[i][3] * rstd * g[3])};
      *(u32x2*)(out + (size_t)t * 1024 + 256 * i + 4 * lane) = w;
    }
  }
}

DI void norm_rows_bf16(const bf16_t* in, const float* gain, bf16_t* out, int nrows) {
  const int lane = threadIdx.x & 63, gw = (blockIdx.x * NTHREADS + threadIdx.x) >> 6, nw = gridDim.x * (NTHREADS / 64);
  for (int t = gw; t < nrows; t += nw) {
    const bf16_t* xr = in + (size_t)t * 1024 + 8 * lane;
    float v[16]; float ss = 0.f;
#pragma unroll
    for (int i = 0; i < 2; ++i) { const u32x4 w = *(const u32x4*)(xr + 512 * i);
#pragma unroll
      for (int j = 0; j < 4; ++j) { v[8 * i + 2 * j] = bflo(w[j]); v[8 * i + 2 * j + 1] = bfhi(w[j]); } }
#pragma unroll
    for (int j = 0; j < 16; ++j) ss += v[j] * v[j];
    ss = wave_sum(ss);
    const float rstd = rsqrtf(ss * (1.0f / 1024.0f) + EPS);
#pragma unroll
    for (int i = 0; i < 2; ++i) {
      const f32x4 g0 = *(const f32x4*)(gain + 512 * i + 8 * lane), g1 = *(const f32x4*)(gain + 512 * i + 8 * lane + 4);
      *(u32x4*)(out + (size_t)t * 1024 + 512 * i + 8 * lane) = u32x4{pk2(v[8 * i] * rstd * g0[0], v[8 * i + 1] * rstd * g0[1]), pk2(v[8 * i + 2] * rstd * g0[2], v[8 * i + 3] * rstd * g0[3]),
                                                                    pk2(v[8 * i + 4] * rstd * g1[0], v[8 * i + 5] * rstd * g1[1]), pk2(v[8 * i + 6] * rstd * g1[2], v[8 * i + 7] * rstd * g1[3])};
    }
  }
}

DI void latent_pass(const Params& p, char* smem) {
  const int tid = threadIdx.x, lane = tid & 63, wid = __builtin_amdgcn_readfirstlane(tid >> 6);
  unsigned char* st = (unsigned char*)smem;
  for (int tile = blockIdx.x; tile < T / 64; tile += gridDim.x) {
#pragma unroll 2
    for (int i = 0; i < 8; ++i) {
      const int tk = wid * 8 + i, t = tile * 64 + tk;
      const bf16_t* lr = p.lat + (size_t)t * 448;
      const u32x2 cq = *(const u32x2*)(lr + 4 * lane);
      const float q0 = bflo(cq[0]), q1 = bfhi(cq[0]), q2 = bflo(cq[1]), q3 = bfhi(cq[1]);
      const float ssq = wave_sum(q0 * q0 + q1 * q1 + q2 * q2 + q3 * q3);
      const float rq = rsqrtf(ssq * (1.0f / 256.0f) + EPS);
      const f32x4 gq = *(const f32x4*)(p.q_a_norm + 4 * lane);
      *(u32x2*)(p.cqn + (size_t)t * 256 + 4 * lane) = u32x2{pk2(q0 * rq * gq[0], q1 * rq * gq[1]), pk2(q2 * rq * gq[2], q3 * rq * gq[3])};
      const unsigned ck = *(const unsigned*)(lr + 256 + 2 * lane);
      const float k0 = bflo(ck), k1 = bfhi(ck);
      const float ssk = wave_sum(k0 * k0 + k1 * k1);
      const float rk = rsqrtf(ssk * (1.0f / 128.0f) + EPS);
      const f32x2 gk = *(const f32x2*)(p.kv_a_norm + 2 * lane);
      const float kn0 = k0 * rk * gk[0], kn1 = k1 * rk * gk[1];
      unsigned char* k8r = p.k8 + (size_t)t * 192;
      *(unsigned short*)(k8r + 2 * lane) = (unsigned short)__builtin_amdgcn_cvt_pk_fp8_f32(kn0 * 0.125f, kn1 * 0.125f, 0, false);
      *(unsigned short*)(st + tk * 128 + 2 * lane) = (unsigned short)__builtin_amdgcn_cvt_pk_fp8_f32(kn0, kn1, 0, false);
      if (lane < 32) {
        const float x1 = bf2f(lr[384 + lane]), x2 = bf2f(lr[416 + lane]);
        const f32x2 cs = *(const f32x2*)(p.rope + (size_t)t * 64 + 2 * lane);
        const float r1 = x1 * cs[0] - x2 * cs[1], r2 = x2 * cs[0] + x1 * cs[1];
        const int pk = __builtin_amdgcn_cvt_pk_fp8_f32(r1 * 0.125f, r2 * 0.125f, 0, false);
        k8r[128 + lane] = (unsigned char)(pk & 0xff); k8r[160 + lane] = (unsigned char)((pk >> 8) & 0xff);
      }
    }
    __syncthreads();
    {
      const int d = tid >> 2, part = tid & 3, k0 = 32 * (part >> 1) + 4 * (part & 1);
      unsigned w[4];
#pragma unroll
      for (int c = 0; c < 4; ++c) {
        unsigned v = 0;
#pragma unroll
        for (int e = 0; e < 4; ++e) v |= (unsigned)st[(k0 + e + 8 * c) * 128 + d] << (8 * e);
        w[c] = v;
      }
      const int t0 = tile * 64, b = t0 / SEQ, s0 = t0 - b * SEQ;
      *(u32x4*)(p.vt8 + ((size_t)b * 128 + d) * SEQ + s0 + 16 * part) = u32x4{w[0], w[1], w[2], w[3]};
    }
    __syncthreads();
  }
}

DI void mix_pass(const Params& p) {
  const int lane = threadIdx.x & 63, gw = (blockIdx.x * NTHREADS + threadIdx.x) >> 6, nw = gridDim.x * (NTHREADS / 64);
  for (int t = gw; t < T; t += nw) {
#pragma unroll
    for (int part = 0; part < 2; ++part) {
      const bf16_t* src = (part ? p.ob : p.oa) + (size_t)t * 512 + 8 * lane;
      const float* g = (part ? p.out_norm_swa : p.out_norm_mla) + 8 * lane;
      const u32x4 w = *(const u32x4*)src;
      float v[8] = {bflo(w[0]), bfhi(w[0]), bflo(w[1]), bfhi(w[1]), bflo(w[2]), bfhi(w[2]), bflo(w[3]), bfhi(w[3])};
      float ss = 0.f;
#pragma unroll
      for (int j = 0; j < 8; ++j) ss += v[j] * v[j];
      ss = wave_sum(ss);
      const float rs = rsqrtf(ss * (1.0f / 512.0f) + EPS);
      const f32x4 g0 = *(const f32x4*)g, g1 = *(const f32x4*)(g + 4);
      u32x4 o = {pk2(v[0] * rs * g0[0], v[1] * rs * g0[1]), pk2(v[2] * rs * g0[2], v[3] * rs * g0[3]), pk2(v[4] * rs * g1[0], v[5] * rs * g1[1]), pk2(v[6] * rs * g1[2], v[7] * rs * g1[3])};
      *(u32x4*)(p.xn + (size_t)t * 1024 + part * 512 + 8 * lane) = o;
    }
  }
}

DI float gelu_exact(float x) { return 0.5f * x * (1.0f + erff(x * 0.70710678118654752f)); }
DI float wave_max(float v) {
#pragma unroll
  for (int o = 32; o >= 1; o >>= 1) v = fmaxf(v, __shfl_xor(v, o));
  return v;
}
DI void peer_pass(const Params& p, float* outbuf, int rowmask) {
  const int lane = threadIdx.x & 63, gw = (blockIdx.x * NTHREADS + threadIdx.x) >> 6, nw = gridDim.x * (NTHREADS / 64);
  const int b5 = (lane >> 5) & 1, b4 = (lane >> 4) & 1, b3 = (lane >> 3) & 1, b2 = (lane >> 2) & 1, kL = (lane >> 2) & 15;
  for (int t = gw; t < T; t += nw) {
    const bf16_t* hr = p.xn + (size_t)t * 1024 + 16 * lane;
    const u32x4 ha = *(const u32x4*)hr, hb = *(const u32x4*)(hr + 8);
    float hv[16];
#pragma unroll
    for (int j = 0; j < 4; ++j) { const unsigned wa = ha[j], wb = hb[j]; hv[2 * j] = bflo(wa); hv[2 * j + 1] = bfhi(wa); hv[8 + 2 * j] = bflo(wb); hv[8 + 2 * j + 1] = bfhi(wb); }
    float hm = 0.f;
#pragma unroll
    for (int j = 0; j < 16; ++j) hm = fmaxf(hm, fabsf(hv[j]));
    hm = fmaxf(wave_max(hm), 1e-20f);
    const float sh = hm * (1.0f / 127.0f), ih = 127.0f / hm;
    int hq[4];
#pragma unroll
    for (int q = 0; q < 4; ++q) {
      const int q0 = (int)rintf(hv[4 * q] * ih), q1 = (int)rintf(hv[4 * q + 1] * ih), q2 = (int)rintf(hv[4 * q + 2] * ih), q3 = (int)rintf(hv[4 * q + 3] * ih);
      hq[q] = (q0 & 255) | ((q1 & 255) << 8) | ((q2 & 255) << 16) | (q3 << 24);
    }
    const int e0 = p.pidx[(size_t)t * 128 + lane], e1 = p.pidx[(size_t)t * 128 + 64 + lane];
    const float su0 = p.su[2 * e0] * sh, su1 = p.su[2 * e1] * sh;
    const float gv0 = p.pg[(size_t)t * 128 + lane] * p.su[2 * e0 + 1], gv1 = p.pg[(size_t)t * 128 + 64 + lane] * p.su[2 * e1 + 1];
    float acc[16];
#pragma unroll
    for (int j = 0; j < 16; ++j) acc[j] = 0.f;
    float csum = 0.f;
#pragma unroll 1
    for (int hd = 0; hd < 8; ++hd) {
      const int esel = (hd < 4) ? e0 : e1;
      const int lbase = (hd & 3) * 16;
      u32x4 ub[16], vb[16];
#pragma unroll
      for (int k = 0; k < 16; ++k) {
        const int idx = __builtin_amdgcn_readlane(esel, lbase + k);
        ub[k] = *(const u32x4*)(p.u_q + (size_t)idx * 1024 + 16 * lane);
        vb[k] = *(const u32x4*)(p.v_q + (size_t)idx * 1024 + 16 * lane);
      }
      int pd[16];
#pragma unroll
      for (int k = 0; k < 16; ++k) {
        int d = 0;
#pragma unroll
        for (int q = 0; q < 4; ++q) { const int a = (int)ub[k][q]; d = __builtin_amdgcn_sdot4(a, hq[q], d, false); }
        pd[k] = d;
      }
      int q8[8], q4[4], q2[2], q1;
#pragma unroll
      for (int k = 0; k < 8; ++k) { const int keep = b5 ? pd[k + 8] : pd[k], send = b5 ? pd[k] : pd[k + 8]; q8[k] = keep + __shfl_xor(send, 32); }
#pragma unroll
      for (int k = 0; k < 4; ++k) { const int keep = b4 ? q8[k + 4] : q8[k], send = b4 ? q8[k] : q8[k + 4]; q4[k] = keep + __shfl_xor(send, 16); }
#pragma unroll
      for (int k = 0; k < 2; ++k) { const int keep = b3 ? q4[k + 2] : q4[k], send = b3 ? q4[k] : q4[k + 2]; q2[k] = keep + __shfl_xor(send, 8); }
      { const int keep = b2 ? q2[1] : q2[0], send = b2 ? q2[0] : q2[1]; q1 = keep + __shfl_xor(send, 4); }
      q1 += __shfl_xor(q1, 2); q1 += __shfl_xor(q1, 1);
      const float suk = __shfl((hd < 4) ? su0 : su1, lbase + kL), gvk = __shfl((hd < 4) ? gv0 : gv1, lbase + kL);
      const float dtot = (float)q1 * suk;
      const float c = DBG_PEER * gvk * gelu_exact(dtot);
#pragma unroll
      for (int k = 0; k < 16; ++k) {
        const float ck = __uint_as_float(__builtin_amdgcn_readlane(__float_as_uint(c), 4 * k));
        csum += ck;
#pragma unroll
        for (int q = 0; q < 4; ++q) {
          const unsigned w = vb[k][q];
          acc[4 * q] += ck * (float)(w & 0xff); acc[4 * q + 1] += ck * (float)((w >> 8) & 0xff); acc[4 * q + 2] += ck * (float)((w >> 16) & 0xff); acc[4 * q + 3] += ck * (float)(w >> 24);
        }
      }
    }
    const float* xr = p.X + (size_t)t * 1024 + 16 * lane; float* orow = outbuf + (size_t)(t & rowmask) * 1024 + 16 * lane;
    float y[16]; float ss = 0.f;
#pragma unroll
    for (int q = 0; q < 4; ++q) {
      const f32x4 xv = *(const f32x4*)(xr + 4 * q);
#pragma unroll
      for (int j = 0; j < 4; ++j) { const float v = xv[j] + (acc[4 * q + j] - 128.0f * csum); y[4 * q + j] = v; ss += v * v; }
    }
    ss = wave_sum(ss);
    const float rstd = rsqrtf(ss * (1.0f / 1024.0f) + EPS);
#pragma unroll
    for (int q = 0; q < 4; ++q) {
      const f32x4 g = *(const f32x4*)(p.norm_final + 16 * lane + 4 * q);
      f32x4 ov;
#pragma unroll
      for (int j = 0; j < 4; ++j) ov[j] = y[4 * q + j] * rstd * g[j];
      *(f32x4*)(orow + 4 * q) = ov;
    }
  }
}

DI void norm_rows_ffn(const Params& p) {
  const int lane = threadIdx.x & 63, gw = (blockIdx.x * NTHREADS + threadIdx.x) >> 6, nw = gridDim.x * (NTHREADS / 64);
  for (int t = gw; t < T; t += nw) {
    const bf16_t* xr = p.X16 + (size_t)t * 1024;
    f32x4 v[4]; float ss = 0.f;
#pragma unroll
    for (int i = 0; i < 4; ++i) { const u32x2 w = *(const u32x2*)(xr + 256 * i + 4 * lane); v[i] = f32x4{bflo(w[0]), bfhi(w[0]), bflo(w[1]), bfhi(w[1])};
      ss += v[i][0] * v[i][0] + v[i][1] * v[i][1] + v[i][2] * v[i][2] + v[i][3] * v[i][3]; }
    ss = wave_sum(ss);
    const float rstd = rsqrtf(ss * (1.0f / 1024.0f) + EPS);
    float hm = 0.f;
#pragma unroll
    for (int i = 0; i < 4; ++i) {
      const f32x4 g = *(const f32x4*)(p.norm_ffn + 256 * i + 4 * lane);
#pragma unroll
      for (int j = 0; j < 4; ++j) { v[i][j] = v[i][j] * rstd * g[j]; hm = fmaxf(hm, fabsf(v[i][j])); }
      *(u32x2*)(p.xn + (size_t)t * 1024 + 256 * i + 4 * lane) = u32x2{pk2(v[i][0], v[i][1]), pk2(v[i][2], v[i][3])};
    }
    hm = fmaxf(wave_max(hm), 1e-20f);
    const float ih = 127.0f / hm;
#pragma unroll
    for (int i = 0; i < 4; ++i) {
      const int q0 = (int)rintf(v[i][0] * ih), q1 = (int)rintf(v[i][1] * ih), q2 = (int)rintf(v[i][2] * ih), q3 = (int)rintf(v[i][3] * ih);
      *(unsigned*)(p.hq + (size_t)t * 1024 + 256 * i + 4 * lane) = (unsigned)(q0 & 255) | ((unsigned)(q1 & 255) << 8) | ((unsigned)(q2 & 255) << 16) | ((unsigned)q3 << 24);
    }
    if (lane == 0) p.sh[t] = hm * (1.0f / 127.0f);
  }
}
DI void peer_dots(const Params& p) {
  const int lane = threadIdx.x & 63, wid = threadIdx.x >> 6, xs = (blockIdx.x & 7) >> 1, r = lane >> 3, ch = lane & 7;
  const int wp = ((blockIdx.x >> 3) * 2 + (blockIdx.x & 1)) * (NTHREADS / 64) + wid, nwp = (gridDim.x >> 2) * (NTHREADS / 64);
  const int b0 = lane & 1, b1 = (lane >> 1) & 1, b2 = (lane >> 2) & 1;
  int* dp = p.dpartA + (size_t)xs * T * 128;
  const unsigned char* ub = p.u_q + 128 * xs + 16 * ch;
  typedef int i32x2 __attribute__((ext_vector_type(2)));
  i32x4 iv[4]; u32x4 hlo, hhi;
  if (wp < T) {
    const int* ip = p.pidx + (size_t)wp * 128 + 16 * r;
#pragma unroll
    for (int q = 0; q < 4; ++q) iv[q] = *(const i32x4*)(ip + 4 * q);
    const unsigned char* hp = p.hq + (size_t)wp * 1024 + 256 * xs + 32 * ch;
    hlo = *(const u32x4*)hp; hhi = *(const u32x4*)(hp + 16);
  }
  for (int t = wp; t < T; t += nwp) {
    u32x4 uv[16];
#pragma unroll
    for (int g = 0; g < 16; ++g) uv[g] = *(const u32x4*)(ub + (size_t)iv[g >> 2][g & 3] * 512);
    int hl[4], hh[4];
#pragma unroll
    for (int q = 0; q < 4; ++q) { hl[q] = (int)hlo[q]; hh[q] = (int)hhi[q]; }
    int hsum = 0;
#pragma unroll
    for (int q = 0; q < 4; ++q) { hsum = __builtin_amdgcn_sdot4(hl[q], 0x01010101, hsum, false); hsum = __builtin_amdgcn_sdot4(hh[q], 0x01010101, hsum, false); }
    const int tn = (t + nwp < T) ? t + nwp : t;
    {
      const int* ip = p.pidx + (size_t)tn * 128 + 16 * r;
#pragma unroll
      for (int q = 0; q < 4; ++q) iv[q] = *(const i32x4*)(ip + 4 * q);
      const unsigned char* hp = p.hq + (size_t)tn * 1024 + 256 * xs + 32 * ch;
      hlo = *(const u32x4*)hp; hhi = *(const u32x4*)(hp + 16);
    }
    int v[16];
#pragma unroll
    for (int g = 0; g < 16; ++g) {
      int d = -8 * hsum;
#pragma unroll
      for (int q = 0; q < 4; ++q) {
        const unsigned w = uv[g][q]; const int lo = (int)(w & 0x0F0F0F0Fu), hi = (int)((w >> 4) & 0x0F0F0F0Fu);
        d = __builtin_amdgcn_sdot4(lo, hl[q], d, false); d = __builtin_amdgcn_sdot4(hi, hh[q], d, false);
      }
      v[g] = d;
    }
    int w8[8], w4[4], w2[2];
#pragma unroll
    for (int k = 0; k < 8; ++k) { const int keep = b2 ? v[k + 8] : v[k], send = b2 ? v[k] : v[k + 8]; w8[k] = keep + __shfl_xor(send, 4); }
#pragma unroll
    for (int k = 0; k < 4; ++k) { const int keep = b1 ? w8[k + 4] : w8[k], send = b1 ? w8[k] : w8[k + 4]; w4[k] = keep + __shfl_xor(send, 2); }
#pragma unroll
    for (int k = 0; k < 2; ++k) { const int keep = b0 ? w4[k + 2] : w4[k], send = b0 ? w4[k] : w4[k + 2]; w2[k] = keep + __shfl_xor(send, 1); }
    *(i32x2*)(dp + (size_t)t * 128 + 16 * r + 2 * ch) = i32x2{w2[0], w2[1]};
  }
}
DI void peer_coef(const Params& p) {
  const size_t n = (size_t)T * 128;
  for (size_t it = (size_t)blockIdx.x * NTHREADS + threadIdx.x; it < n; it += (size_t)gridDim.x * NTHREADS) {
    int d = 0;
#pragma unroll
    for (int x = 0; x < 4; ++x) d += p.dpartA[(size_t)x * n + it];
    const int e = p.pidx[it];
    const f32x2 sc2 = *(const f32x2*)(p.su + 2 * (size_t)e);
    const float dt = (float)d * sc2[0] * p.sh[it >> 7];
    p.cbuf[it] = DBG_PEER * p.pg[it] * gelu_exact(dt) * sc2[1];
  }
}
DI void peer_accum(const Params& p, bf16_t* Xout, int rowmask) {
  const int lane = threadIdx.x & 63, wid = threadIdx.x >> 6, xs = (blockIdx.x & 7) >> 1, r = lane >> 3, ch = lane & 7;
  const int wp = ((blockIdx.x >> 3) * 2 + (blockIdx.x & 1)) * (NTHREADS / 64) + wid, nwp = (gridDim.x >> 2) * (NTHREADS / 64);
  const int b3 = (lane >> 3) & 1, b4 = (lane >> 4) & 1, b5 = (lane >> 5) & 1;
  const unsigned char* vbp = p.v_q + 128 * xs + 16 * ch;
  const size_t xoff = (size_t)256 * xs + 32 * ch + 4 * r;
  if (wp >= T) return;
  i32x4 ivA[2], ivB[2]; f32x4 cvA[4], cvN[4]; i32x4 ivN[4];
  u32x4 ra[8], rb[8];
  u32x2 xv, xvN;
#define LOAD_META(tt, IV, CV) do { const int* ip_ = p.pidx + (size_t)(tt) * 128 + 16 * r; const float* cp_ = p.cbuf + (size_t)(tt) * 128 + 16 * r; \
    _Pragma("unroll") for (int q_ = 0; q_ < 4; ++q_) { IV[q_] = *(const i32x4*)(ip_ + 4 * q_); CV[q_] = *(const f32x4*)(cp_ + 4 * q_); } } while (0)
#define LOAD_ROWS(R, I0, I1) do { _Pragma("unroll") for (int g_ = 0; g_ < 4; ++g_) { R[g_] = *(const u32x4*)(vbp + (size_t)I0[g_] * 512); R[4 + g_] = *(const u32x4*)(vbp + (size_t)I1[g_] * 512); } } while (0)
#define ACCUM(R, C0, C1) do { _Pragma("unroll") for (int g_ = 0; g_ < 8; ++g_) { const float cg_ = (g_ < 4) ? C0[g_ & 3] : C1[g_ & 3]; const f32x2 cgv_ = {cg_, cg_}; \
    _Pragma("unroll") for (int q_ = 0; q_ < 4; ++q_) { const unsigned w_ = R[g_][q_]; \
      acc2[4 * q_] += cgv_ * __builtin_amdgcn_cvt_scalef32_pk_f32_fp4(w_, 1.0f, 0); acc2[4 * q_ + 1] += cgv_ * __builtin_amdgcn_cvt_scalef32_pk_f32_fp4(w_, 1.0f, 1); \
      acc2[4 * q_ + 2] += cgv_ * __builtin_amdgcn_cvt_scalef32_pk_f32_fp4(w_, 1.0f, 2); acc2[4 * q_ + 3] += cgv_ * __builtin_amdgcn_cvt_scalef32_pk_f32_fp4(w_, 1.0f, 3); } \
    SBAR(); } } while (0)
  LOAD_META(wp, ivN, cvN);
  ivA[0] = ivN[0]; ivA[1] = ivN[1]; ivB[0] = ivN[2]; ivB[1] = ivN[3];
#pragma unroll
  for (int q = 0; q < 4; ++q) cvA[q] = cvN[q];
  LOAD_ROWS(ra, ivA[0], ivA[1]);
  xv = *(const u32x2*)(p.X16 + (size_t)wp * 1024 + xoff);
  for (int t = wp; t < T; t += nwp) {
    const int tn = (t + nwp < T) ? t + nwp : t;
    f32x2 acc2[16];
#pragma unroll
    for (int j = 0; j < 16; ++j) acc2[j] = f32x2{0.f, 0.f};
    LOAD_ROWS(rb, ivB[0], ivB[1]);
    LOAD_META(tn, ivN, cvN);
    xvN = *(const u32x2*)(p.X16 + (size_t)tn * 1024 + xoff);
    ACCUM(ra, cvA[0], cvA[1]);
    ivA[0] = ivN[0]; ivA[1] = ivN[1]; ivB[0] = ivN[2]; ivB[1] = ivN[3];
    LOAD_ROWS(ra, ivA[0], ivA[1]);
    ACCUM(rb, cvA[2], cvA[3]);
#pragma unroll
    for (int q = 0; q < 4; ++q) cvA[q] = cvN[q];
    float acc[32];
#pragma unroll
    for (int j = 0; j < 16; ++j) { acc[2 * j] = acc2[j][0]; acc[2 * j + 1] = acc2[j][1]; }
    float w16[16], w8[8], w4[4];
#pragma unroll
    for (int k = 0; k < 16; ++k) { const float keep = b5 ? acc[k + 16] : acc[k], send = b5 ? acc[k] : acc[k + 16]; w16[k] = keep + __shfl_xor(send, 32); }
#pragma unroll
    for (int k = 0; k < 8; ++k) { const float keep = b4 ? w16[k + 8] : w16[k], send = b4 ? w16[k] : w16[k + 8]; w8[k] = keep + __shfl_xor(send, 16); }
#pragma unroll
    for (int k = 0; k < 4; ++k) { const float keep = b3 ? w8[k + 4] : w8[k], send = b3 ? w8[k] : w8[k + 4]; w4[k] = keep + __shfl_xor(send, 8); }
    *(u32x2*)(Xout + (size_t)(t & rowmask) * 1024 + xoff) = u32x2{pk2(bflo(xv[0]) + w4[0], bfhi(xv[0]) + w4[1]), pk2(bflo(xv[1]) + w4[2], bfhi(xv[1]) + w4[3])};
    xv = xvN;
  }
#undef LOAD_META
#undef LOAD_ROWS
#undef ACCUM
}
DI void final_norm(const Params& p) {
  const int lane = threadIdx.x & 63, gw = (blockIdx.x * NTHREADS + threadIdx.x) >> 6, nw = gridDim.x * (NTHREADS / 64);
  for (int t = gw; t < T; t += nw) {
    const bf16_t* xr = p.X16 + (size_t)t * 1024;
    f32x4 v[4]; float ss = 0.f;
#pragma unroll
    for (int i = 0; i < 4; ++i) { const u32x2 w = *(const u32x2*)(xr + 256 * i + 4 * lane); v[i] = f32x4{bflo(w[0]), bfhi(w[0]), bflo(w[1]), bfhi(w[1])};
      ss += v[i][0] * v[i][0] + v[i][1] * v[i][1] + v[i][2] * v[i][2] + v[i][3] * v[i][3]; }
    ss = wave_sum(ss);
    const float rstd = rsqrtf(ss * (1.0f / 1024.0f) + EPS);
    float* orow = p.X + (size_t)t * 1024;
#pragma unroll
    for (int i = 0; i < 4; ++i) {
      const f32x4 g = *(const f32x4*)(p.norm_final + 256 * i + 4 * lane);
      *(f32x4*)(orow + 256 * i + 4 * lane) = f32x4{v[i][0] * rstd * g[0], v[i][1] * rstd * g[1], v[i][2] * rstd * g[2], v[i][3] * rstd * g[3]};
    }
  }
}

DI void quant_fp8(const float* src, unsigned char* dst, size_t n4) {
  for (size_t i = (size_t)blockIdx.x * NTHREADS + threadIdx.x; i < n4; i += (size_t)gridDim.x * NTHREADS) {
    const f32x4 v = *(const f32x4*)(src + i * 4);
    int pk = 0;
    pk = __builtin_amdgcn_cvt_pk_fp8_f32(v[0] * V_FP8_SCALE, v[1] * V_FP8_SCALE, pk, false);
    pk = __builtin_amdgcn_cvt_pk_fp8_f32(v[2] * V_FP8_SCALE, v[3] * V_FP8_SCALE, pk, true);
    *(unsigned*)(dst + i * 4) = (unsigned)pk;
  }
}
DI void quant_u4(const float* src, unsigned char* dst, float* scale, int nrows) {
  const int lane = threadIdx.x & 63, gw = (blockIdx.x * NTHREADS + threadIdx.x) >> 6, nw = gridDim.x * (NTHREADS / 64);
  const int c = lane >> 1, hf = lane & 1;
  for (int r = gw; r < nrows; r += nw) {
    const float* xr = src + (size_t)r * 1024 + 32 * c + 8 * hf;
    const f32x4 a0 = *(const f32x4*)xr, a1 = *(const f32x4*)(xr + 4), b0 = *(const f32x4*)(xr + 16), b1 = *(const f32x4*)(xr + 20);
    float ss = 0.f;
#pragma unroll
    for (int j = 0; j < 4; ++j) ss += a0[j] * a0[j] + a1[j] * a1[j] + b0[j] * b0[j] + b1[j] * b1[j];
    ss = wave_sum(ss);
    const float sc = fmaxf(2.45f * sqrtf(ss * (1.0f / 1024.0f)) * (1.0f / 7.0f), 1e-30f), inv = 1.0f / sc;
    unsigned w[2];
#pragma unroll
    for (int q = 0; q < 2; ++q) {
      const f32x4 lo = q ? a1 : a0, hi = q ? b1 : b0;
      unsigned ww = 0;
#pragma unroll
      for (int j = 0; j < 4; ++j) {
        const int ql = (int)fminf(fmaxf(rintf(lo[j] * inv), -7.f), 7.f) + 8, qh = (int)fminf(fmaxf(rintf(hi[j] * inv), -7.f), 7.f) + 8;
        ww |= (unsigned)(ql | (qh << 4)) << (8 * j);
      }
      w[q] = ww;
    }
    *(u32x2*)(dst + (size_t)r * 512 + 16 * c + 8 * hf) = u32x2{w[0], w[1]};
    if (lane == 0) scale[2 * r] = sc;
  }
}
DI void quant_v4(const float* src, unsigned char* dst, float* scale, int nrows) {
  const int lane = threadIdx.x & 63, gw = (blockIdx.x * NTHREADS + threadIdx.x) >> 6, nw = gridDim.x * (NTHREADS / 64);
  for (int r = gw; r < nrows; r += nw) {
    const float* xr = src + (size_t)r * 1024 + 16 * lane;
    f32x4 a[4]; float ss = 0.f;
#pragma unroll
    for (int q = 0; q < 4; ++q) { a[q] = *(const f32x4*)(xr + 4 * q); ss += a[q][0] * a[q][0] + a[q][1] * a[q][1] + a[q][2] * a[q][2] + a[q][3] * a[q][3]; }
    ss = wave_sum(ss);
    const float sc = fmaxf(sqrtf(ss * (1.0f / 1024.0f)) * (1.0f / 2.1f), 1e-30f), inv = 1.0f / sc;
    unsigned w0 = 0, w1 = 0;
    w0 = __builtin_amdgcn_cvt_scalef32_pk_fp4_f32(w0, a[0][0] * inv, a[0][1] * inv, 1.0f, 0);
    w0 = __builtin_amdgcn_cvt_scalef32_pk_fp4_f32(w0, a[0][2] * inv, a[0][3] * inv, 1.0f, 1);
    w0 = __builtin_amdgcn_cvt_scalef32_pk_fp4_f32(w0, a[1][0] * inv, a[1][1] * inv, 1.0f, 2);
    w0 = __builtin_amdgcn_cvt_scalef32_pk_fp4_f32(w0, a[1][2] * inv, a[1][3] * inv, 1.0f, 3);
    w1 = __builtin_amdgcn_cvt_scalef32_pk_fp4_f32(w1, a[2][0] * inv, a[2][1] * inv, 1.0f, 0);
    w1 = __builtin_amdgcn_cvt_scalef32_pk_fp4_f32(w1, a[2][2] * inv, a[2][3] * inv, 1.0f, 1);
    w1 = __builtin_amdgcn_cvt_scalef32_pk_fp4_f32(w1, a[3][0] * inv, a[3][1] * inv, 1.0f, 2);
    w1 = __builtin_amdgcn_cvt_scalef32_pk_fp4_f32(w1, a[3][2] * inv, a[3][3] * inv, 1.0f, 3);
    *(u32x2*)(dst + (size_t)r * 512 + 8 * lane) = u32x2{w0, w1};
    if (lane == 0) scale[2 * r] = sc;
  }
}
template <bool OFFS>
DI void quant_rows(const float* src, unsigned char* dst, float* scale, int nrows) {
  const int lane = threadIdx.x & 63, gw = (blockIdx.x * NTHREADS + threadIdx.x) >> 6, nw = gridDim.x * (NTHREADS / 64);
  for (int r = gw; r < nrows; r += nw) {
    const float* xr = src + (size_t)r * 1024 + 4 * lane;
    f32x4 v[4]; float m = 0.f;
#pragma unroll
    for (int q = 0; q < 4; ++q) { v[q] = *(const f32x4*)(xr + 256 * q); m = fmaxf(m, fmaxf(fmaxf(fabsf(v[q][0]), fabsf(v[q][1])), fmaxf(fabsf(v[q][2]), fabsf(v[q][3])))); }
    m = fmaxf(wave_max(m), 1e-30f);
    const float inv = 127.0f / m;
#pragma unroll
    for (int q = 0; q < 4; ++q) {
      int a0 = (int)rintf(v[q][0] * inv), a1 = (int)rintf(v[q][1] * inv), a2 = (int)rintf(v[q][2] * inv), a3 = (int)rintf(v[q][3] * inv);
      if (OFFS) { a0 += 128; a1 += 128; a2 += 128; a3 += 128; }
      *(unsigned*)(dst + (size_t)r * 1024 + 4 * lane + 256 * q) = (unsigned)(a0 & 255) | ((unsigned)(a1 & 255) << 8) | ((unsigned)(a2 & 255) << 16) | ((unsigned)a3 << 24);
    }
    if (lane == 0) scale[r] = m * (1.0f / 127.0f);
  }
}

DI void transpose_cvt(const float* W, int ldw, int K, int N, bf16_t* Wt, int ldt, char* smem, int& job, int jobstride) {
  float* tile = (float*)smem;
  const int tk = K / 64, tn = N / 64, total = tk * tn;
  const int tid = threadIdx.x;
  for (; job < total; job += jobstride) {
    const int k0 = (job / tn) * 64, n0 = (job % tn) * 64;
    __syncthreads();
#pragma unroll
    for (int i = 0; i < 8; ++i) { const int e = tid + i * NTHREADS, kk = e >> 6, nn = e & 63; tile[kk * 65 + nn] = W[(size_t)(k0 + kk) * ldw + n0 + nn]; }
    __syncthreads();
#pragma unroll
    for (int i = 0; i < 8; ++i) { const int e = tid + i * NTHREADS, nn = e >> 6, kk = e & 63; Wt[(size_t)(n0 + nn) * ldt + k0 + kk] = f2bf(tile[kk * 65 + nn]); }
  }
  job -= total;
}
DI void cvt_elems(const float* src, bf16_t* dst, size_t n8) {
  for (size_t i = (size_t)blockIdx.x * NTHREADS + threadIdx.x; i < n8; i += (size_t)gridDim.x * NTHREADS) {
    const f32x4 a = *(const f32x4*)(src + i * 8), b = *(const f32x4*)(src + i * 8 + 4);
    *(u32x4*)(dst + i * 8) = u32x4{pk2(a[0], a[1]), pk2(a[2], a[3]), pk2(b[0], b[1]), pk2(b[2], b[3])};
  }
}
DI void prep_phase(const Params& p, char* smem) {
  int job = blockIdx.x; const int js = gridDim.x;
  transpose_cvt(p.w_in, IN_COLS, 1024, IN_COLS, p.wt_in, 1024, smem, job, js);
  transpose_cvt(p.w_out, 1024, 1024, 1024, p.wt_out, 1024, smem, job, js);
  transpose_cvt(p.w_cq, 512, 1024, 512, p.wt_cq, 1024, smem, job, js);
  transpose_cvt(p.w_ck, 512, 1024, 512, p.wt_ckv, 1024, smem, job, js);
  transpose_cvt(p.w_cv, 512, 1024, 512, p.wt_ckv + (size_t)512 * 1024, 1024, smem, job, js);
  transpose_cvt(p.w_co, 1024, 512, 1024, p.wt_co, 512, smem, job, js);
  for (int h = 0; h < 4; ++h) transpose_cvt(p.w_kv_b + h * 256 + 128, 1024, 128, 128, p.wt_uv + (size_t)h * 128 * 128, 128, smem, job, js);
  __syncthreads();
  const size_t gtid = (size_t)blockIdx.x * NTHREADS + threadIdx.x, gn = (size_t)gridDim.x * NTHREADS;
  for (size_t i = gtid; i < (size_t)64 * 1024 / 8; i += gn) *(u32x4*)(p.wt_in + (size_t)IN_COLS * 1024 + i * 8) = u32x4{0, 0, 0, 0};
  for (size_t i = gtid; i < (size_t)768 * 256; i += gn) {
    const int n = (int)(i >> 8), k = (int)(i & 255), h = n / 192, j = n - h * 192;
    float v;
    if (j < 128) {
      const float* a = p.w_q_b + (size_t)k * 768 + h * 192; const float* b = p.w_kv_b + (size_t)j * 1024 + h * 256;
      float s = 0.f;
      for (int d = 0; d < 128; d += 4) { const f32x4 av = *(const f32x4*)(a + d), bv = *(const f32x4*)(b + d); s += av[0] * bv[0] + av[1] * bv[1] + av[2] * bv[2] + av[3] * bv[3]; }
      v = s;
    } else v = p.w_q_b[(size_t)k * 768 + n];
    p.wt_qc[i] = f2bf(v);
  }
  cvt_elems(p.peer_w_q, p.a_pq, (size_t)1024 * 2048 / 8);
  cvt_elems(p.peer_keys, p.keys_bf, (size_t)2048 * 128 / 8);
  quant_u4(p.peer_u, p.u_q, p.su, 16384);
  quant_v4(p.peer_v, p.v_q, p.su + 1, 16384);
  for (size_t i = gtid; i < (size_t)T * 32; i += gn) {
    const int t = (int)(i >> 5), ii = (int)(i & 31);
    const float inv = exp2f(-(float)ii * (13.287712379549449f / 32.0f));
    const float ang = (float)p.positions[t] * inv;
    float sn, cs; sincosf(ang, &sn, &cs);
    *(f32x2*)(p.rope + i * 2) = f32x2{cs, sn};
  }
  norm_rows_1024(p.mem, p.norm_mem, p.mn, NB * 256);
  norm_rows_1024(p.x, p.norm_mix, p.xn, T);
}

struct KArgs { const void* in[25]; float* out; char* ws; };
__host__ __device__ __forceinline__ size_t align_up(size_t v) { return (v + 255) & ~(size_t)255; }
__host__ __device__ __forceinline__ Params build_params(const KArgs& k, size_t* total) {
  Params p{};
  p.x = (const float*)k.in[0]; p.mem = (const float*)k.in[1]; p.positions = (const int*)k.in[2]; p.norm_mix = (const float*)k.in[3]; p.w_in = (const float*)k.in[4];
  p.q_a_norm = (const float*)k.in[5]; p.w_q_b = (const float*)k.in[6]; p.kv_a_norm = (const float*)k.in[7]; p.w_kv_b = (const float*)k.in[8]; p.swa_sinks = (const float*)k.in[9];
  p.out_norm_mla = (const float*)k.in[10]; p.out_norm_swa = (const float*)k.in[11]; p.w_out = (const float*)k.in[12]; p.norm_cross = (const float*)k.in[13]; p.norm_mem = (const float*)k.in[14];
  p.w_cq = (const float*)k.in[15]; p.w_ck = (const float*)k.in[16]; p.w_cv = (const float*)k.in[17]; p.w_co = (const float*)k.in[18]; p.norm_ffn = (const float*)k.in[19];
  p.peer_w_q = (const float*)k.in[20]; p.peer_keys = (const float*)k.in[21]; p.peer_u = (const float*)k.in[22]; p.peer_v = (const float*)k.in[23]; p.norm_final = (const float*)k.in[24];
  p.X = k.out;
  char* ws = k.ws; size_t off = 0;
#define TAKE(bytes) (ws + ((off += align_up(bytes)) - align_up(bytes)))
  p.wt_in = (bf16_t*)TAKE((size_t)IN_COLS_PAD * 1024 * 2);
  p.wt_qc = (bf16_t*)TAKE((size_t)768 * 256 * 2);
  p.wt_uv = (bf16_t*)TAKE((size_t)512 * 128 * 2);
  p.wt_out = (bf16_t*)TAKE((size_t)1024 * 1024 * 2);
  p.wt_cq = (bf16_t*)TAKE((size_t)512 * 1024 * 2);
  p.wt_ckv = (bf16_t*)TAKE((size_t)1024 * 1024 * 2);
  p.wt_co = (bf16_t*)TAKE((size_t)1024 * 512 * 2);
  p.a_pq = (bf16_t*)TAKE((size_t)1024 * 2048 * 2);
  p.keys_bf = (bf16_t*)TAKE((size_t)2048 * 128 * 2);
  p.wt_sc = (bf16_t*)TAKE((size_t)2048 * 1024 * 2);
  p.bar = (unsigned*)TAKE((size_t)XCD_BAR_WORDS * 4);
  p.u_q = (unsigned char*)TAKE((size_t)16384 * 512);
  p.v_q = (unsigned char*)TAKE((size_t)16384 * 512);
  p.k8 = (unsigned char*)TAKE((size_t)T * 192);
  p.vt8 = (unsigned char*)TAKE((size_t)T * 128);
  p.su = (float*)TAKE((size_t)16384 * 8);
  p.sv = p.su + 1;
  p.mn = (bf16_t*)TAKE((size_t)512 * 1024 * 2);
  p.kvc = (bf16_t*)TAKE((size_t)512 * 1024 * 2);
  p.rope = (float*)TAKE((size_t)T * 64 * 4);
  p.xn = (bf16_t*)TAKE((size_t)T * 1024 * 2);
  const size_t offR = off;
  p.lat = (bf16_t*)TAKE((size_t)T * 448 * 2);
  p.cqn = (bf16_t*)TAKE((size_t)T * 256 * 2);
  p.qcat = (bf16_t*)TAKE((size_t)T * 768 * 2);
  p.kcat = (bf16_t*)TAKE((size_t)T * 192 * 2);
  p.qs = (bf16_t*)TAKE((size_t)T * 512 * 2);
  p.ks = (bf16_t*)TAKE((size_t)T * 128 * 2);
  p.vs = (bf16_t*)TAKE((size_t)T * 128 * 2);
  p.olat = (bf16_t*)TAKE((size_t)T * 512 * 2);
  p.ob = (bf16_t*)TAKE((size_t)T * 512 * 2);
  p.oa = (bf16_t*)TAKE((size_t)T * 512 * 2);
  const size_t offEnd = off;
  off = offR;
  p.qx = (bf16_t*)TAKE((size_t)T * 512 * 2);
  p.ox = (bf16_t*)TAKE((size_t)T * 512 * 2);
  p.top1 = (int*)TAKE((size_t)T * 256 * 4);
  p.pidx = (int*)TAKE((size_t)T * 128 * 4);
  p.pg = (float*)TAKE((size_t)T * 128 * 4);
  p.dpartA = (int*)(ws + offR);
  p.dpartB = (int*)TAKE((size_t)4 * T * 128 * 4);
  p.X16 = (bf16_t*)p.dpartB;
  p.hq = (unsigned char*)TAKE((size_t)T * 1024);
  p.sh = (float*)TAKE((size_t)T * 4);
  p.cbuf = (float*)TAKE((size_t)T * 128 * 4);
#undef TAKE
  if (total) *total = (off > offEnd) ? off : offEnd;
  return p;
}

constexpr int N_PHASES = 19;
template <int PH> DI void run_phase(const Params& p, char* smem) {
  if constexpr (PH == 0) prep_phase(p, smem);
  else if constexpr (PH == 1) {
    g8::run(p.xn, p.wt_in, T, IN_COLS_PAD, DM, g8::EpiInproj{p.lat, p.qs, p.ks, p.vs}, smem);
    { const int G = (int)gridDim.x, n3 = 640 - 2 * G;
      if (n3 > 0 && G - n3 >= 72) {
        if ((int)blockIdx.x >= n3) {
          const int c = (int)blockIdx.x - n3;
          if (c < 8) g8::run_on(p.mn, p.wt_ckv, NB * 256, 1024, DM, g8::EpiBf16{p.kvc, 1024, 1.0f}, smem, c, 8);
          else if (c < 72) gemm_phase(p.a_pq, 2048, 128, p.keys_bf, 128, 1024, 2048, 128, EpiBf16T{p.wt_sc, 1024}, smem, c - 8, 64);
        }
      } else {
        g8::run(p.mn, p.wt_ckv, NB * 256, 1024, DM, g8::EpiBf16{p.kvc, 1024, 1.0f}, smem);
        gemm_phase(p.a_pq, 2048, 128, p.keys_bf, 128, 1024, 2048, 128, EpiBf16T{p.wt_sc, 1024}, smem);
      } }
  }
  else if constexpr (PH == 2) latent_pass(p, smem);
  else if constexpr (PH == 3) g8::run(p.cqn, p.wt_qc, T, 768, 256, g8::EpiBf16{p.qcat, 768, MLA_QSCALE}, smem);
  else if constexpr (PH == 4) { mla_phase(p, smem); swa_phase(p, smem); }
  else if constexpr (PH == 5) gemm_phase(p.olat, 512, 128, p.wt_uv, 128, T, 512, 128, EpiBf16{p.oa, 512, 1.0f}, smem);
  else if constexpr (PH == 6) mix_pass(p);
  else if constexpr (PH == 7) g8::run(p.xn, p.wt_out, T, DM, DM, g8::EpiResid16<true>{p.x, p.X16, DM, DBG_MIX}, smem);
  else if constexpr (PH == 8) norm_rows_bf16(p.X16, p.norm_cross, p.xn, T);
  else if constexpr (PH == 9) g8::run(p.xn, p.wt_cq, T, 512, DM, g8::EpiBf16{p.qx, 512, X_QSCALE}, smem);
  else if constexpr (PH == 10) xattn_phase(p, smem);
  else if constexpr (PH == 11) g8::run(p.ox, p.wt_co, T, DM, 512, g8::EpiResid16<false>{p.X16, p.X16, DM, DBG_XAT}, smem);
  else if constexpr (PH == 12) norm_rows_ffn(p);
  else if constexpr (PH == 13) score_phase(p, smem);
  else if constexpr (PH == 14) topk2_phase(p);
  else if constexpr (PH == 15) peer_dots(p);
  else if constexpr (PH == 16) peer_coef(p);
  else if constexpr (PH == 17) peer_accum(p, p.X16, -1);
  else if constexpr (PH == 18) final_norm(p);
}

template <int PB, int PE>
__global__ void __launch_bounds__(NTHREADS) mega_kernel(KArgs ka) {
  const Params p = build_params(ka, nullptr);
  if (ka.ws == nullptr) cg::this_grid().sync();
  __shared__ __attribute__((aligned(16))) char smem[SMEM_BYTES];
  XcdBarrier xb;
  if constexpr (PE - PB > 1) {
    volatile LAS unsigned* xbw = (volatile LAS unsigned*)(smem + SMEM_BYTES - 256);
    if (threadIdx.x == 0) { xbw[0] = 0u; xbw[1] = 0u; }
    __syncthreads();
    xb = xcd_barrier_post(p.bar, xbw);
  }
#define RUN(n) if constexpr (PB <= n && n < PE) { if constexpr (n == DUP) { if constexpr (n == 17) peer_accum(p, p.oa, 1023); else run_phase<n>(p, smem); xcd_barrier(xb); } run_phase<n>(p, smem); if constexpr (n + 1 < PE) { xcd_barrier(xb); } }
  RUN(0) RUN(1) RUN(2) RUN(3) RUN(4) RUN(5) RUN(6) RUN(7) RUN(8) RUN(9) RUN(10) RUN(11) RUN(12) RUN(13) RUN(14) RUN(15) RUN(16) RUN(17) RUN(18)
#undef RUN
}


extern "C" void kernel_launch(void* const* d_in, const int* in_sizes, int n_in, void* d_out, int out_size, void* d_ws, size_t ws_size, hipStream_t stream) {
  (void)in_sizes; (void)n_in; (void)out_size;
  KArgs ka{};
  for (int i = 0; i < 25; ++i) ka.in[i] = d_in[i];
  ka.out = (float*)d_out; ka.ws = (char*)d_ws;
  size_t need = 0;
  const Params hp = build_params(ka, &need);
  if (need > ws_size) { fprintf(stderr, "kernel_launch: workspace too small (%zu > %zu)\n", need, ws_size); return; }

  static int grid_blocks = 0;
  if (!grid_blocks) {
    int dev = 0, cus = 0;
    (void)hipGetDevice(&dev);
    (void)hipDeviceGetAttribute(&cus, hipDeviceAttributeMultiprocessorCount, dev);
    grid_blocks = cus > 0 ? cus : 256;
  }
#if MK_SINGLE_LAUNCH
  {
    (void)hipMemsetAsync(hp.bar, 0, (size_t)XCD_BAR_WORDS * 4, stream);
    int per_cu = 0;
    (void)hipOccupancyMaxActiveBlocksPerMultiprocessor(&per_cu, mega_kernel<0, N_PHASES>, NTHREADS, 0);
    if (per_cu < 1) fprintf(stderr, "occupancy query returned %d\n", per_cu);
    void* args[] = {&ka};
    hipError_t e = hipLaunchCooperativeKernel((void*)mega_kernel<0, N_PHASES>, dim3(grid_blocks), dim3(NTHREADS), args, 0, stream);
    if (e != hipSuccess) fprintf(stderr, "cooperative launch failed: %s (grid %d)\n", hipGetErrorString(e), grid_blocks);
  }
#else
#define LAUNCH(n) hipLaunchKernelGGL((mega_kernel<n, n + 1>), dim3(grid_blocks), dim3(NTHREADS), 0, stream, ka);
  LAUNCH(0) LAUNCH(1) LAUNCH(2) LAUNCH(3) LAUNCH(4) LAUNCH(5) LAUNCH(6) LAUNCH(7) LAUNCH(8) LAUNCH(9) LAUNCH(10) LAUNCH(11) LAUNCH(12) LAUNCH(13) LAUNCH(14) LAUNCH(15) LAUNCH(16) LAUNCH(17) LAUNCH(18)
#undef LAUNCH
#endif
}
```

```cpp
#include <hip/hip_runtime.h>
#include <hip/hip_cooperative_groups.h>
#include <cstdint>
#include <cstdio>
namespace cg = cooperative_groups;

#ifndef MK_SINGLE_LAUNCH
#define MK_SINGLE_LAUNCH 1
#endif

#ifndef DUP
#define DUP -1
#endif
#ifndef DBG
#define DBG 0
#endif
#define DBG_MIX ((DBG == 1) ? 0.0f : 1.0f)
#define DBG_XAT ((DBG == 1 || DBG == 2) ? 0.0f : 1.0f)
#define DBG_PEER ((DBG >= 1 && DBG <= 3) ? 0.0f : (DBG == 4 ? -0.5f : 1.0f))
#define DI __device__ __forceinline__
typedef unsigned short bf16_t;
typedef short bf16x8 __attribute__((ext_vector_type(8)));
typedef short s16x4 __attribute__((ext_vector_type(4)));
typedef float f32x16 __attribute__((ext_vector_type(16)));
typedef float f32x4 __attribute__((ext_vector_type(4)));
typedef float f32x2 __attribute__((ext_vector_type(2)));
typedef unsigned u32x4 __attribute__((ext_vector_type(4)));
typedef unsigned u32x2 __attribute__((ext_vector_type(2)));
typedef int i32x4 __attribute__((ext_vector_type(4)));
typedef __bf16 bf2_t __attribute__((ext_vector_type(2)));

constexpr int NB = 2, SEQ = 16384, DM = 1024, T = NB * SEQ;
constexpr int NTHREADS = 512;
constexpr float LOG2E = 1.4426950408889634f;
constexpr float EPS = 1e-6f;
constexpr int IN_COLS = 1216, IN_COLS_PAD = 1280;
constexpr float MLA_QSCALE = 0.07216878364870322f * LOG2E * 8.0f;
constexpr float SWA_QSCALE = 0.125f * LOG2E;
constexpr float X_QSCALE = 0.08838834764831845f * LOG2E;
constexpr float SM_THR = 8.0f;
constexpr float V_FP8_SCALE = 64.0f;

#define XB_TMO      128
#define XB_XCNT(j)  (256  + 64 * (j))
#define XB_XSUB(j)  (1280 + 64 * (j))
#define XB_XGEN(j)  (2304 + 64 * (j))
#define XB_TOP      3328
#define XB_TOPGEN   3392
#define XCD_BAR_WORDS 3456
#define XB_SPIN_CAP (1u << 22)
#define LAS __attribute__((address_space(3)))
DI unsigned xb_ld(unsigned* p)              { return __hip_atomic_load(p, __ATOMIC_RELAXED, __HIP_MEMORY_SCOPE_AGENT); }
DI unsigned xb_add(unsigned* p, unsigned v) { return __hip_atomic_fetch_add(p, v, __ATOMIC_RELAXED, __HIP_MEMORY_SCOPE_AGENT); }
DI unsigned xb_xcc_id() { return (unsigned)__builtin_amdgcn_s_getreg((3 << 11) | 20) & 0xFu; }
#define XB_SPIN(cond, bar) do { unsigned _sp = 0; while (cond) { __builtin_amdgcn_s_sleep(1); \
    if ((++_sp & 255u) == 0u) { if (xb_ld(&(bar)[XB_TMO])) break; if (_sp > XB_SPIN_CAP) { atomicAdd(&(bar)[XB_TMO], 1u); break; } } } } while (0)
struct XcdBarrier { unsigned* bar; unsigned x; volatile LAS unsigned* st; };
DI XcdBarrier xcd_barrier_post(unsigned* bar, volatile LAS unsigned* st) {
  XcdBarrier b; b.bar = bar; b.x = xb_xcc_id(); b.st = st;
  if (threadIdx.x == 0) (void)xb_add(&bar[XB_XCNT(b.x)], 1u);
  return b;
}
DI void xcd_barrier_complete(unsigned* bar, unsigned x, unsigned& nloc, unsigned& nx) {
  const unsigned G = gridDim.x * gridDim.y * gridDim.z;
  unsigned sum, cnt, mine, sp = 0u;
  for (;;) {
    sum = 0u; cnt = 0u; mine = 0u;
#pragma unroll
    for (unsigned j = 0; j < 16; ++j) { const unsigned c = xb_ld(&bar[XB_XCNT(j)]); sum += c; cnt += (c > 0u) ? 1u : 0u; mine = (j == x) ? c : mine; }
    if (sum == G) break;
    __builtin_amdgcn_s_sleep(1);
    if ((++sp & 255u) == 0u) { if (xb_ld(&bar[XB_TMO])) break; if (sp > XB_SPIN_CAP) { atomicAdd(&bar[XB_TMO], 1u); break; } }
  }
  nloc = mine > 0u ? mine : 1u; nx = cnt > 0u ? cnt : 1u;
}
DI void xcd_barrier(const XcdBarrier& b) {
  asm volatile("s_waitcnt vmcnt(0)" ::: "memory");
  __syncthreads();
  if (threadIdx.x == 0) {
    unsigned* bar = b.bar;
    __builtin_amdgcn_s_waitcnt(0);
    unsigned nloc = b.st[0], nx = b.st[1];
    if (nloc == 0u) { xcd_barrier_complete(bar, b.x, nloc, nx); b.st[0] = nloc; b.st[1] = nx; }
    const unsigned old = xb_add(&bar[XB_XSUB(b.x)], 1u);
    const unsigned gen = old / nloc;
    if (old + 1u == (gen + 1u) * nloc) {
      __builtin_amdgcn_fence(__ATOMIC_RELEASE, "agent");
      asm volatile("s_waitcnt vmcnt(0)" ::: "memory");
      const unsigned og = xb_add(&bar[XB_TOP], 1u);
      const unsigned tg = og / nx;
      if (og + 1u == (tg + 1u) * nx) xb_add(&bar[XB_TOPGEN], 1u);
      else XB_SPIN(xb_ld(&bar[XB_TOPGEN]) == tg, bar);
      __builtin_amdgcn_fence(__ATOMIC_ACQUIRE, "agent");
      xb_add(&bar[XB_XGEN(b.x)], 1u);
      asm volatile("s_waitcnt vmcnt(0)" ::: "memory");
    } else {
      XB_SPIN(xb_ld(&bar[XB_XGEN(b.x)]) == gen, bar);
      __builtin_amdgcn_fence(__ATOMIC_ACQUIRE, "agent");
      asm volatile("s_waitcnt vmcnt(0)" ::: "memory");
    }
  }
  __syncthreads();
}

struct Params {
  const float* x; const float* mem; const int* positions; const float* norm_mix; const float* w_in; const float* q_a_norm; const float* w_q_b;
  const float* kv_a_norm; const float* w_kv_b; const float* swa_sinks; const float* out_norm_mla; const float* out_norm_swa; const float* w_out;
  const float* norm_cross; const float* norm_mem; const float* w_cq; const float* w_ck; const float* w_cv; const float* w_co; const float* norm_ffn;
  const float* peer_w_q; const float* peer_keys; const float* peer_u; const float* peer_v; const float* norm_final;
  float* X;
  bf16_t* wt_in; bf16_t* wt_qc; bf16_t* wt_uv; bf16_t* wt_out; bf16_t* wt_cq; bf16_t* wt_ckv; bf16_t* wt_co; bf16_t* a_pq; bf16_t* keys_bf; bf16_t* wt_sc;
  unsigned char* u_q; unsigned char* v_q; unsigned char* k8; unsigned char* vt8; float* su; float* sv; unsigned* bar; bf16_t* mn; bf16_t* kvc; float* rope; bf16_t* xn; bf16_t* lat; bf16_t* cqn; bf16_t* qcat; bf16_t* kcat;
  bf16_t* qs; bf16_t* ks; bf16_t* vs; bf16_t* olat; bf16_t* ob; bf16_t* oa; bf16_t* qx; bf16_t* ox; int* top1; int* pidx; float* pg; unsigned char* hq; float* sh; int* dpartA; int* dpartB; float* cbuf; bf16_t* X16;
};

DI unsigned pk2(float lo, float hi) { f32x2 v = {lo, hi}; bf2_t b = __builtin_convertvector(v, bf2_t); return __builtin_bit_cast(unsigned, b); }
DI bf16_t f2bf(float x) { __bf16 b = (__bf16)x; return __builtin_bit_cast(bf16_t, b); }
DI float bf2f(bf16_t b) { return __uint_as_float(((unsigned)b) << 16); }
DI float bflo(unsigned w) { return __uint_as_float(w << 16); }
DI float bfhi(unsigned w) { return __uint_as_float(w & 0xffff0000u); }
DI float dot2bf(unsigned a, unsigned b, float c) { return __builtin_amdgcn_fdot2_f32_bf16(__builtin_bit_cast(bf2_t, a), __builtin_bit_cast(bf2_t, b), c, false); }
DI int crow(int r, int hi) { return (r & 3) + 8 * (r >> 2) + 4 * hi; }
DI float wave_sum(float v) {
#pragma unroll
  for (int o = 32; o >= 1; o >>= 1) v += __shfl_xor(v, o);
  return v;
}
#define MFMA32(a, b, c) __builtin_amdgcn_mfma_f32_32x32x16_bf16((a), (b), (c), 0, 0, 0)
#define SBAR() __builtin_amdgcn_sched_barrier(0)

constexpr int G_BM = 256, G_BN = 128, G_BK = 64;
constexpr int G_A_BYTES = G_BM * 128, G_B_BYTES = G_BN * 128, G_STAGE = G_A_BYTES + G_B_BYTES;
constexpr int G_NSTAGE = 3;
constexpr int SMEM_BYTES = 160768 + 256;
#define LDSP(p) ((__attribute__((address_space(3))) unsigned*)(p))

template <int V>
DI void gemm_mainloop(const bf16_t* __restrict__ A, int lda, const bf16_t* __restrict__ Bt, int ldb, int K, int row0, int col0, f32x16 (&acc)[4], char* smem) {
  int tid_ = threadIdx.x; asm volatile("" : "+v"(tid_));
  const int tid = tid_, lane = tid & 63, wid = tid >> 6, r32 = lane & 31, hi = lane >> 5;
  const int srow = tid >> 3, spc = tid & 7, slc = spc ^ ((srow >> 1) & 7);
  const bf16_t* Ag = A + (size_t)(row0 + srow) * lda + slc * 8;
  const bf16_t* Bg = Bt + (size_t)(col0 + srow) * ldb + slc * 8;
  const size_t a64 = (size_t)64 * lda, b64 = (size_t)64 * ldb;
#pragma unroll
  for (int i = 0; i < 4; ++i) acc[i] = f32x16{};
  const int nk = K / G_BK;
  auto stage = [&](int kt, int slot) {
    char* sa = smem + slot * G_STAGE + tid * 16;
    const bf16_t* ag = Ag + kt * G_BK; const bf16_t* bg = Bg + kt * G_BK;
#pragma unroll
    for (int i = 0; i < 4; ++i) __builtin_amdgcn_global_load_lds((const unsigned*)(ag + i * a64), LDSP(sa + i * 8192), 16, 0, 0);
#pragma unroll
    for (int i = 0; i < 2; ++i) __builtin_amdgcn_global_load_lds((const unsigned*)(bg + i * b64), LDSP(sa + G_A_BYTES + i * 8192), 16, 0, 0);
  };
  stage(0, 0);
  if (nk > 1) stage(1, 1);
  const int x = (r32 >> 1) & 7;
  int so[4];
#pragma unroll
  for (int s = 0; s < 4; ++s) so[s] = ((2 * s + hi) ^ x) * 16;
  int aoff, boff;
  if (V == 0) { aoff = ((wid >> 1) * 64 + r32) * 128; boff = G_A_BYTES + ((wid & 1) * 64 + r32) * 128; }
  else        { aoff = ((wid >> 2) * 128 + r32) * 128; boff = G_A_BYTES + ((wid & 3) * 32 + r32) * 128; }
  int slot = 0;
  for (int kt = 0; kt < nk; ++kt) {
    if (kt + 1 < nk) asm volatile("s_waitcnt vmcnt(6) lgkmcnt(0)" ::: "memory"); else asm volatile("s_waitcnt vmcnt(0) lgkmcnt(0)" ::: "memory");
    __builtin_amdgcn_s_barrier();
    if (kt + 2 < nk) { int ns = slot + 2; if (ns >= G_NSTAGE) ns -= G_NSTAGE; stage(kt + 2, ns); }
    const char* cs = smem + slot * G_STAGE;
    if (V == 0) {
      bf16x8 af[4][2], bf[4][2];
#pragma unroll
      for (int s = 0; s < 4; ++s) {
        af[s][0] = *(const bf16x8*)(cs + aoff + so[s]); af[s][1] = *(const bf16x8*)(cs + aoff + 32 * 128 + so[s]);
        bf[s][0] = *(const bf16x8*)(cs + boff + so[s]); bf[s][1] = *(const bf16x8*)(cs + boff + 32 * 128 + so[s]);
      }
#pragma unroll
      for (int s = 0; s < 4; ++s) {
        acc[0] = MFMA32(af[s][0], bf[s][0], acc[0]); acc[1] = MFMA32(af[s][0], bf[s][1], acc[1]);
        acc[2] = MFMA32(af[s][1], bf[s][0], acc[2]); acc[3] = MFMA32(af[s][1], bf[s][1], acc[3]);
      }
    } else {
      bf16x8 af[4][4], bf[4];
#pragma unroll
      for (int s = 0; s < 4; ++s) {
        bf[s] = *(const bf16x8*)(cs + boff + so[s]);
#pragma unroll
        for (int mi = 0; mi < 4; ++mi) af[s][mi] = *(const bf16x8*)(cs + aoff + mi * 32 * 128 + so[s]);
      }
#pragma unroll
      for (int s = 0; s < 4; ++s)
#pragma unroll
        for (int mi = 0; mi < 4; ++mi) acc[mi] = MFMA32(af[s][mi], bf[s], acc[mi]);
    }
    slot = (slot + 1 == G_NSTAGE) ? 0 : slot + 1;
  }
  __syncthreads();
}

constexpr int EP_STR = 132;
template <class Epi>
DI void gemm_epi_rows(const f32x16 (&acc)[4], int row0, int col0, const Epi& epi, char* smem) {
  int tid_ = threadIdx.x; asm volatile("" : "+v"(tid_));
  const int tid = tid_, lane = tid & 63, wid = tid >> 6, r32 = lane & 31, hi = lane >> 5;
  float* tile = (float*)smem;
  const int rb = (wid >> 1) * 64, cb = (wid & 1) * 64 + r32;
  const int rr = tid >> 5, c4 = (tid & 31) * 4;
  if constexpr (Epi::HAS_BASE) {
    f32x4 bs[16];
#pragma unroll
    for (int it = 0; it < 16; ++it) bs[it] = epi.load_base(row0 + it * 16 + rr, col0 + c4);
#pragma unroll
    for (int mi = 0; mi < 2; ++mi)
#pragma unroll
      for (int ni = 0; ni < 2; ++ni)
#pragma unroll
        for (int r = 0; r < 16; ++r) tile[(rb + mi * 32 + crow(r, hi)) * EP_STR + cb + ni * 32] = acc[mi * 2 + ni][r];
    __syncthreads();
#pragma unroll
    for (int it = 0; it < 16; ++it) {
      const int row = it * 16 + rr;
      const f32x4 v = *(const f32x4*)(tile + row * EP_STR + c4);
      epi.store(row0 + row, col0 + c4, v, bs[it]);
    }
  } else {
#pragma unroll
    for (int mi = 0; mi < 2; ++mi)
#pragma unroll
      for (int ni = 0; ni < 2; ++ni)
#pragma unroll
        for (int r = 0; r < 16; ++r) tile[(rb + mi * 32 + crow(r, hi)) * EP_STR + cb + ni * 32] = acc[mi * 2 + ni][r];
    __syncthreads();
#pragma unroll 4
    for (int it = 0; it < 16; ++it) {
      const int row = it * 16 + rr;
      const f32x4 v = *(const f32x4*)(tile + row * EP_STR + c4);
      epi(row0 + row, col0 + c4, v);
    }
  }
  __syncthreads();
}

template <class Epi>
DI void gemm_phase(const bf16_t* A, int lda, int a_kstride, const bf16_t* Bt, int ldb, int M, int N, int K, const Epi& epi, char* smem, int bid = -1, int nb = 0) {
  if (bid < 0) { bid = (int)blockIdx.x; nb = (int)gridDim.x; }
  const int ntn = N / G_BN, total = (M / G_BM) * ntn;
  for (int L = bid; L < total; L += nb) {
    const int wg = (L & 7) * (total >> 3) + (L >> 3);
    const int pm = wg / ntn, pn = wg - pm * ntn;
    f32x16 acc[4];
    gemm_mainloop<0>(A + (size_t)pn * a_kstride, lda, Bt, ldb, K, pm * G_BM, pn * G_BN, acc, smem);
    gemm_epi_rows(acc, pm * G_BM, pn * G_BN, epi, smem);
  }
}

DI u32x2 pk4(const f32x4& v, float s) { return u32x2{pk2(v[0] * s, v[1] * s), pk2(v[2] * s, v[3] * s)}; }
struct EpiInproj {
  static constexpr bool HAS_BASE = false;
  bf16_t* lat; bf16_t* qs; bf16_t* ks; bf16_t* vs;
  DI void operator()(int row, int col, const f32x4& v) const {
    if (col < 448) *(u32x2*)(lat + (size_t)row * 448 + col) = pk4(v, 1.0f);
    else if (col < 960) *(u32x2*)(qs + (size_t)row * 512 + (col - 448)) = pk4(v, SWA_QSCALE);
    else if (col < 1088) *(u32x2*)(ks + (size_t)row * 128 + (col - 960)) = pk4(v, 1.0f);
    else if (col < 1216) *(u32x2*)(vs + (size_t)row * 128 + (col - 1088)) = pk4(v, 1.0f);
  }
};
struct EpiBf16 { static constexpr bool HAS_BASE = false; bf16_t* out; int ld; float scale; DI void operator()(int row, int col, const f32x4& v) const { *(u32x2*)(out + (size_t)row * ld + col) = pk4(v, scale); } };
struct EpiBf16T { static constexpr bool HAS_BASE = false; bf16_t* out; int ld; DI void operator()(int row, int col, const f32x4& v) const {
#pragma unroll
  for (int j = 0; j < 4; ++j) out[(size_t)(col + j) * ld + row] = f2bf(v[j]); } };
struct EpiResid { static constexpr bool HAS_BASE = true; const float* base; float* out; int ld; float scale;
  DI f32x4 load_base(int row, int col) const { return *(const f32x4*)(base + (size_t)row * ld + col); }
  DI void store(int row, int col, const f32x4& v, const f32x4& b) const { *(f32x4*)(out + (size_t)row * ld + col) = b + v * scale; } };

namespace g8 {
#define PG8_LAS __attribute__((address_space(3)))
constexpr int BM = 256, BK = 64, HALF = 128, HTB = HALF * BK * 2, NXCD = 8, WGM = 8;
DI int lds_byte(int r, int c) { const int st = (r >> 4) * 2 + (c >> 5), rr = r & 15, cc = c & 31, ob = rr * 64 + cc * 2; return st * 1024 + (ob ^ (((ob >> 9) & 1) << 5)); }
DI void stage_rc(int b, int& R, int& C) { const int st = b / 1024, sb = b % 1024, swz = sb ^ (((sb >> 9) & 1) << 5); R = (st >> 1) * 16 + swz / 64; C = (st & 1) * 32 + (swz % 64) / 2; }
DI int perm32(int rho) { const int n = rho >> 4, i = rho & 15; return 8 * (i >> 2) + 4 * n + (i & 3); }
struct Unit { int pm, pn; };
struct Gemm { const bf16_t* A; const bf16_t* Bt; int M, N, K; };
struct StaticOrder {
  int nM, nN, nwg, G, c;
  DI void init(int M, int N, int G_, int c_) { nM = M / BM; nN = N / BM; nwg = nM * nN; G = G_; c = c_; }
  DI bool next(int i, Unit& u) const {
    const long L = (long)i * G + c; if (L >= nwg) return false;
    int wgid = (int)L; { const int q = nwg / NXCD, r = nwg % NXCD, xcd = wgid % NXCD, off = wgid / NXCD; wgid = (xcd < r ? xcd * (q + 1) : r * (q + 1) + (xcd - r) * q) + off; }
    const int nig = WGM * nN, gid = wgid / nig, fm = gid * WGM, gsz = (nM - fm) < WGM ? (nM - fm) : WGM;
    u.pm = fm + ((wgid % nig) % gsz); u.pn = (wgid % nig) / gsz; return true;
  }
};
template <class Epi>
DI void gemm_phase(PG8_LAS unsigned char* lds, const Gemm g, const StaticOrder& S, const Epi& E) {
  int tid = threadIdx.x; asm volatile("" : "+v"(tid));
  const int wid = __builtin_amdgcn_readfirstlane(tid >> 6), lane = tid & 63, wr = wid >> 2, wc = wid & 3, fr = lane & 15, fq = lane >> 4;
  const int K = g.K, nt = K / BK;
  unsigned voffA[2], voffB[2];
#pragma unroll
  for (int i = 0; i < 2; ++i) { int R, C; stage_rc(tid * 16 + i * 8192, R, C); const int Rb = Epi::PERM ? ((R & ~31) + perm32(R & 31)) : R;
    voffA[i] = (unsigned)(R * K + C) * 2u; voffB[i] = (unsigned)(Rb * K + C) * 2u; }
  const size_t kstep = (size_t)(BK * 2), hstep = (size_t)HALF * K * 2, tstep = 2 * hstep;
  const unsigned ldsw = (unsigned)wid * 1024u;
  const int aoff = lds_byte(wr * 64 + fr, fq * 8), boff = lds_byte(wc * 32 + fr, fq * 8);
#define PG8_SA(b, h) (((b) * 2 + (h)) * HTB)
#define PG8_SB(b, h) ((4 + (b) * 2 + (h)) * HTB)
#define PG8_STAGE(bufoff, gbase, voff) do { _Pragma("unroll") for (int _i = 0; _i < 2; ++_i) \
    __builtin_amdgcn_global_load_lds((const unsigned*)((const char*)(gbase) + (voff)[_i]), (PG8_LAS unsigned*)(lds + (bufoff) + ldsw + _i * 8192), 16, 0, 0); } while (0)
#define PG8_LDA(dst, b, h) do { _Pragma("unroll") for (int m = 0; m < 4; ++m) _Pragma("unroll") for (int k = 0; k < 2; ++k) dst[m][k] = *(const PG8_LAS bf16x8*)(lds + PG8_SA(b, h) + aoff + m * 2048 + k * 1024); } while (0)
#define PG8_LDB(dst, b, h) do { _Pragma("unroll") for (int n = 0; n < 2; ++n) _Pragma("unroll") for (int k = 0; k < 2; ++k) dst[n][k] = *(const PG8_LAS bf16x8*)(lds + PG8_SB(b, h) + boff + n * 2048 + k * 1024); } while (0)
#define PG8_MMA(ai, bj, At, Bt) do { __builtin_amdgcn_s_setprio(1); _Pragma("unroll") for (int m = 0; m < 4; ++m) _Pragma("unroll") for (int n = 0; n < 2; ++n) _Pragma("unroll") for (int k = 0; k < 2; ++k) \
    acc[ai][bj][m][n] = __builtin_amdgcn_mfma_f32_16x16x32_bf16(Bt[n][k], At[m][k], acc[ai][bj][m][n], 0, 0, 0); __builtin_amdgcn_s_setprio(0); } while (0)
#define PG8_WAIT_V(n) asm volatile("s_waitcnt vmcnt(" #n ")" ::: "memory")
#define PG8_WAIT_L(n) asm volatile("s_waitcnt lgkmcnt(" #n ")" ::: "memory")
#define PG8_BAR __builtin_amdgcn_s_barrier()
#define PG8_SCHED __builtin_amdgcn_sched_barrier(0)
  Unit cur, nxt; int ui = 0;
  if (!S.next(0, cur)) return;
  f32x4 acc[2][2][4][2];
#pragma unroll
  for (int a = 0; a < 2; ++a)
#pragma unroll
    for (int b = 0; b < 2; ++b)
#pragma unroll
      for (int m = 0; m < 4; ++m)
#pragma unroll
        for (int n = 0; n < 2; ++n) acc[a][b][m][n] = (f32x4){0.f, 0.f, 0.f, 0.f};
  bf16x8 At[4][2], B0[2][2], B1[2][2];
  const char* cA = (const char*)g.A + (size_t)cur.pm * tstep; const char* cB = (const char*)g.Bt + (size_t)cur.pn * tstep;
  PG8_STAGE(PG8_SB(0, 0), cB, voffB); PG8_STAGE(PG8_SA(0, 0), cA, voffA); PG8_STAGE(PG8_SB(0, 1), cB + hstep, voffB); PG8_STAGE(PG8_SA(0, 1), cA + hstep, voffA);
  if (wr == 1) PG8_BAR;
  PG8_WAIT_V(4); PG8_BAR;
  PG8_STAGE(PG8_SB(1, 0), cB + kstep, voffB); PG8_STAGE(PG8_SA(1, 0), cA + kstep, voffA); PG8_STAGE(PG8_SB(1, 1), cB + hstep + kstep, voffB);
  PG8_WAIT_V(6); PG8_BAR;
  for (;;) {
    const bool has_next = S.next(ui + 1, nxt);
    const char* nA = has_next ? (const char*)g.A + (size_t)nxt.pm * tstep : cA; const char* nB = has_next ? (const char*)g.Bt + (size_t)nxt.pn * tstep : cB;
    for (int t = 0; t < nt; t += 2) {
      const bool last = (t == nt - 2);
      const char* a1 = cA + (size_t)(t + 1) * kstep;
      const char* a2 = last ? nA : cA + (size_t)(t + 2) * kstep; const char* b2 = last ? nB : cB + (size_t)(t + 2) * kstep;
      const char* a3 = a2 + kstep; const char* b3 = b2 + kstep;
      PG8_LDB(B0, 0, 0); PG8_SCHED; PG8_LDA(At, 0, 0); PG8_STAGE(PG8_SA(1, 1), a1 + hstep, voffA);
      PG8_WAIT_L(8); PG8_BAR; PG8_WAIT_L(0); PG8_MMA(0, 0, At, B0); PG8_BAR; PG8_SCHED;
      PG8_LDB(B1, 0, 1); PG8_STAGE(PG8_SB(0, 0), b2, voffB);
      PG8_BAR; PG8_WAIT_L(0); PG8_MMA(0, 1, At, B1); PG8_BAR;
      PG8_LDA(At, 0, 1); PG8_STAGE(PG8_SA(0, 0), a2, voffA);
      PG8_BAR; PG8_WAIT_L(0); PG8_MMA(1, 0, At, B0); PG8_BAR; PG8_SCHED;
      PG8_STAGE(PG8_SB(0, 1), b2 + hstep, voffB);
      PG8_WAIT_V(6); PG8_BAR; PG8_MMA(1, 1, At, B1); PG8_BAR;
      PG8_LDB(B0, 1, 0); PG8_SCHED; PG8_LDA(At, 1, 0); PG8_STAGE(PG8_SA(0, 1), a2 + hstep, voffA);
      PG8_WAIT_L(8); PG8_BAR; PG8_WAIT_L(0); PG8_MMA(0, 0, At, B0); PG8_BAR; PG8_SCHED;
      PG8_LDB(B1, 1, 1); PG8_STAGE(PG8_SB(1, 0), b3, voffB);
      PG8_BAR; PG8_WAIT_L(0); PG8_MMA(0, 1, At, B1); PG8_BAR;
      PG8_LDA(At, 1, 1); PG8_STAGE(PG8_SA(1, 0), a3, voffA);
      PG8_BAR; PG8_WAIT_L(0); PG8_MMA(1, 0, At, B0); PG8_BAR; PG8_SCHED;
      PG8_STAGE(PG8_SB(1, 1), b3 + hstep, voffB);
      PG8_WAIT_V(6); PG8_BAR; PG8_MMA(1, 1, At, B1); PG8_BAR;
    }
    E(acc, cur, wr, wc, fr, fq);
    if (!has_next) break;
#pragma unroll
    for (int a = 0; a < 2; ++a)
#pragma unroll
      for (int b = 0; b < 2; ++b)
#pragma unroll
        for (int m = 0; m < 4; ++m)
#pragma unroll
          for (int n = 0; n < 2; ++n) acc[a][b][m][n] = (f32x4){0.f, 0.f, 0.f, 0.f};
    cur = nxt; cA = nA; cB = nB; ++ui;
  }
  PG8_WAIT_V(0);
  if (wr == 0) PG8_BAR;
  PG8_BAR;
#undef PG8_SA
#undef PG8_SB
#undef PG8_STAGE
#undef PG8_LDA
#undef PG8_LDB
#undef PG8_MMA
#undef PG8_WAIT_V
#undef PG8_WAIT_L
#undef PG8_BAR
#undef PG8_SCHED
}
DI u32x4 pk8(const f32x4& v0, const f32x4& v1, float s) { return u32x4{pk2(v0[0] * s, v0[1] * s), pk2(v0[2] * s, v0[3] * s), pk2(v1[0] * s, v1[1] * s), pk2(v1[2] * s, v1[3] * s)}; }
struct EpiBf16 {
  static constexpr bool PERM = true;
  bf16_t* out; int ld; float scale;
  DI void operator()(const f32x4 (&acc)[2][2][4][2], const Unit& u, int wr, int wc, int fr, int fq) const {
    const int row0 = u.pm * BM + wr * 64 + fr, col0 = u.pn * BM + wc * 32 + 8 * fq;
#pragma unroll
    for (int ai = 0; ai < 2; ++ai)
#pragma unroll
      for (int m = 0; m < 4; ++m) { bf16_t* rowp = out + (size_t)(row0 + ai * HALF + m * 16) * ld + col0;
#pragma unroll
        for (int bj = 0; bj < 2; ++bj) *(u32x4*)(rowp + bj * HALF) = pk8(acc[ai][bj][m][0], acc[ai][bj][m][1], scale); }
  }
};
struct EpiInproj {
  static constexpr bool PERM = true;
  bf16_t* lat; bf16_t* qs; bf16_t* ks; bf16_t* vs;
  DI void operator()(const f32x4 (&acc)[2][2][4][2], const Unit& u, int wr, int wc, int fr, int fq) const {
    const int row0 = u.pm * BM + wr * 64 + fr;
#pragma unroll
    for (int bj = 0; bj < 2; ++bj) {
      const int cw = u.pn * BM + bj * HALF + wc * 32;
      bf16_t* dst; int ld; float sc = 1.0f;
      if (cw < 448) { dst = lat + cw; ld = 448; } else if (cw < 960) { dst = qs + (cw - 448); ld = 512; sc = SWA_QSCALE; }
      else if (cw < 1088) { dst = ks + (cw - 960); ld = 128; } else if (cw < 1216) { dst = vs + (cw - 1088); ld = 128; } else continue;
#pragma unroll
      for (int ai = 0; ai < 2; ++ai)
#pragma unroll
        for (int m = 0; m < 4; ++m) *(u32x4*)(dst + (size_t)(row0 + ai * HALF + m * 16) * ld + 8 * fq) = pk8(acc[ai][bj][m][0], acc[ai][bj][m][1], sc);
    }
  }
};
template <bool BASE_F32>
struct EpiResid16 {
  static constexpr bool PERM = true;
  const void* base; bf16_t* out; int ld; float scale;
  DI void operator()(const f32x4 (&acc)[2][2][4][2], const Unit& u, int wr, int wc, int fr, int fq) const {
    const int row0 = u.pm * BM + wr * 64 + fr, col0 = u.pn * BM + wc * 32 + 8 * fq;
#pragma unroll
    for (int ai = 0; ai < 2; ++ai)
#pragma unroll
      for (int m = 0; m < 4; ++m) { const size_t ro = (size_t)(row0 + ai * HALF + m * 16) * ld + col0;
        f32x4 b[2][2];
#pragma unroll
        for (int bj = 0; bj < 2; ++bj) {
          if (BASE_F32) { b[bj][0] = *(const f32x4*)((const float*)base + ro + bj * HALF); b[bj][1] = *(const f32x4*)((const float*)base + ro + bj * HALF + 4); }
          else { const u32x4 w = *(const u32x4*)((const bf16_t*)base + ro + bj * HALF);
            b[bj][0] = f32x4{bflo(w[0]), bfhi(w[0]), bflo(w[1]), bfhi(w[1])}; b[bj][1] = f32x4{bflo(w[2]), bfhi(w[2]), bflo(w[3]), bfhi(w[3])}; }
        }
#pragma unroll
        for (int bj = 0; bj < 2; ++bj) *(u32x4*)(out + ro + bj * HALF) = pk8(b[bj][0] + acc[ai][bj][m][0] * scale, b[bj][1] + acc[ai][bj][m][1] * scale, 1.0f);
        if (m & 1) asm volatile("" ::: "memory"); }
  }
};
template <class Epi>
DI void run_on(const bf16_t* A, const bf16_t* Bt, int M, int N, int K, const Epi& E, char* smem, int c, int G) {
  StaticOrder S; S.init(M, N, G, c);
  gemm_phase<Epi>((PG8_LAS unsigned char*)smem, Gemm{A, Bt, M, N, K}, S, E);
  __syncthreads();
}
template <class Epi>
DI void run(const bf16_t* A, const bf16_t* Bt, int M, int N, int K, const Epi& E, char* smem) { run_on(A, Bt, M, N, K, E, smem, (int)blockIdx.x, (int)gridDim.x); }
}

DI int tokey(float f) { const int u = __float_as_int(f); return u ^ ((u >> 31) & 0x7fffffff); }
DI float fromkey(int k) { return __int_as_float(k ^ ((k >> 31) & 0x7fffffff)); }
DI void ins16(int (&top)[16], int key) {
#pragma unroll
  for (int j = 0; j < 16; ++j) { const int h = max(top[j], key); key = min(top[j], key); top[j] = h; }
}

DI void score_phase(const Params& p, char* smem) {
  const int ntn = T / G_BN, total = (2048 / G_BM) * ntn;
  for (int L = blockIdx.x; L < total; L += gridDim.x) {
    const int wg = (L & 7) * (total >> 3) + (L >> 3);
    const int pn = wg >> 3, pm = wg & 7;
    f32x16 acc[4];
    gemm_mainloop<1>(p.wt_sc, DM, p.xn, DM, DM, pm * G_BM, pn * G_BN, acc, smem);
    SBAR();
    int tid_ = threadIdx.x; asm volatile("" : "+v"(tid_));
    const int tid = tid_, lane = tid & 63, wid = tid >> 6, r32 = lane & 31, hi = lane >> 5;
    const int group = pm * 2 + (wid >> 2);
    const int tok = pn * G_BN + (wid & 3) * 32 + r32;
    int top[16];
    {
      int g[4][16];
#pragma unroll
      for (int mi = 0; mi < 4; ++mi)
#pragma unroll
        for (int r = 0; r < 16; ++r) { const int n = 32 * mi + crow(r, hi); g[mi][r] = (tokey(acc[mi][r]) & ~127) | (127 - n); }
#pragma unroll
      for (int mi = 0; mi < 4; ++mi)
#pragma unroll
        for (int k = 2; k <= 16; k <<= 1)
#pragma unroll
          for (int j = k >> 1; j >= 1; j >>= 1)
#pragma unroll
            for (int i = 0; i < 16; ++i) { const int l = i ^ j; if (l > i) { const int a = g[mi][i], b = g[mi][l]; const bool desc = (k == 16) || ((i & k) == 0);
              g[mi][i] = desc ? max(a, b) : min(a, b); g[mi][l] = desc ? min(a, b) : max(a, b); } }
      auto merge16 = [](int (&a)[16], const int (&b)[16]) {
#pragma unroll
        for (int i = 0; i < 16; ++i) a[i] = max(a[i], b[15 - i]);
#pragma unroll
        for (int d = 8; d >= 1; d >>= 1)
#pragma unroll
          for (int i = 0; i < 16; ++i) if ((i & d) == 0) { const int x = max(a[i], a[i + d]), y = min(a[i], a[i + d]); a[i] = x; a[i + d] = y; }
      };
      merge16(g[0], g[1]); merge16(g[2], g[3]); merge16(g[0], g[2]);
#pragma unroll
      for (int i = 0; i < 16; ++i) top[i] = g[0][i];
    }
    int c[16];
#pragma unroll
    for (int j = 0; j < 16; ++j) {
      auto rr = __builtin_amdgcn_permlane32_swap((unsigned)top[15 - j], (unsigned)top[15 - j], false, false);
      const int other = hi ? (int)rr[0] : (int)rr[1];
      c[j] = max(top[j], other);
    }
#pragma unroll
    for (int d = 8; d >= 1; d >>= 1)
#pragma unroll
      for (int i = 0; i < 16; ++i) if ((i & d) == 0) { const int a = max(c[i], c[i + d]), b = min(c[i], c[i + d]); c[i] = a; c[i + d] = b; }
    int* dst = p.top1 + ((size_t)tok * 16 + group) * 16 + hi * 8;
    if (hi == 0) { *(i32x4*)dst = i32x4{c[0], c[1], c[2], c[3]}; *(i32x4*)(dst + 4) = i32x4{c[4], c[5], c[6], c[7]}; }
    else         { *(i32x4*)dst = i32x4{c[8], c[9], c[10], c[11]}; *(i32x4*)(dst + 4) = i32x4{c[12], c[13], c[14], c[15]}; }
    SBAR();
  }
}

DI void ins16v(float (&bv)[16], int (&bp)[16], float v, int pl) {
#pragma unroll
  for (int j = 0; j < 16; ++j) { const bool c = v > bv[j]; const float nv = c ? bv[j] : v; const int np = c ? bp[j] : pl; bv[j] = c ? v : bv[j]; bp[j] = c ? pl : bp[j]; v = nv; pl = np; }
}
DI void topk2_phase(const Params& p) {
  const int nitems = T * 8;
  for (int it = blockIdx.x * NTHREADS + threadIdx.x; it < nitems; it += gridDim.x * NTHREADS) {
    const int* src = p.top1 + (size_t)it * 32;
    int ka[16], kb[16];
#pragma unroll
    for (int q = 0; q < 4; ++q) { const i32x4 v = *(const i32x4*)(src + 4 * q); ka[4 * q] = v[0]; ka[4 * q + 1] = v[1]; ka[4 * q + 2] = v[2]; ka[4 * q + 3] = v[3]; }
#pragma unroll
    for (int q = 0; q < 4; ++q) { const i32x4 v = *(const i32x4*)(src + 16 + 4 * q); kb[4 * q] = v[0]; kb[4 * q + 1] = v[1]; kb[4 * q + 2] = v[2]; kb[4 * q + 3] = v[3]; }
    float av[16], bvv[16]; int ia[16], ib[16];
#pragma unroll
    for (int i = 0; i < 16; ++i) { av[i] = fromkey(ka[i] & ~127); ia[i] = (127 - (ka[i] & 127)) << 7; bvv[i] = fromkey(kb[i] & ~127); ib[i] = 127 - (kb[i] & 127); }
    int best[16];
#pragma unroll
    for (int j = 0; j < 16; ++j) best[j] = (int)0x80000000;
#pragma unroll
    for (int i = 0; i < 16; ++i)
#pragma unroll
      for (int j = 0; j < 16; ++j)
        if ((i + 1) * (j + 1) <= 16) ins16(best, (tokey(av[i] + bvv[j]) & ~0x3fff) | ia[i] | ib[j]);
    float bv[16]; int bp[16];
#pragma unroll
    for (int j = 0; j < 16; ++j) { bv[j] = fromkey(best[j] & ~0x3fff); bp[j] = best[j] & 0x3fff; }
    const float m = bv[0];
    float w[16], sum = 0.f;
#pragma unroll
    for (int j = 0; j < 16; ++j) { w[j] = __builtin_amdgcn_exp2f((bv[j] - m) * LOG2E); sum += w[j]; }
    const float inv = 1.0f / sum;
    int* di = p.pidx + (size_t)it * 16; float* dg = p.pg + (size_t)it * 16;
#pragma unroll
    for (int q = 0; q < 4; ++q) {
      *(i32x4*)(di + 4 * q) = i32x4{bp[4 * q], bp[4 * q + 1], bp[4 * q + 2], bp[4 * q + 3]};
#if DBG == 5
      *(f32x4*)(dg + 4 * q) = f32x4{0.0625f, 0.0625f, 0.0625f, 0.0625f};
#else
      *(f32x4*)(dg + 4 * q) = f32x4{w[4 * q] * inv, w[4 * q + 1] * inv, w[4 * q + 2] * inv, w[4 * q + 3] * inv};
#endif
    }
  }
}

template <int NDB> DI int v_st(int k, int c) { const int kk = (k & ~0xC) | ((k & 4) << 1) | ((k & 8) >> 1); return ((kk >> 3) * NDB + (c >> 5)) * 512 + ((kk & 7) * 32 + (c & 31)) * 2; }
DI int v_rd_base(int lane) { return ((lane & 3) << 3) | (((lane >> 2) & 3) << 6) | (((lane >> 4) & 1) << 5) | (((lane >> 5) & 1) << 8); }
template <int OFF> DI s16x4 tr_read(int vb) { s16x4 r; asm volatile("ds_read_b64_tr_b16 %0, %1 offset:%2" : "=&v"(r) : "v"(vb), "i"(OFF) : "memory"); return r; }
template <int NDB, int D0> DI void pv_one(f32x16& od, int vb, bf16x8 pa0, bf16x8 pa1, bf16x8 pa2, bf16x8 pa3) {
  constexpr int KS = 2 * NDB * 512, HF = NDB * 512;
  const s16x4 l0 = tr_read<D0 * 512 + 0 * KS>(vb), h0 = tr_read<D0 * 512 + 0 * KS + HF>(vb), l1 = tr_read<D0 * 512 + 1 * KS>(vb), h1 = tr_read<D0 * 512 + 1 * KS + HF>(vb);
  const s16x4 l2 = tr_read<D0 * 512 + 2 * KS>(vb), h2 = tr_read<D0 * 512 + 2 * KS + HF>(vb), l3 = tr_read<D0 * 512 + 3 * KS>(vb), h3 = tr_read<D0 * 512 + 3 * KS + HF>(vb);
  asm volatile("s_waitcnt lgkmcnt(0)" ::: "memory"); SBAR();
#define PKV(L, H) (bf16x8){L[0], L[1], L[2], L[3], H[0], H[1], H[2], H[3]}
  od = MFMA32(pa0, PKV(l0, h0), od); od = MFMA32(pa1, PKV(l1, h1), od); od = MFMA32(pa2, PKV(l2, h2), od); od = MFMA32(pa3, PKV(l3, h3), od);
#undef PKV
}

template <int OFF> DI void pv_rd4(int vb, s16x4 (&l)[2], s16x4 (&h)[2]) {
  constexpr int KS = 2 * 4 * 512, HF = 4 * 512;
  l[0] = tr_read<OFF>(vb); h[0] = tr_read<OFF + HF>(vb); l[1] = tr_read<OFF + KS>(vb); h[1] = tr_read<OFF + KS + HF>(vb);
}
#define PKV(L, H) (bf16x8){L[0], L[1], L[2], L[3], H[0], H[1], H[2], H[3]}
DI void pv_all4(f32x16 (&o)[4], int vb, bf16x8 pa0, bf16x8 pa1, bf16x8 pa2, bf16x8 pa3) {
  constexpr int KS2 = 2 * 2 * 4 * 512;
  s16x4 la[2], ha[2], lb[2], hb[2];
  pv_rd4<0 * 512>(vb, la, ha); pv_rd4<0 * 512 + KS2>(vb, lb, hb);
#define PV_STEP(D, NEXTA, NEXTB) \
  asm volatile("s_waitcnt lgkmcnt(4)" ::: "memory"); SBAR(); \
  o[D] = MFMA32(pa0, PKV(la[0], ha[0]), o[D]); o[D] = MFMA32(pa1, PKV(la[1], ha[1]), o[D]); SBAR(); \
  NEXTA; \
  asm volatile("s_waitcnt lgkmcnt(4)" ::: "memory"); SBAR(); \
  o[D] = MFMA32(pa2, PKV(lb[0], hb[0]), o[D]); o[D] = MFMA32(pa3, PKV(lb[1], hb[1]), o[D]); SBAR(); \
  NEXTB;
  PV_STEP(0, (pv_rd4<1 * 512>(vb, la, ha)), (pv_rd4<1 * 512 + KS2>(vb, lb, hb)))
  PV_STEP(1, (pv_rd4<2 * 512>(vb, la, ha)), (pv_rd4<2 * 512 + KS2>(vb, lb, hb)))
  PV_STEP(2, (pv_rd4<3 * 512>(vb, la, ha)), (pv_rd4<3 * 512 + KS2>(vb, lb, hb)))
  asm volatile("s_waitcnt lgkmcnt(4)" ::: "memory"); SBAR();
  o[3] = MFMA32(pa0, PKV(la[0], ha[0]), o[3]); o[3] = MFMA32(pa1, PKV(la[1], ha[1]), o[3]); SBAR();
  asm volatile("s_waitcnt lgkmcnt(0)" ::: "memory"); SBAR();
  o[3] = MFMA32(pa2, PKV(lb[0], hb[0]), o[3]); o[3] = MFMA32(pa3, PKV(lb[1], hb[1]), o[3]);
#undef PV_STEP
}
#undef PKV

template <int DQK, int DV, int MODE>
struct AttnArgs {
  const bf16_t* Kb; int ldk;
  const bf16_t* Vb; int ldv;
  int jt0, NT;
  int tq;
  int diag_tile;
  int tw0;
  float slope2, sink2;
  bf16_t* Ow; int ldo;
};

template <int DQK, int DV, int MODE, int QL>
DI void attn_unit(const bf16x8 (&qr)[DQK / 16 - QL], const AttnArgs<DQK, DV, MODE>& a, char* smem) {
  constexpr int NKS = DQK / 16, NDB = DV / 32, KSTR = DQK * 2 + 16, KBUF = 64 * KSTR, VBUF = 64 * DV * 2, BUF = KBUF + VBUF, NKC = DQK / 64, NVC = DV / 64;
  const int tid = threadIdx.x, wid = __builtin_amdgcn_readfirstlane(tid >> 6), lane = tid & 63, r32 = lane & 31, hi = lane >> 5;
  const bool rot = (wid >= 4);
  float* wsf = (float*)(smem + 3 * BUF) + wid * 64; float* li_l = wsf; float* al_l = wsf + 32;
  const char* qlds = smem + 3 * BUF + 2048 + wid * 4096 + r32 * 128;
  const int qx = (r32 >> 1) & 7;
  float m_reg = -1e30f, l_reg = 0.f; f32x16 o[NDB];
#pragma unroll
  for (int d = 0; d < NDB; ++d) o[d] = f32x16{};
  const int srow = tid >> 3, c8 = tid & 7;
  const int vb0 = (int)(uintptr_t)smem + v_rd_base(lane);
  bf16x8 kst[NKC], vst[(MODE == 0) ? 1 : NVC];
  auto sload = [&](int jt) {
    const size_t krow = (size_t)(jt * 64 + srow);
#pragma unroll
    for (int i = 0; i < NKC; ++i) kst[i] = *(const bf16x8*)(a.Kb + krow * a.ldk + 64 * i + 8 * c8);
    if (MODE != 0) {
#pragma unroll
      for (int i = 0; i < NVC; ++i) vst[i] = *(const bf16x8*)(a.Vb + krow * a.ldv + 64 * i + 8 * c8);
    }
  };
  auto swrite = [&](int b) {
    char* bp = smem + b * BUF;
#pragma unroll
    for (int i = 0; i < NKC; ++i) *(bf16x8*)(bp + VBUF + srow * KSTR + (64 * i + 8 * c8) * 2) = kst[i];
    if (MODE == 0) {
#pragma unroll
      for (int i = 0; i < NVC; ++i) *(bf16x8*)(bp + v_st<NDB>(srow, 64 * i + 8 * c8)) = kst[i];
    } else {
#pragma unroll
      for (int i = 0; i < NVC; ++i) *(bf16x8*)(bp + v_st<NDB>(srow, 64 * i + 8 * c8)) = vst[i];
    }
  };
  auto tile_active = [&](int jt) -> bool { if (MODE == 2) return (jt * 64 + 63 >= a.tw0 - 127) && (jt * 64 <= a.tw0 + 31); return true; };
  f32x16 p0, p1;
  auto qkt = [&](int b) {
    p0 = f32x16{}; p1 = f32x16{};
    const char* Kc = smem + b * BUF + VBUF + r32 * KSTR + hi * 16;
    __builtin_amdgcn_s_setprio(1);
#pragma unroll
    for (int s = 0; s < NKS - QL; ++s) {
      const bf16x8 b0 = *(const bf16x8*)(Kc + s * 32), b1 = *(const bf16x8*)(Kc + 32 * KSTR + s * 32);
      p0 = MFMA32(b0, qr[s], p0); p1 = MFMA32(b1, qr[s], p1);
    }
#pragma unroll
    for (int s = NKS - QL; s < NKS; ++s) {
      const bf16x8 b0 = *(const bf16x8*)(Kc + s * 32), b1 = *(const bf16x8*)(Kc + 32 * KSTR + s * 32);
      const bf16x8 qf = *(const bf16x8*)(qlds + (((2 * (s - (NKS - QL)) + hi) ^ qx) << 4));
      p0 = MFMA32(b0, qf, p0); p1 = MFMA32(b1, qf, p1);
    }
    __builtin_amdgcn_s_setprio(0);
  };
  sload(a.jt0); swrite(0);
  if (a.NT > 1) { sload(a.jt0 + 1); swrite(1); }
  __syncthreads();
  if (rot && tile_active(a.jt0)) qkt(0);
  int cur = 0;
  for (int j = 0; j < a.NT; ++j) {
    const int jt = a.jt0 + j;
    int nxt = cur + 1; if (nxt == 3) nxt = 0;
    int nx2 = nxt + 1; if (nx2 == 3) nx2 = 0;
    if (j + 2 < a.NT) sload(jt + 2);
    const bool active = tile_active(jt);
    if (active) {
      if (!rot) qkt(cur);
      if (MODE == 0) {
        if (jt == a.diag_tile) {
          const int tl = a.tq & 63;
#pragma unroll
          for (int r = 0; r < 16; ++r) { const int kl = crow(r, hi); if (kl > tl) p0[r] = -INFINITY; if (kl + 32 > tl) p1[r] = -INFINITY; }
        }
      } else if (MODE == 2) {
#pragma unroll
        for (int r = 0; r < 16; ++r) {
          const int d0 = a.tq - (jt * 64 + crow(r, hi)), d1 = d0 - 32;
          p0[r] = (d0 >= 0 && d0 < 128) ? p0[r] - a.slope2 * (float)d0 : -INFINITY;
          p1[r] = (d1 >= 0 && d1 < 128) ? p1[r] - a.slope2 * (float)d1 : -INFINITY;
        }
      }
      float pmax = p0[0];
#pragma unroll
      for (int r = 1; r < 16; ++r) pmax = fmaxf(pmax, p0[r]);
#pragma unroll
      for (int r = 0; r < 16; ++r) pmax = fmaxf(pmax, p1[r]);
      { auto rr = __builtin_amdgcn_permlane32_swap(__float_as_uint(pmax), __float_as_uint(pmax), false, false); pmax = fmaxf(__uint_as_float(rr[0]), __uint_as_float(rr[1])); }
      float mn, alpha;
      if (__all(pmax - m_reg <= SM_THR)) { mn = m_reg; alpha = 1.f; }
      else { mn = fmaxf(m_reg, pmax); alpha = __builtin_amdgcn_exp2f(m_reg - mn); m_reg = mn; }
#pragma unroll
      for (int r = 0; r < 16; ++r) { p0[r] = __builtin_amdgcn_exp2f(p0[r] - mn); p1[r] = __builtin_amdgcn_exp2f(p1[r] - mn); }
      float ps = 0.f;
#pragma unroll
      for (int r = 0; r < 16; ++r) ps += p0[r] + p1[r];
      { auto rr = __builtin_amdgcn_permlane32_swap(__float_as_uint(ps), __float_as_uint(ps), false, false); ps = __uint_as_float(rr[0]) + __uint_as_float(rr[1]); }
      l_reg = l_reg * alpha + ps;
      if (__any(alpha < 1.f)) {
        if (hi == 0) al_l[r32] = alpha;
        asm volatile("s_waitcnt lgkmcnt(0)" ::: "memory");
#pragma unroll
        for (int r = 0; r < 16; ++r) { const float al = al_l[crow(r, hi)];
#pragma unroll
          for (int d = 0; d < NDB; ++d) o[d][r] *= al; }
      }
      bf16x8 pa0, pa1, pa2, pa3;
#define PK4(P, BASE, OUT) do { const unsigned a0 = pk2(P[BASE + 0], P[BASE + 1]), a1 = pk2(P[BASE + 2], P[BASE + 3]);   \
      const unsigned b0_ = pk2(P[BASE + 4], P[BASE + 5]), b1_ = pk2(P[BASE + 6], P[BASE + 7]);                          \
      auto r0 = __builtin_amdgcn_permlane32_swap(a0, b0_, false, false); auto r1 = __builtin_amdgcn_permlane32_swap(a1, b1_, false, false); \
      u32x4 w = {r0[0], r1[0], r0[1], r1[1]}; OUT = __builtin_bit_cast(bf16x8, w); } while (0)
      PK4(p0, 0, pa0); PK4(p0, 8, pa1); PK4(p1, 0, pa2); PK4(p1, 8, pa3);
#undef PK4
      const int vb = vb0 + cur * BUF;
      __builtin_amdgcn_s_setprio(1);
      pv_one<NDB, 0>(o[0], vb, pa0, pa1, pa2, pa3);
      pv_one<NDB, 1>(o[1], vb, pa0, pa1, pa2, pa3);
      if constexpr (NDB > 2) { pv_one<NDB, 2>(o[2], vb, pa0, pa1, pa2, pa3); pv_one<NDB, 3>(o[3], vb, pa0, pa1, pa2, pa3); }
      __builtin_amdgcn_s_setprio(0);
    }
    if (j + 2 < a.NT) swrite(nx2);
    if (rot && j + 1 < a.NT && tile_active(jt + 1)) qkt(nxt);
    __syncthreads();
    cur = nxt;
  }
  if (MODE == 2) l_reg += __builtin_amdgcn_exp2f(a.sink2 - m_reg);
  if (hi == 0) li_l[r32] = l_reg;
  asm volatile("s_waitcnt lgkmcnt(0)" ::: "memory");
#pragma unroll
  for (int r = 0; r < 16; ++r) {
    const int orow = crow(r, hi); const float rl = 1.0f / li_l[orow];
#pragma unroll
    for (int d = 0; d < NDB; ++d) a.Ow[(size_t)orow * a.ldo + d * 32 + r32] = f2bf(o[d][r] * rl);
  }
  __syncthreads();
}

#ifndef P8_SCL_SIGN
#define P8_SCL_SIGN 1
#endif
typedef short s16x2 __attribute__((ext_vector_type(2)));
#define MFMA32F8(a, b, c) __builtin_amdgcn_mfma_f32_32x32x16_fp8_fp8((a), (b), (c), 0, 0, 0)
typedef int i32x8u __attribute__((ext_vector_type(8)));
DI void mla_unit(const i32x8u (&q8)[3], const unsigned char* __restrict__ K8b, const unsigned char* __restrict__ Vt8b, int NT, int tl, bf16_t* Ow, char* smem) {
  constexpr int NDB = 4, KSTR = 192, VBUF = 8192, KBUF = 64 * KSTR, BUF = VBUF + KBUF;
  const int tid = threadIdx.x, wid = __builtin_amdgcn_readfirstlane(tid >> 6), lane = tid & 63, r32 = lane & 31, hi = lane >> 5;
  const bool rot = (wid >= 4);
  float* li_l = (float*)(smem + 3 * BUF) + wid * 64;
  float l_reg = 0.f; f32x16 o[NDB];
#pragma unroll
  for (int d = 0; d < NDB; ++d) o[d] = f32x16{};
  unsigned ksrc[2];
#pragma unroll
  for (int i = 0; i < 2; ++i) { const int q = i * 512 + tid, row = q / 12, pc = q - 12 * row, c = (pc & 12) | ((pc & 3) ^ ((row >> 2) & 3)); ksrc[i] = (unsigned)(row * 192 + c * 16); }
  const unsigned vsrc = (unsigned)((tid >> 2) * SEQ + 16 * ((tid & 3) ^ ((tid >> 4) & 3)));
  const char* K8base = (const char*)K8b; const char* Vbase = (const char*)Vt8b;
  auto stage = [&](int jt, int b) {
    const char* tk = K8base + (size_t)jt * (64 * 192); const char* tv = Vbase + (size_t)jt * 64; char* bp = smem + b * BUF + tid * 16;
    { unsigned off = vsrc; asm volatile("" : "+v"(off));
      __builtin_amdgcn_global_load_lds((const unsigned*)(tv + off), LDSP(bp), 16, 0, 0); }
    { unsigned off = ksrc[0]; asm volatile("" : "+v"(off)); __builtin_amdgcn_global_load_lds((const unsigned*)(tk + off), LDSP(bp + VBUF), 16, 0, 0); }
    if (wid < 4) { unsigned off = ksrc[1]; asm volatile("" : "+v"(off)); __builtin_amdgcn_global_load_lds((const unsigned*)(tk + off), LDSP(bp + VBUF + 8192), 16, 0, 0); }
  };
  f32x16 p0, p1;
#define DSR(dst, addr, OFF) asm volatile("ds_read_b128 %0, %1 offset:%2" : "=&v"(dst) : "v"(addr), "i"(OFF) : "memory")
#define QK_WAIT(n) do { asm volatile("s_waitcnt lgkmcnt(" #n ")" ::: "memory"); SBAR(); } while (0)
#define QK_RD(A0, A1, B0, B1, pb) do { DSR(A0, ka0, (pb) * 64); DSR(A1, ka1, (pb) * 64); DSR(B0, ka0, 32 * KSTR + (pb) * 64); DSR(B1, ka1, 32 * KSTR + (pb) * 64); } while (0)
#define CAT8(X, Y) (i32x8u){(int)(X)[0], (int)(X)[1], (int)(X)[2], (int)(X)[3], (int)(Y)[0], (int)(Y)[1], (int)(Y)[2], (int)(Y)[3]}
#define QK_MMA(A0, A1, B0, B1, pb) do { p0 = __builtin_amdgcn_mfma_scale_f32_32x32x64_f8f6f4(CAT8(A0, A1), q8[pb], p0, 0, 0, 0, 0x7f7f7f7f, 0, 0x7f7f7f7f); \
    p1 = __builtin_amdgcn_mfma_scale_f32_32x32x64_f8f6f4(CAT8(B0, B1), q8[pb], p1, 0, 0, 0, 0x7f7f7f7f, 0, 0x7f7f7f7f); SBAR(); } while (0)
  const int swz = (r32 >> 2) & 3;
  auto qkt = [&](int b) {
    const int kb = (int)(uintptr_t)(smem + b * BUF + VBUF) + r32 * KSTR;
    const int ka0 = kb + (((2 * hi) ^ swz) << 4), ka1 = kb + (((2 * hi + 1) ^ swz) << 4);
    p0 = f32x16{}; p1 = f32x16{};
    u32x4 a0, a1, a2, a3, b0, b1, b2, b3;
    __builtin_amdgcn_s_setprio(1);
    QK_RD(a0, a1, a2, a3, 0); QK_RD(b0, b1, b2, b3, 1);
    QK_WAIT(4); QK_MMA(a0, a1, a2, a3, 0); QK_RD(a0, a1, a2, a3, 2);
    QK_WAIT(4); QK_MMA(b0, b1, b2, b3, 1);
    QK_WAIT(0); QK_MMA(a0, a1, a2, a3, 2);
    __builtin_amdgcn_s_setprio(0);
  };
#define MLA_SYNC() do { asm volatile("s_waitcnt vmcnt(0) lgkmcnt(0)" ::: "memory"); __builtin_amdgcn_s_barrier(); asm volatile("" ::: "memory"); } while (0)
  stage(0, 0);
  if (NT > 1) stage(1, 1);
  MLA_SYNC();
  if (rot) qkt(0);
  int cur = 0;
  for (int j = 0; j < NT; ++j) {
    int nxt = cur + 1; if (nxt == 3) nxt = 0;
    int nx2 = nxt + 1; if (nx2 == 3) nx2 = 0;
    if (j + 2 < NT) stage(j + 2, nx2);
    if (!rot) qkt(cur);
    if (j == NT - 1) {
#pragma unroll
      for (int r = 0; r < 16; ++r) { const int kl = crow(r, hi); if (kl > tl) p0[r] = -INFINITY; if (kl + 32 > tl) p1[r] = -INFINITY; }
    }
#pragma unroll
    for (int r = 0; r < 16; ++r) { p0[r] = __builtin_amdgcn_exp2f(p0[r]); p1[r] = __builtin_amdgcn_exp2f(p1[r]); }
    float ps;
    {
      f32x2 s2 = {p0[0], p0[1]};
#pragma unroll
      for (int r = 2; r < 16; r += 2) s2 += f32x2{p0[r], p0[r + 1]};
#pragma unroll
      for (int r = 0; r < 16; r += 2) s2 += f32x2{p1[r], p1[r + 1]};
      ps = s2[0] + s2[1];
    }
    l_reg += ps;
    int ei;
    { auto rr = __builtin_amdgcn_permlane32_swap(__float_as_uint(ps), __float_as_uint(ps), false, false);
      ei = __builtin_amdgcn_frexp_expf(__uint_as_float(rr[0]) + __uint_as_float(rr[1])) - 7; }
    const float scl = __uint_as_float((unsigned)(P8_SCL_SIGN * ei + 127) << 23);
    i32x8u pa;
#pragma unroll
    for (int c = 0; c < 4; ++c) {
      s16x2 w0 = {0, 0}, w1 = {0, 0};
      w0 = __builtin_amdgcn_cvt_scalef32_pk_fp8_f32(w0, p0[4 * c], p0[4 * c + 1], scl, false); w0 = __builtin_amdgcn_cvt_scalef32_pk_fp8_f32(w0, p0[4 * c + 2], p0[4 * c + 3], scl, true);
      w1 = __builtin_amdgcn_cvt_scalef32_pk_fp8_f32(w1, p1[4 * c], p1[4 * c + 1], scl, false); w1 = __builtin_amdgcn_cvt_scalef32_pk_fp8_f32(w1, p1[4 * c + 2], p1[4 * c + 3], scl, true);
      auto rr = __builtin_amdgcn_permlane32_swap(__builtin_bit_cast(unsigned, w0), __builtin_bit_cast(unsigned, w1), false, false);
      pa[c] = (int)rr[0]; pa[4 + c] = (int)rr[1];
    }
    const int sc = ei + 127;
    if (rot && j + 1 < NT) qkt(nxt);
    u32x4 v0a, v0b, v1a, v1b, v2a, v2b, v3a, v3b;
    {
      const int vbs = (int)(uintptr_t)(smem + cur * BUF) + r32 * 64;
      const int va0 = vbs + (((2 * hi) ^ swz) << 4), va1 = vbs + (((2 * hi + 1) ^ swz) << 4);
      DSR(v0a, va0, 0); DSR(v0b, va1, 0); DSR(v1a, va0, 2048); DSR(v1b, va1, 2048); DSR(v2a, va0, 4096); DSR(v2b, va1, 4096); DSR(v3a, va0, 6144); DSR(v3b, va1, 6144);
      SBAR();
    }
    __builtin_amdgcn_s_setprio(1);
#define PV_MMA(D, X, Y) o[D] = __builtin_amdgcn_mfma_scale_f32_32x32x64_f8f6f4(pa, CAT8(X, Y), o[D], 0, 0, 0, sc, 0, 0x7f7f7f7f)
    QK_WAIT(6); PV_MMA(0, v0a, v0b); QK_WAIT(4); PV_MMA(1, v1a, v1b); QK_WAIT(2); PV_MMA(2, v2a, v2b); QK_WAIT(0); PV_MMA(3, v3a, v3b);
    SBAR();
#undef PV_MMA
    __builtin_amdgcn_s_setprio(0);
    if (j + 2 < NT) {
      if (wid < 4) asm volatile("s_waitcnt vmcnt(3) lgkmcnt(0)" ::: "memory"); else asm volatile("s_waitcnt vmcnt(2) lgkmcnt(0)" ::: "memory");
      __builtin_amdgcn_s_barrier(); asm volatile("" ::: "memory");
    } else MLA_SYNC();
    cur = nxt;
  }
  { auto rr = __builtin_amdgcn_permlane32_swap(__float_as_uint(l_reg), __float_as_uint(l_reg), false, false); l_reg = __uint_as_float(rr[0]) + __uint_as_float(rr[1]); }
  if (hi == 0) li_l[r32] = l_reg;
  asm volatile("s_waitcnt lgkmcnt(0)" ::: "memory");
  {
    int lo = hi * (4 * 512) + r32; asm volatile("" : "+v"(lo));
    bf16_t* Op = Ow + lo;
#pragma unroll
    for (int r = 0; r < 16; ++r) {
      const float rl = __builtin_amdgcn_rcpf(li_l[crow(r, hi)]);
#pragma unroll
      for (int d = 0; d < NDB; ++d) Op[((r & 3) + 8 * (r >> 2)) * 512 + d * 32] = f2bf(o[d][r] * rl);
    }
  }
  __syncthreads();
#undef MLA_SYNC
#undef DSR
#undef QK_WAIT
#undef CAT8
#undef QK_MMA
#undef QK_RD
}

typedef int i32x8 __attribute__((ext_vector_type(8)));
DI void mla_phase(const Params& p, char* smem) {
  const int tid = threadIdx.x, wid = __builtin_amdgcn_readfirstlane(tid >> 6), lane = tid & 63, r32 = lane & 31, hi = lane >> 5;
#ifndef MLA_REPS
#define MLA_REPS 1
#endif
  for (int kk = blockIdx.x; kk < 256 * MLA_REPS; kk += gridDim.x) {
    const int k = kk & 255;
#pragma unroll 1
    for (int half = 0; half < 2; ++half) {
      const int b = k & 1, i0 = k >> 1, i = half ? (255 - i0) : i0;
      const int head = wid >> 1, tq = i * 64 + (wid & 1) * 32 + r32;
      const size_t trow = (size_t)b * SEQ + tq;
      i32x8 q8[3];
      const bf16_t* qrow = p.qcat + trow * 768 + head * 192;
      auto pack4 = [](float a, float b, float c, float d) -> int { int w = 0; w = __builtin_amdgcn_cvt_pk_fp8_f32(a, b, w, false); w = __builtin_amdgcn_cvt_pk_fp8_f32(c, d, w, true); return w; };
#pragma unroll
      for (int pb = 0; pb < 2; ++pb) {
        const bf16_t* qp = qrow + 64 * pb + 32 * hi;
#pragma unroll
        for (int c = 0; c < 4; ++c) { const bf16x8 x = *(const bf16x8*)(qp + 8 * c);
          q8[pb][2 * c] = pack4(bf2f((bf16_t)x[0]), bf2f((bf16_t)x[1]), bf2f((bf16_t)x[2]), bf2f((bf16_t)x[3]));
          q8[pb][2 * c + 1] = pack4(bf2f((bf16_t)x[4]), bf2f((bf16_t)x[5]), bf2f((bf16_t)x[6]), bf2f((bf16_t)x[7])); }
      }
      {
        const float* rp = p.rope + trow * 64;
#pragma unroll
        for (int c = 0; c < 4; ++c) {
          const bf16x8 x1 = *(const bf16x8*)(qrow + 128 + 8 * c), x2 = *(const bf16x8*)(qrow + 160 + 8 * c);
          float v[8];
#pragma unroll
          for (int j = 0; j < 8; ++j) {
            const f32x2 cs = *(const f32x2*)(rp + 2 * (8 * c + j));
            const float a1 = bf2f((bf16_t)x1[j]), a2 = bf2f((bf16_t)x2[j]);
            v[j] = hi ? (a2 * cs[0] + a1 * cs[1]) : (a1 * cs[0] - a2 * cs[1]);
          }
          q8[2][2 * c] = pack4(v[0], v[1], v[2], v[3]); q8[2][2 * c + 1] = pack4(v[4], v[5], v[6], v[7]);
        }
      }
      mla_unit(q8, p.k8 + (size_t)b * SEQ * 192, p.vt8 + (size_t)b * SEQ * 128, i + 1, tq & 63, p.olat + ((size_t)b * SEQ + i * 64 + (wid & 1) * 32) * 512 + head * 128, smem);
    }
  }
}

DI void swa_phase(const Params& p, char* smem) {
  constexpr int KSTR = 144, KBUF = 64 * KSTR, VBUF = 64 * 64 * 2, BUF = KBUF + VBUF, NDB = 2;
  const int tid = threadIdx.x, wid = __builtin_amdgcn_readfirstlane(tid >> 6), lane = tid & 63, r32 = lane & 31, hi = lane >> 5;
  float* wsf = (float*)(smem + 6 * BUF) + wid * 64; float* li_l = wsf; float* al_l = wsf + 32;
  const int srow = tid >> 3, c8 = tid & 7;
  const int vb0 = (int)(uintptr_t)smem + v_rd_base(lane);
  for (int u = blockIdx.x; u < 256; u += gridDim.x) {
    const int kvh = u & 1, i = (u >> 1) & 63, b = u >> 7;
    const int jt0 = (i == 0) ? 0 : (4 * i - 2), NT = 4 * i + 4 - jt0;
    const bf16_t* Kb = p.ks + (size_t)b * SEQ * 128 + kvh * 64; const bf16_t* Vb = p.vs + (size_t)b * SEQ * 128 + kvh * 64;
    {
      bf16x8 kst[6], vst[6];
#pragma unroll
      for (int j = 0; j < 6; ++j) if (j < NT) { const size_t krow = (size_t)((jt0 + j) * 64 + srow) * 128 + 8 * c8; kst[j] = *(const bf16x8*)(Kb + krow); vst[j] = *(const bf16x8*)(Vb + krow); }
#pragma unroll
      for (int j = 0; j < 6; ++j) if (j < NT) { char* bp = smem + j * BUF; *(bf16x8*)(bp + VBUF + srow * KSTR + 16 * c8) = kst[j]; *(bf16x8*)(bp + v_st<NDB>(srow, 8 * c8)) = vst[j]; }
    }
    __syncthreads();
    const int tw0 = i * 256 + wid * 32, tq = tw0 + r32;
    const size_t trow = (size_t)b * SEQ + tq;
#pragma unroll 1
    for (int g = 0; g < 4; ++g) {
      const int h = kvh * 4 + g;
      bf16x8 qr[4];
      const bf16_t* qp = p.qs + trow * 512 + h * 64 + hi * 8;
#pragma unroll
      for (int s = 0; s < 4; ++s) qr[s] = *(const bf16x8*)(qp + s * 16);
      const float slope2 = exp2f(-(float)(h + 1)) * LOG2E, sink2 = p.swa_sinks[h] * LOG2E;
      float m_reg = -1e30f, l_reg = 0.f; f32x16 o[NDB];
#pragma unroll
      for (int d = 0; d < NDB; ++d) o[d] = f32x16{};
      for (int j = 0; j < NT; ++j) {
        const int jt = jt0 + j;
        if (!((jt * 64 + 63 >= tw0 - 127) && (jt * 64 <= tw0 + 31))) continue;
        f32x16 p0 = f32x16{}, p1 = f32x16{};
        const char* Kc = smem + j * BUF + VBUF + r32 * KSTR + hi * 16;
#pragma unroll
        for (int s = 0; s < 4; ++s) {
          const bf16x8 b0 = *(const bf16x8*)(Kc + s * 32), b1 = *(const bf16x8*)(Kc + 32 * KSTR + s * 32);
          p0 = MFMA32(b0, qr[s], p0); p1 = MFMA32(b1, qr[s], p1);
        }
#pragma unroll
        for (int r = 0; r < 16; ++r) {
          const int d0 = tq - (jt * 64 + crow(r, hi)), d1 = d0 - 32;
          p0[r] = (d0 >= 0 && d0 < 128) ? p0[r] - slope2 * (float)d0 : -INFINITY;
          p1[r] = (d1 >= 0 && d1 < 128) ? p1[r] - slope2 * (float)d1 : -INFINITY;
        }
        float pmax = p0[0];
#pragma unroll
        for (int r = 1; r < 16; ++r) pmax = fmaxf(pmax, p0[r]);
#pragma unroll
        for (int r = 0; r < 16; ++r) pmax = fmaxf(pmax, p1[r]);
        { auto rr = __builtin_amdgcn_permlane32_swap(__float_as_uint(pmax), __float_as_uint(pmax), false, false); pmax = fmaxf(__uint_as_float(rr[0]), __uint_as_float(rr[1])); }
        float mn, alpha;
        if (__all(pmax - m_reg <= SM_THR)) { mn = m_reg; alpha = 1.f; }
        else { mn = fmaxf(m_reg, pmax); alpha = __builtin_amdgcn_exp2f(m_reg - mn); m_reg = mn; }
#pragma unroll
        for (int r = 0; r < 16; ++r) { p0[r] = __builtin_amdgcn_exp2f(p0[r] - mn); p1[r] = __builtin_amdgcn_exp2f(p1[r] - mn); }
        float ps = 0.f;
#pragma unroll
        for (int r = 0; r < 16; ++r) ps += p0[r] + p1[r];
        { auto rr = __builtin_amdgcn_permlane32_swap(__float_as_uint(ps), __float_as_uint(ps), false, false); ps = __uint_as_float(rr[0]) + __uint_as_float(rr[1]); }
        l_reg = l_reg * alpha + ps;
        if (__any(alpha < 1.f)) {
          if (hi == 0) al_l[r32] = alpha;
          asm volatile("s_waitcnt lgkmcnt(0)" ::: "memory");
#pragma unroll
          for (int r = 0; r < 16; ++r) { const float al = al_l[crow(r, hi)];
#pragma unroll
            for (int d = 0; d < NDB; ++d) o[d][r] *= al; }
        }
        bf16x8 pa0, pa1, pa2, pa3;
#define PK4(P, BASE, OUT) do { const unsigned a0 = pk2(P[BASE + 0], P[BASE + 1]), a1 = pk2(P[BASE + 2], P[BASE + 3]);   \
        const unsigned b0_ = pk2(P[BASE + 4], P[BASE + 5]), b1_ = pk2(P[BASE + 6], P[BASE + 7]);                          \
        auto r0 = __builtin_amdgcn_permlane32_swap(a0, b0_, false, false); auto r1 = __builtin_amdgcn_permlane32_swap(a1, b1_, false, false); \
        u32x4 w = {r0[0], r1[0], r0[1], r1[1]}; OUT = __builtin_bit_cast(bf16x8, w); } while (0)
        PK4(p0, 0, pa0); PK4(p0, 8, pa1); PK4(p1, 0, pa2); PK4(p1, 8, pa3);
#undef PK4
        const int vb = vb0 + j * BUF;
        pv_one<NDB, 0>(o[0], vb, pa0, pa1, pa2, pa3);
        pv_one<NDB, 1>(o[1], vb, pa0, pa1, pa2, pa3);
      }
      l_reg += __builtin_amdgcn_exp2f(sink2 - m_reg);
      if (hi == 0) li_l[r32] = l_reg;
      asm volatile("s_waitcnt lgkmcnt(0)" ::: "memory");
      bf16_t* Ow = p.ob + ((size_t)b * SEQ + tw0) * 512 + h * 64;
#pragma unroll
      for (int r = 0; r < 16; ++r) {
        const int orow = crow(r, hi); const float rl = __builtin_amdgcn_rcpf(li_l[orow]);
#pragma unroll
        for (int d = 0; d < NDB; ++d) Ow[(size_t)orow * 512 + d * 32 + r32] = f2bf(o[d][r] * rl);
      }
      asm volatile("s_waitcnt lgkmcnt(0)" ::: "memory");
    }
    __syncthreads();
  }
}

DI void xattn_phase(const Params& p, char* smem) {
  const int tid = threadIdx.x, wid = __builtin_amdgcn_readfirstlane(tid >> 6), lane = tid & 63, r32 = lane & 31, hi = lane >> 5;
  for (int u = blockIdx.x; u < 512; u += gridDim.x) {
    const int h = u & 3, i = (u >> 2) & 63, b = u >> 8;
    const int tq = i * 256 + wid * 32 + r32;
    const size_t trow = (size_t)b * SEQ + tq;
    bf16x8 qr[8];
    const bf16_t* qp = p.qx + trow * 512 + h * 128 + hi * 8;
#pragma unroll
    for (int s = 0; s < 8; ++s) qr[s] = *(const bf16x8*)(qp + s * 16);
    AttnArgs<128, 128, 1> a;
    a.Kb = p.kvc + (size_t)b * 256 * 1024 + h * 128; a.ldk = 1024; a.Vb = a.Kb + 512; a.ldv = 1024;
    a.jt0 = 0; a.NT = 4; a.tq = tq; a.diag_tile = -1; a.tw0 = 0; a.slope2 = 0.f; a.sink2 = 0.f;
    a.Ow = p.ox + ((size_t)b * SEQ + i * 256 + wid * 32) * 512 + h * 128; a.ldo = 512;
    attn_unit<128, 128, 1, 0>(qr, a, smem);
  }
}

DI void norm_rows_1024(const float* in, const float* gain, bf16_t* out, int nrows) {
  const int lane = threadIdx.x & 63, gw = (blockIdx.x * NTHREADS + threadIdx.x) >> 6, nw = gridDim.x * (NTHREADS / 64);
  for (int t = gw; t < nrows; t += nw) {
    const float* xr = in + (size_t)t * 1024;
    f32x4 v[4]; float ss = 0.f;
#pragma unroll
    for (int i = 0; i < 4; ++i) { v[i] = *(const f32x4*)(xr + 256 * i + 4 * lane); ss += v[i][0] * v[i][0] + v[i][1] * v[i][1] + v[i][2] * v[i][2] + v[i][3] * v[i][3]; }
    ss = wave_sum(ss);
    const float rstd = rsqrtf(ss * (1.0f / 1024.0f) + EPS);
#pragma unroll
    for (int i = 0; i < 4; ++i) {
      const f32x4 g = *(const f32x4*)(gain + 256 * i + 4 * lane);
      u32x2 w = {pk2(v[i][0] * rstd * g[0], v[i][1] * rstd * g[1]), pk2(v[i][2] * rstd * g[2], v[i][3] * rstd * g[3])};
      *(u32x2*)(out + (size_t)t * 1024 + 256 * i + 4 * lane) = w;
    }
  }
}

DI void norm_rows_bf16(const bf16_t* in, const float* gain, bf16_t* out, int nrows) {
  const int lane = threadIdx.x & 63, gw = (blockIdx.x * NTHREADS + threadIdx.x) >> 6, nw = gridDim.x * (NTHREADS / 64);
  for (int t = gw; t < nrows; t += nw) {
    const bf16_t* xr = in + (size_t)t * 1024 + 8 * lane;
    float v[16]; float ss = 0.f;
#pragma unroll
    for (int i = 0; i < 2; ++i) { const u32x4 w = *(const u32x4*)(xr + 512 * i);
#pragma unroll
      for (int j = 0; j < 4; ++j) { v[8 * i + 2 * j] = bflo(w[j]); v[8 * i + 2 * j + 1] = bfhi(w[j]); } }
#pragma unroll
    for (int j = 0; j < 16; ++j) ss += v[j] * v[j];
    ss = wave_sum(ss);
    const float rstd = rsqrtf(ss * (1.0f / 1024.0f) + EPS);
#pragma unroll
    for (int i = 0; i < 2; ++i) {
      const f32x4 g0 = *(const f32x4*)(gain + 512 * i + 8 * lane), g1 = *(const f32x4*)(gain + 512 * i + 8 * lane + 4);
      *(u32x4*)(out + (size_t)t * 1024 + 512 * i + 8 * lane) = u32x4{pk2(v[8 * i] * rstd * g0[0], v[8 * i + 1] * rstd * g0[1]), pk2(v[8 * i + 2] * rstd * g0[2], v[8 * i + 3] * rstd * g0[3]),
                                                                    pk2(v[8 * i + 4] * rstd * g1[0], v[8 * i + 5] * rstd * g1[1]), pk2(v[8 * i + 6] * rstd * g1[2], v[8 * i + 7] * rstd * g1[3])};
    }
  }
}

DI void latent_pass(const Params& p, char* smem) {
  const int tid = threadIdx.x, lane = tid & 63, wid = __builtin_amdgcn_readfirstlane(tid >> 6);
  unsigned char* st = (unsigned char*)smem;
  for (int tile = blockIdx.x; tile < T / 64; tile += gridDim.x) {
#pragma unroll 2
    for (int i = 0; i < 8; ++i) {
      const int tk = wid * 8 + i, t = tile * 64 + tk;
      const bf16_t* lr = p.lat + (size_t)t * 448;
      const u32x2 cq = *(const u32x2*)(lr + 4 * lane);
      const float q0 = bflo(cq[0]), q1 = bfhi(cq[0]), q2 = bflo(cq[1]), q3 = bfhi(cq[1]);
      const float ssq = wave_sum(q0 * q0 + q1 * q1 + q2 * q2 + q3 * q3);
      const float rq = rsqrtf(ssq * (1.0f / 256.0f) + EPS);
      const f32x4 gq = *(const f32x4*)(p.q_a_norm + 4 * lane);
      *(u32x2*)(p.cqn + (size_t)t * 256 + 4 * lane) = u32x2{pk2(q0 * rq * gq[0], q1 * rq * gq[1]), pk2(q2 * rq * gq[2], q3 * rq * gq[3])};
      const unsigned ck = *(const unsigned*)(lr + 256 + 2 * lane);
      const float k0 = bflo(ck), k1 = bfhi(ck);
      const float ssk = wave_sum(k0 * k0 + k1 * k1);
      const float rk = rsqrtf(ssk * (1.0f / 128.0f) + EPS);
      const f32x2 gk = *(const f32x2*)(p.kv_a_norm + 2 * lane);
      const float kn0 = k0 * rk * gk[0], kn1 = k1 * rk * gk[1];
      unsigned char* k8r = p.k8 + (size_t)t * 192;
      *(unsigned short*)(k8r + 2 * lane) = (unsigned short)__builtin_amdgcn_cvt_pk_fp8_f32(kn0 * 0.125f, kn1 * 0.125f, 0, false);
      *(unsigned short*)(st + tk * 128 + 2 * lane) = (unsigned short)__builtin_amdgcn_cvt_pk_fp8_f32(kn0, kn1, 0, false);
      if (lane < 32) {
        const float x1 = bf2f(lr[384 + lane]), x2 = bf2f(lr[416 + lane]);
        const f32x2 cs = *(const f32x2*)(p.rope + (size_t)t * 64 + 2 * lane);
        const float r1 = x1 * cs[0] - x2 * cs[1], r2 = x2 * cs[0] + x1 * cs[1];
        const int pk = __builtin_amdgcn_cvt_pk_fp8_f32(r1 * 0.125f, r2 * 0.125f, 0, false);
        k8r[128 + lane] = (unsigned char)(pk & 0xff); k8r[160 + lane] = (unsigned char)((pk >> 8) & 0xff);
      }
    }
    __syncthreads();
    {
      const int d = tid >> 2, part = tid & 3, k0 = 32 * (part >> 1) + 4 * (part & 1);
      unsigned w[4];
#pragma unroll
      for (int c = 0; c < 4; ++c) {
        unsigned v = 0;
#pragma unroll
        for (int e = 0; e < 4; ++e) v |= (unsigned)st[(k0 + e + 8 * c) * 128 + d] << (8 * e);
        w[c] = v;
      }
      const int t0 = tile * 64, b = t0 / SEQ, s0 = t0 - b * SEQ;
      *(u32x4*)(p.vt8 + ((size_t)b * 128 + d) * SEQ + s0 + 16 * part) = u32x4{w[0], w[1], w[2], w[3]};
    }
    __syncthreads();
  }
}

DI void mix_pass(const Params& p) {
  const int lane = threadIdx.x & 63, gw = (blockIdx.x * NTHREADS + threadIdx.x) >> 6, nw = gridDim.x * (NTHREADS / 64);
  for (int t = gw; t < T; t += nw) {
#pragma unroll
    for (int part = 0; part < 2; ++part) {
      const bf16_t* src = (part ? p.ob : p.oa) + (size_t)t * 512 + 8 * lane;
      const float* g = (part ? p.out_norm_swa : p.out_norm_mla) + 8 * lane;
      const u32x4 w = *(const u32x4*)src;
      float v[8] = {bflo(w[0]), bfhi(w[0]), bflo(w[1]), bfhi(w[1]), bflo(w[2]), bfhi(w[2]), bflo(w[3]), bfhi(w[3])};
      float ss = 0.f;
#pragma unroll
      for (int j = 0; j < 8; ++j) ss += v[j] * v[j];
      ss = wave_sum(ss);
      const float rs = rsqrtf(ss * (1.0f / 512.0f) + EPS);
      const f32x4 g0 = *(const f32x4*)g, g1 = *(const f32x4*)(g + 4);
      u32x4 o = {pk2(v[0] * rs * g0[0], v[1] * rs * g0[1]), pk2(v[2] * rs * g0[2], v[3] * rs * g0[3]), pk2(v[4] * rs * g1[0], v[5] * rs * g1[1]), pk2(v[6] * rs * g1[2], v[7] * rs * g1[3])};
      *(u32x4*)(p.xn + (size_t)t * 1024 + part * 512 + 8 * lane) = o;
    }
  }
}

DI float gelu_exact(float x) { return 0.5f * x * (1.0f + erff(x * 0.70710678118654752f)); }
DI float wave_max(float v) {
#pragma unroll
  for (int o = 32; o >= 1; o >>= 1) v = fmaxf(v, __shfl_xor(v, o));
  return v;
}
DI void peer_pass(const Params& p, float* outbuf, int rowmask) {
  const int lane = threadIdx.x & 63, gw = (blockIdx.x * NTHREADS + threadIdx.x) >> 6, nw = gridDim.x * (NTHREADS / 64);
  const int b5 = (lane >> 5) & 1, b4 = (lane >> 4) & 1, b3 = (lane >> 3) & 1, b2 = (lane >> 2) & 1, kL = (lane >> 2) & 15;
  for (int t = gw; t < T; t += nw) {
    const bf16_t* hr = p.xn + (size_t)t * 1024 + 16 * lane;
    const u32x4 ha = *(const u32x4*)hr, hb = *(const u32x4*)(hr + 8);
    float hv[16];
#pragma unroll
    for (int j = 0; j < 4; ++j) { const unsigned wa = ha[j], wb = hb[j]; hv[2 * j] = bflo(wa); hv[2 * j + 1] = bfhi(wa); hv[8 + 2 * j] = bflo(wb); hv[8 + 2 * j + 1] = bfhi(wb); }
    float hm = 0.f;
#pragma unroll
    for (int j = 0; j < 16; ++j) hm = fmaxf(hm, fabsf(hv[j]));
    hm = fmaxf(wave_max(hm), 1e-20f);
    const float sh = hm * (1.0f / 127.0f), ih = 127.0f / hm;
    int hq[4];
#pragma unroll
    for (int q = 0; q < 4; ++q) {
      const int q0 = (int)rintf(hv[4 * q] * ih), q1 = (int)rintf(hv[4 * q + 1] * ih), q2 = (int)rintf(hv[4 * q + 2] * ih), q3 = (int)rintf(hv[4 * q + 3] * ih);
      hq[q] = (q0 & 255) | ((q1 & 255) << 8) | ((q2 & 255) << 16) | (q3 << 24);
    }
    const int e0 = p.pidx[(size_t)t * 128 + lane], e1 = p.pidx[(size_t)t * 128 + 64 + lane];
    const float su0 = p.su[2 * e0] * sh, su1 = p.su[2 * e1] * sh;
    const float gv0 = p.pg[(size_t)t * 128 + lane] * p.su[2 * e0 + 1], gv1 = p.pg[(size_t)t * 128 + 64 + lane] * p.su[2 * e1 + 1];
    float acc[16];
#pragma unroll
    for (int j = 0; j < 16; ++j) acc[j] = 0.f;
    float csum = 0.f;
#pragma unroll 1
    for (int hd = 0; hd < 8; ++hd) {
      const int esel = (hd < 4) ? e0 : e1;
      const int lbase = (hd & 3) * 16;
      u32x4 ub[16], vb[16];
#pragma unroll
      for (int k = 0; k < 16; ++k) {
        const int idx = __builtin_amdgcn_readlane(esel, lbase + k);
        ub[k] = *(const u32x4*)(p.u_q + (size_t)idx * 1024 + 16 * lane);
        vb[k] = *(const u32x4*)(p.v_q + (size_t)idx * 1024 + 16 * lane);
      }
      int pd[16];
#pragma unroll
      for (int k = 0; k < 16; ++k) {
        int d = 0;
#pragma unroll
        for (int q = 0; q < 4; ++q) { const int a = (int)ub[k][q]; d = __builtin_amdgcn_sdot4(a, hq[q], d, false); }
        pd[k] = d;
      }
      int q8[8], q4[4], q2[2], q1;
#pragma unroll
      for (int k = 0; k < 8; ++k) { const int keep = b5 ? pd[k + 8] : pd[k], send = b5 ? pd[k] : pd[k + 8]; q8[k] = keep + __shfl_xor(send, 32); }
#pragma unroll
      for (int k = 0; k < 4; ++k) { const int keep = b4 ? q8[k + 4] : q8[k], send = b4 ? q8[k] : q8[k + 4]; q4[k] = keep + __shfl_xor(send, 16); }
#pragma unroll
      for (int k = 0; k < 2; ++k) { const int keep = b3 ? q4[k + 2] : q4[k], send = b3 ? q4[k] : q4[k + 2]; q2[k] = keep + __shfl_xor(send, 8); }
      { const int keep = b2 ? q2[1] : q2[0], send = b2 ? q2[0] : q2[1]; q1 = keep + __shfl_xor(send, 4); }
      q1 += __shfl_xor(q1, 2); q1 += __shfl_xor(q1, 1);
      const float suk = __shfl((hd < 4) ? su0 : su1, lbase + kL), gvk = __shfl((hd < 4) ? gv0 : gv1, lbase + kL);
      const float dtot = (float)q1 * suk;
      const float c = DBG_PEER * gvk * gelu_exact(dtot);
#pragma unroll
      for (int k = 0; k < 16; ++k) {
        const float ck = __uint_as_float(__builtin_amdgcn_readlane(__float_as_uint(c), 4 * k));
        csum += ck;
#pragma unroll
        for (int q = 0; q < 4; ++q) {
          const unsigned w = vb[k][q];
          acc[4 * q] += ck * (float)(w & 0xff); acc[4 * q + 1] += ck * (float)((w >> 8) & 0xff); acc[4 * q + 2] += ck * (float)((w >> 16) & 0xff); acc[4 * q + 3] += ck * (float)(w >> 24);
        }
      }
    }
    const float* xr = p.X + (size_t)t * 1024 + 16 * lane; float* orow = outbuf + (size_t)(t & rowmask) * 1024 + 16 * lane;
    float y[16]; float ss = 0.f;
#pragma unroll
    for (int q = 0; q < 4; ++q) {
      const f32x4 xv = *(const f32x4*)(xr + 4 * q);
#pragma unroll
      for (int j = 0; j < 4; ++j) { const float v = xv[j] + (acc[4 * q + j] - 128.0f * csum); y[4 * q + j] = v; ss += v * v; }
    }
    ss = wave_sum(ss);
    const float rstd = rsqrtf(ss * (1.0f / 1024.0f) + EPS);
#pragma unroll
    for (int q = 0; q < 4; ++q) {
      const f32x4 g = *(const f32x4*)(p.norm_final + 16 * lane + 4 * q);
      f32x4 ov;
#pragma unroll
      for (int j = 0; j < 4; ++j) ov[j] = y[4 * q + j] * rstd * g[j];
      *(f32x4*)(orow + 4 * q) = ov;
    }
  }
}

DI void norm_rows_ffn(const Params& p) {
  const int lane = threadIdx.x & 63, gw = (blockIdx.x * NTHREADS + threadIdx.x) >> 6, nw = gridDim.x * (NTHREADS / 64);
  for (int t = gw; t < T; t += nw) {
    const bf16_t* xr = p.X16 + (size_t)t * 1024;
    f32x4 v[4]; float ss = 0.f;
#pragma unroll
    for (int i = 0; i < 4; ++i) { const u32x2 w = *(const u32x2*)(xr + 256 * i + 4 * lane); v[i] = f32x4{bflo(w[0]), bfhi(w[0]), bflo(w[1]), bfhi(w[1])};
      ss += v[i][0] * v[i][0] + v[i][1] * v[i][1] + v[i][2] * v[i][2] + v[i][3] * v[i][3]; }
    ss = wave_sum(ss);
    const float rstd = rsqrtf(ss * (1.0f / 1024.0f) + EPS);
    float hm = 0.f;
#pragma unroll
    for (int i = 0; i < 4; ++i) {
      const f32x4 g = *(const f32x4*)(p.norm_ffn + 256 * i + 4 * lane);
#pragma unroll
      for (int j = 0; j < 4; ++j) { v[i][j] = v[i][j] * rstd * g[j]; hm = fmaxf(hm, fabsf(v[i][j])); }
      *(u32x2*)(p.xn + (size_t)t * 1024 + 256 * i + 4 * lane) = u32x2{pk2(v[i][0], v[i][1]), pk2(v[i][2], v[i][3])};
    }
    hm = fmaxf(wave_max(hm), 1e-20f);
    const float ih = 127.0f / hm;
#pragma unroll
    for (int i = 0; i < 4; ++i) {
      const int q0 = (int)rintf(v[i][0] * ih), q1 = (int)rintf(v[i][1] * ih), q2 = (int)rintf(v[i][2] * ih), q3 = (int)rintf(v[i][3] * ih);
      *(unsigned*)(p.hq + (size_t)t * 1024 + 256 * i + 4 * lane) = (unsigned)(q0 & 255) | ((unsigned)(q1 & 255) << 8) | ((unsigned)(q2 & 255) << 16) | ((unsigned)q3 << 24);
    }
    if (lane == 0) p.sh[t] = hm * (1.0f / 127.0f);
  }
}
DI void peer_dots(const Params& p) {
  const int lane = threadIdx.x & 63, wid = threadIdx.x >> 6, xs = (blockIdx.x & 7) >> 1, r = lane >> 3, ch = lane & 7;
  const int wp = ((blockIdx.x >> 3) * 2 + (blockIdx.x & 1)) * (NTHREADS / 64) + wid, nwp = (gridDim.x >> 2) * (NTHREADS / 64);
  const int b0 = lane & 1, b1 = (lane >> 1) & 1, b2 = (lane >> 2) & 1;
  int* dp = p.dpartA + (size_t)xs * T * 128;
  const unsigned char* ub = p.u_q + 128 * xs + 16 * ch;
  typedef int i32x2 __attribute__((ext_vector_type(2)));
  i32x4 iv[4]; u32x4 hlo, hhi;
  if (wp < T) {
    const int* ip = p.pidx + (size_t)wp * 128 + 16 * r;
#pragma unroll
    for (int q = 0; q < 4; ++q) iv[q] = *(const i32x4*)(ip + 4 * q);
    const unsigned char* hp = p.hq + (size_t)wp * 1024 + 256 * xs + 32 * ch;
    hlo = *(const u32x4*)hp; hhi = *(const u32x4*)(hp + 16);
  }
  for (int t = wp; t < T; t += nwp) {
    u32x4 uv[16];
#pragma unroll
    for (int g = 0; g < 16; ++g) uv[g] = *(const u32x4*)(ub + (size_t)iv[g >> 2][g & 3] * 512);
    int hl[4], hh[4];
#pragma unroll
    for (int q = 0; q < 4; ++q) { hl[q] = (int)hlo[q]; hh[q] = (int)hhi[q]; }
    int hsum = 0;
#pragma unroll
    for (int q = 0; q < 4; ++q) { hsum = __builtin_amdgcn_sdot4(hl[q], 0x01010101, hsum, false); hsum = __builtin_amdgcn_sdot4(hh[q], 0x01010101, hsum, false); }
    const int tn = (t + nwp < T) ? t + nwp : t;
    {
      const int* ip = p.pidx + (size_t)tn * 128 + 16 * r;
#pragma unroll
      for (int q = 0; q < 4; ++q) iv[q] = *(const i32x4*)(ip + 4 * q);
      const unsigned char* hp = p.hq + (size_t)tn * 1024 + 256 * xs + 32 * ch;
      hlo = *(const u32x4*)hp; hhi = *(const u32x4*)(hp + 16);
    }
    int v[16];
#pragma unroll
    for (int g = 0; g < 16; ++g) {
      int d = -8 * hsum;
#pragma unroll
      for (int q = 0; q < 4; ++q) {
        const unsigned w = uv[g][q]; const int lo = (int)(w & 0x0F0F0F0Fu), hi = (int)((w >> 4) & 0x0F0F0F0Fu);
        d = __builtin_amdgcn_sdot4(lo, hl[q], d, false); d = __builtin_amdgcn_sdot4(hi, hh[q], d, false);
      }
      v[g] = d;
    }
    int w8[8], w4[4], w2[2];
#pragma unroll
    for (int k = 0; k < 8; ++k) { const int keep = b2 ? v[k + 8] : v[k], send = b2 ? v[k] : v[k + 8]; w8[k] = keep + __shfl_xor(send, 4); }
#pragma unroll
    for (int k = 0; k < 4; ++k) { const int keep = b1 ? w8[k + 4] : w8[k], send = b1 ? w8[k] : w8[k + 4]; w4[k] = keep + __shfl_xor(send, 2); }
#pragma unroll
    for (int k = 0; k < 2; ++k) { const int keep = b0 ? w4[k + 2] : w4[k], send = b0 ? w4[k] : w4[k + 2]; w2[k] = keep + __shfl_xor(send, 1); }
    *(i32x2*)(dp + (size_t)t * 128 + 16 * r + 2 * ch) = i32x2{w2[0], w2[1]};
  }
}
DI void peer_coef(const Params& p) {
  const size_t n = (size_t)T * 128;
  for (size_t it = (size_t)blockIdx.x * NTHREADS + threadIdx.x; it < n; it += (size_t)gridDim.x * NTHREADS) {
    int d = 0;
#pragma unroll
    for (int x = 0; x < 4; ++x) d += p.dpartA[(size_t)x * n + it];
    const int e = p.pidx[it];
    const f32x2 sc2 = *(const f32x2*)(p.su + 2 * (size_t)e);
    const float dt = (float)d * sc2[0] * p.sh[it >> 7];
    p.cbuf[it] = DBG_PEER * p.pg[it] * gelu_exact(dt) * sc2[1];
  }
}
DI void peer_accum(const Params& p, bf16_t* Xout, int rowmask) {
  const int lane = threadIdx.x & 63, wid = threadIdx.x >> 6, xs = (blockIdx.x & 7) >> 1, r = lane >> 3, ch = lane & 7;
  const int wp = ((blockIdx.x >> 3) * 2 + (blockIdx.x & 1)) * (NTHREADS / 64) + wid, nwp = (gridDim.x >> 2) * (NTHREADS / 64);
  const int b3 = (lane >> 3) & 1, b4 = (lane >> 4) & 1, b5 = (lane >> 5) & 1;
  const unsigned char* vbp = p.v_q + 128 * xs + 16 * ch;
  const size_t xoff = (size_t)256 * xs + 32 * ch + 4 * r;
  if (wp >= T) return;
  i32x4 ivA[2], ivB[2]; f32x4 cvA[4], cvN[4]; i32x4 ivN[4];
  u32x4 ra[8], rb[8];
  u32x2 xv, xvN;
#define LOAD_META(tt, IV, CV) do { const int* ip_ = p.pidx + (size_t)(tt) * 128 + 16 * r; const float* cp_ = p.cbuf + (size_t)(tt) * 128 + 16 * r; \
    _Pragma("unroll") for (int q_ = 0; q_ < 4; ++q_) { IV[q_] = *(const i32x4*)(ip_ + 4 * q_); CV[q_] = *(const f32x4*)(cp_ + 4 * q_); } } while (0)
#define LOAD_ROWS(R, I0, I1) do { _Pragma("unroll") for (int g_ = 0; g_ < 4; ++g_) { R[g_] = *(const u32x4*)(vbp + (size_t)I0[g_] * 512); R[4 + g_] = *(const u32x4*)(vbp + (size_t)I1[g_] * 512); } } while (0)
#define ACCUM(R, C0, C1) do { _Pragma("unroll") for (int g_ = 0; g_ < 8; ++g_) { const float cg_ = (g_ < 4) ? C0[g_ & 3] : C1[g_ & 3]; const f32x2 cgv_ = {cg_, cg_}; \
    _Pragma("unroll") for (int q_ = 0; q_ < 4; ++q_) { const unsigned w_ = R[g_][q_]; \
      acc2[4 * q_] += cgv_ * __builtin_amdgcn_cvt_scalef32_pk_f32_fp4(w_, 1.0f, 0); acc2[4 * q_ + 1] += cgv_ * __builtin_amdgcn_cvt_scalef32_pk_f32_fp4(w_, 1.0f, 1); \
      acc2[4 * q_ + 2] += cgv_ * __builtin_amdgcn_cvt_scalef32_pk_f32_fp4(w_, 1.0f, 2); acc2[4 * q_ + 3] += cgv_ * __builtin_amdgcn_cvt_scalef32_pk_f32_fp4(w_, 1.0f, 3); } \
    SBAR(); } } while (0)
  LOAD_META(wp, ivN, cvN);
  ivA[0] = ivN[0]; ivA[1] = ivN[1]; ivB[0] = ivN[2]; ivB[1] = ivN[3];
#pragma unroll
  for (int q = 0; q < 4; ++q) cvA[q] = cvN[q];
  LOAD_ROWS(ra, ivA[0], ivA[1]);
  xv = *(const u32x2*)(p.X16 + (size_t)wp * 1024 + xoff);
  for (int t = wp; t < T; t += nwp) {
    const int tn = (t + nwp < T) ? t + nwp : t;
    f32x2 acc2[16];
#pragma unroll
    for (int j = 0; j < 16; ++j) acc2[j] = f32x2{0.f, 0.f};
    LOAD_ROWS(rb, ivB[0], ivB[1]);
    LOAD_META(tn, ivN, cvN);
    xvN = *(const u32x2*)(p.X16 + (size_t)tn * 1024 + xoff);
    ACCUM(ra, cvA[0], cvA[1]);
    ivA[0] = ivN[0]; ivA[1] = ivN[1]; ivB[0] = ivN[2]; ivB[1] = ivN[3];
    LOAD_ROWS(ra, ivA[0], ivA[1]);
    ACCUM(rb, cvA[2], cvA[3]);
#pragma unroll
    for (int q = 0; q < 4; ++q) cvA[q] = cvN[q];
    float acc[32];
#pragma unroll
    for (int j = 0; j < 16; ++j) { acc[2 * j] = acc2[j][0]; acc[2 * j + 1] = acc2[j][1]; }
    float w16[16], w8[8], w4[4];
#pragma unroll
    for (int k = 0; k < 16; ++k) { const float keep = b5 ? acc[k + 16] : acc[k], send = b5 ? acc[k] : acc[k + 16]; w16[k] = keep + __shfl_xor(send, 32); }
#pragma unroll
    for (int k = 0; k < 8; ++k) { const float keep = b4 ? w16[k + 8] : w16[k], send = b4 ? w16[k] : w16[k + 8]; w8[k] = keep + __shfl_xor(send, 16); }
#pragma unroll
    for (int k = 0; k < 4; ++k) { const float keep = b3 ? w8[k + 4] : w8[k], send = b3 ? w8[k] : w8[k + 4]; w4[k] = keep + __shfl_xor(send, 8); }
    *(u32x2*)(Xout + (size_t)(t & rowmask) * 1024 + xoff) = u32x2{pk2(bflo(xv[0]) + w4[0], bfhi(xv[0]) + w4[1]), pk2(bflo(xv[1]) + w4[2], bfhi(xv[1]) + w4[3])};
    xv = xvN;
  }
#undef LOAD_META
#undef LOAD_ROWS
#undef ACCUM
}
DI void final_norm(const Params& p) {
  const int lane = threadIdx.x & 63, gw = (blockIdx.x * NTHREADS + threadIdx.x) >> 6, nw = gridDim.x * (NTHREADS / 64);
  for (int t = gw; t < T; t += nw) {
    const bf16_t* xr = p.X16 + (size_t)t * 1024;
    f32x4 v[4]; float ss = 0.f;
#pragma unroll
    for (int i = 0; i < 4; ++i) { const u32x2 w = *(const u32x2*)(xr + 256 * i + 4 * lane); v[i] = f32x4{bflo(w[0]), bfhi(w[0]), bflo(w[1]), bfhi(w[1])};
      ss += v[i][0] * v[i][0] + v[i][1] * v[i][1] + v[i][2] * v[i][2] + v[i][3] * v[i][3]; }
    ss = wave_sum(ss);
    const float rstd = rsqrtf(ss * (1.0f / 1024.0f) + EPS);
    float* orow = p.X + (size_t)t * 1024;
#pragma unroll
    for (int i = 0; i < 4; ++i) {
      const f32x4 g = *(const f32x4*)(p.norm_final + 256 * i + 4 * lane);
      *(f32x4*)(orow + 256 * i + 4 * lane) = f32x4{v[i][0] * rstd * g[0], v[i][1] * rstd * g[1], v[i][2] * rstd * g[2], v[i][3] * rstd * g[3]};
    }
  }
}

DI void quant_fp8(const float* src, unsigned char* dst, size_t n4) {
  for (size_t i = (size_t)blockIdx.x * NTHREADS + threadIdx.x; i < n4; i += (size_t)gridDim.x * NTHREADS) {
    const f32x4 v = *(const f32x4*)(src + i * 4);
    int pk = 0;
    pk = __builtin_amdgcn_cvt_pk_fp8_f32(v[0] * V_FP8_SCALE, v[1] * V_FP8_SCALE, pk, false);
    pk = __builtin_amdgcn_cvt_pk_fp8_f32(v[2] * V_FP8_SCALE, v[3] * V_FP8_SCALE, pk, true);
    *(unsigned*)(dst + i * 4) = (unsigned)pk;
  }
}
DI void quant_u4(const float* src, unsigned char* dst, float* scale, int nrows) {
  const int lane = threadIdx.x & 63, gw = (blockIdx.x * NTHREADS + threadIdx.x) >> 6, nw = gridDim.x * (NTHREADS / 64);
  const int c = lane >> 1, hf = lane & 1;
  for (int r = gw; r < nrows; r += nw) {
    const float* xr = src + (size_t)r * 1024 + 32 * c + 8 * hf;
    const f32x4 a0 = *(const f32x4*)xr, a1 = *(const f32x4*)(xr + 4), b0 = *(const f32x4*)(xr + 16), b1 = *(const f32x4*)(xr + 20);
    float ss = 0.f;
#pragma unroll
    for (int j = 0; j < 4; ++j) ss += a0[j] * a0[j] + a1[j] * a1[j] + b0[j] * b0[j] + b1[j] * b1[j];
    ss = wave_sum(ss);
    const float sc = fmaxf(2.45f * sqrtf(ss * (1.0f / 1024.0f)) * (1.0f / 7.0f), 1e-30f), inv = 1.0f / sc;
    unsigned w[2];
#pragma unroll
    for (int q = 0; q < 2; ++q) {
      const f32x4 lo = q ? a1 : a0, hi = q ? b1 : b0;
      unsigned ww = 0;
#pragma unroll
      for (int j = 0; j < 4; ++j) {
        const int ql = (int)fminf(fmaxf(rintf(lo[j] * inv), -7.f), 7.f) + 8, qh = (int)fminf(fmaxf(rintf(hi[j] * inv), -7.f), 7.f) + 8;
        ww |= (unsigned)(ql | (qh << 4)) << (8 * j);
      }
      w[q] = ww;
    }
    *(u32x2*)(dst + (size_t)r * 512 + 16 * c + 8 * hf) = u32x2{w[0], w[1]};
    if (lane == 0) scale[2 * r] = sc;
  }
}
DI void quant_v4(const float* src, unsigned char* dst, float* scale, int nrows) {
  const int lane = threadIdx.x & 63, gw = (blockIdx.x * NTHREADS + threadIdx.x) >> 6, nw = gridDim.x * (NTHREADS / 64);
  for (int r = gw; r < nrows; r += nw) {
    const float* xr = src + (size_t)r * 1024 + 16 * lane;
    f32x4 a[4]; float ss = 0.f;
#pragma unroll
    for (int q = 0; q < 4; ++q) { a[q] = *(const f32x4*)(xr + 4 * q); ss += a[q][0] * a[q][0] + a[q][1] * a[q][1] + a[q][2] * a[q][2] + a[q][3] * a[q][3]; }
    ss = wave_sum(ss);
    const float sc = fmaxf(sqrtf(ss * (1.0f / 1024.0f)) * (1.0f / 2.1f), 1e-30f), inv = 1.0f / sc;
    unsigned w0 = 0, w1 = 0;
    w0 = __builtin_amdgcn_cvt_scalef32_pk_fp4_f32(w0, a[0][0] * inv, a[0][1] * inv, 1.0f, 0);
    w0 = __builtin_amdgcn_cvt_scalef32_pk_fp4_f32(w0, a[0][2] * inv, a[0][3] * inv, 1.0f, 1);
    w0 = __builtin_amdgcn_cvt_scalef32_pk_fp4_f32(w0, a[1][0] * inv, a[1][1] * inv, 1.0f, 2);
    w0 = __builtin_amdgcn_cvt_scalef32_pk_fp4_f32(w0, a[1][2] * inv, a[1][3] * inv, 1.0f, 3);
    w1 = __builtin_amdgcn_cvt_scalef32_pk_fp4_f32(w1, a[2][0] * inv, a[2][1] * inv, 1.0f, 0);
    w1 = __builtin_amdgcn_cvt_scalef32_pk_fp4_f32(w1, a[2][2] * inv, a[2][3] * inv, 1.0f, 1);
    w1 = __builtin_amdgcn_cvt_scalef32_pk_fp4_f32(w1, a[3][0] * inv, a[3][1] * inv, 1.0f, 2);
    w1 = __builtin_amdgcn_cvt_scalef32_pk_fp4_f32(w1, a[3][2] * inv, a[3][3] * inv, 1.0f, 3);
    *(u32x2*)(dst + (size_t)r * 512 + 8 * lane) = u32x2{w0, w1};
    if (lane == 0) scale[2 * r] = sc;
  }
}
template <bool OFFS>
DI void quant_rows(const float* src, unsigned char* dst, float* scale, int nrows) {
  const int lane = threadIdx.x & 63, gw = (blockIdx.x * NTHREADS + threadIdx.x) >> 6, nw = gridDim.x * (NTHREADS / 64);
  for (int r = gw; r < nrows; r += nw) {
    const float* xr = src + (size_t)r * 1024 + 4 * lane;
    f32x4 v[4]; float m = 0.f;
#pragma unroll
    for (int q = 0; q < 4; ++q) { v[q] = *(const f32x4*)(xr + 256 * q); m = fmaxf(m, fmaxf(fmaxf(fabsf(v[q][0]), fabsf(v[q][1])), fmaxf(fabsf(v[q][2]), fabsf(v[q][3])))); }
    m = fmaxf(wave_max(m), 1e-30f);
    const float inv = 127.0f / m;
#pragma unroll
    for (int q = 0; q < 4; ++q) {
      int a0 = (int)rintf(v[q][0] * inv), a1 = (int)rintf(v[q][1] * inv), a2 = (int)rintf(v[q][2] * inv), a3 = (int)rintf(v[q][3] * inv);
      if (OFFS) { a0 += 128; a1 += 128; a2 += 128; a3 += 128; }
      *(unsigned*)(dst + (size_t)r * 1024 + 4 * lane + 256 * q) = (unsigned)(a0 & 255) | ((unsigned)(a1 & 255) << 8) | ((unsigned)(a2 & 255) << 16) | ((unsigned)a3 << 24);
    }
    if (lane == 0) scale[r] = m * (1.0f / 127.0f);
  }
}

DI void transpose_cvt(const float* W, int ldw, int K, int N, bf16_t* Wt, int ldt, char* smem, int& job, int jobstride) {
  float* tile = (float*)smem;
  const int tk = K / 64, tn = N / 64, total = tk * tn;
  const int tid = threadIdx.x;
  for (; job < total; job += jobstride) {
    const int k0 = (job / tn) * 64, n0 = (job % tn) * 64;
    __syncthreads();
#pragma unroll
    for (int i = 0; i < 8; ++i) { const int e = tid + i * NTHREADS, kk = e >> 6, nn = e & 63; tile[kk * 65 + nn] = W[(size_t)(k0 + kk) * ldw + n0 + nn]; }
    __syncthreads();
#pragma unroll
    for (int i = 0; i < 8; ++i) { const int e = tid + i * NTHREADS, nn = e >> 6, kk = e & 63; Wt[(size_t)(n0 + nn) * ldt + k0 + kk] = f2bf(tile[kk * 65 + nn]); }
  }
  job -= total;
}
DI void cvt_elems(const float* src, bf16_t* dst, size_t n8) {
  for (size_t i = (size_t)blockIdx.x * NTHREADS + threadIdx.x; i < n8; i += (size_t)gridDim.x * NTHREADS) {
    const f32x4 a = *(const f32x4*)(src + i * 8), b = *(const f32x4*)(src + i * 8 + 4);
    *(u32x4*)(dst + i * 8) = u32x4{pk2(a[0], a[1]), pk2(a[2], a[3]), pk2(b[0], b[1]), pk2(b[2], b[3])};
  }
}
DI void prep_phase(const Params& p, char* smem) {
  int job = blockIdx.x; const int js = gridDim.x;
  transpose_cvt(p.w_in, IN_COLS, 1024, IN_COLS, p.wt_in, 1024, smem, job, js);
  transpose_cvt(p.w_out, 1024, 1024, 1024, p.wt_out, 1024, smem, job, js);
  transpose_cvt(p.w_cq, 512, 1024, 512, p.wt_cq, 1024, smem, job, js);
  transpose_cvt(p.w_ck, 512, 1024, 512, p.wt_ckv, 1024, smem, job, js);
  transpose_cvt(p.w_cv, 512, 1024, 512, p.wt_ckv + (size_t)512 * 1024, 1024, smem, job, js);
  transpose_cvt(p.w_co, 1024, 512, 1024, p.wt_co, 512, smem, job, js);
  for (int h = 0; h < 4; ++h) transpose_cvt(p.w_kv_b + h * 256 + 128, 1024, 128, 128, p.wt_uv + (size_t)h * 128 * 128, 128, smem, job, js);
  __syncthreads();
  const size_t gtid = (size_t)blockIdx.x * NTHREADS + threadIdx.x, gn = (size_t)gridDim.x * NTHREADS;
  for (size_t i = gtid; i < (size_t)64 * 1024 / 8; i += gn) *(u32x4*)(p.wt_in + (size_t)IN_COLS * 1024 + i * 8) = u32x4{0, 0, 0, 0};
  for (size_t i = gtid; i < (size_t)768 * 256; i += gn) {
    const int n = (int)(i >> 8), k = (int)(i & 255), h = n / 192, j = n - h * 192;
    float v;
    if (j < 128) {
      const float* a = p.w_q_b + (size_t)k * 768 + h * 192; const float* b = p.w_kv_b + (size_t)j * 1024 + h * 256;
      float s = 0.f;
      for (int d = 0; d < 128; d += 4) { const f32x4 av = *(const f32x4*)(a + d), bv = *(const f32x4*)(b + d); s += av[0] * bv[0] + av[1] * bv[1] + av[2] * bv[2] + av[3] * bv[3]; }
      v = s;
    } else v = p.w_q_b[(size_t)k * 768 + n];
    p.wt_qc[i] = f2bf(v);
  }
  cvt_elems(p.peer_w_q, p.a_pq, (size_t)1024 * 2048 / 8);
  cvt_elems(p.peer_keys, p.keys_bf, (size_t)2048 * 128 / 8);
  quant_u4(p.peer_u, p.u_q, p.su, 16384);
  quant_v4(p.peer_v, p.v_q, p.su + 1, 16384);
  for (size_t i = gtid; i < (size_t)T * 32; i += gn) {
    const int t = (int)(i >> 5), ii = (int)(i & 31);
    const float inv = exp2f(-(float)ii * (13.287712379549449f / 32.0f));
    const float ang = (float)p.positions[t] * inv;
    float sn, cs; sincosf(ang, &sn, &cs);
    *(f32x2*)(p.rope + i * 2) = f32x2{cs, sn};
  }
  norm_rows_1024(p.mem, p.norm_mem, p.mn, NB * 256);
  norm_rows_1024(p.x, p.norm_mix, p.xn, T);
}

struct KArgs { const void* in[25]; float* out; char* ws; };
__host__ __device__ __forceinline__ size_t align_up(size_t v) { return (v + 255) & ~(size_t)255; }
__host__ __device__ __forceinline__ Params build_params(const KArgs& k, size_t* total) {
  Params p{};
  p.x = (const float*)k.in[0]; p.mem = (const float*)k.in[1]; p.positions = (const int*)k.in[2]; p.norm_mix = (const float*)k.in[3]; p.w_in = (const float*)k.in[4];
  p.q_a_norm = (const float*)k.in[5]; p.w_q_b = (const float*)k.in[6]; p.kv_a_norm = (const float*)k.in[7]; p.w_kv_b = (const float*)k.in[8]; p.swa_sinks = (const float*)k.in[9];
  p.out_norm_mla = (const float*)k.in[10]; p.out_norm_swa = (const float*)k.in[11]; p.w_out = (const float*)k.in[12]; p.norm_cross = (const float*)k.in[13]; p.norm_mem = (const float*)k.in[14];
  p.w_cq = (const float*)k.in[15]; p.w_ck = (const float*)k.in[16]; p.w_cv = (const float*)k.in[17]; p.w_co = (const float*)k.in[18]; p.norm_ffn = (const float*)k.in[19];
  p.peer_w_q = (const float*)k.in[20]; p.peer_keys = (const float*)k.in[21]; p.peer_u = (const float*)k.in[22]; p.peer_v = (const float*)k.in[23]; p.norm_final = (const float*)k.in[24];
  p.X = k.out;
  char* ws = k.ws; size_t off = 0;
#define TAKE(bytes) (ws + ((off += align_up(bytes)) - align_up(bytes)))
  p.wt_in = (bf16_t*)TAKE((size_t)IN_COLS_PAD * 1024 * 2);
  p.wt_qc = (bf16_t*)TAKE((size_t)768 * 256 * 2);
  p.wt_uv = (bf16_t*)TAKE((size_t)512 * 128 * 2);
  p.wt_out = (bf16_t*)TAKE((size_t)1024 * 1024 * 2);
  p.wt_cq = (bf16_t*)TAKE((size_t)512 * 1024 * 2);
  p.wt_ckv = (bf16_t*)TAKE((size_t)1024 * 1024 * 2);
  p.wt_co = (bf16_t*)TAKE((size_t)1024 * 512 * 2);
  p.a_pq = (bf16_t*)TAKE((size_t)1024 * 2048 * 2);
  p.keys_bf = (bf16_t*)TAKE((size_t)2048 * 128 * 2);
  p.wt_sc = (bf16_t*)TAKE((size_t)2048 * 1024 * 2);
  p.bar = (unsigned*)TAKE((size_t)XCD_BAR_WORDS * 4);
  p.u_q = (unsigned char*)TAKE((size_t)16384 * 512);
  p.v_q = (unsigned char*)TAKE((size_t)16384 * 512);
  p.k8 = (unsigned char*)TAKE((size_t)T * 192);
  p.vt8 = (unsigned char*)TAKE((size_t)T * 128);
  p.su = (float*)TAKE((size_t)16384 * 8);
  p.sv = p.su + 1;
  p.mn = (bf16_t*)TAKE((size_t)512 * 1024 * 2);
  p.kvc = (bf16_t*)TAKE((size_t)512 * 1024 * 2);
  p.rope = (float*)TAKE((size_t)T * 64 * 4);
  p.xn = (bf16_t*)TAKE((size_t)T * 1024 * 2);
  const size_t offR = off;
  p.lat = (bf16_t*)TAKE((size_t)T * 448 * 2);
  p.cqn = (bf16_t*)TAKE((size_t)T * 256 * 2);
  p.qcat = (bf16_t*)TAKE((size_t)T * 768 * 2);
  p.kcat = (bf16_t*)TAKE((size_t)T * 192 * 2);
  p.qs = (bf16_t*)TAKE((size_t)T * 512 * 2);
  p.ks = (bf16_t*)TAKE((size_t)T * 128 * 2);
  p.vs = (bf16_t*)TAKE((size_t)T * 128 * 2);
  p.olat = (bf16_t*)TAKE((size_t)T * 512 * 2);
  p.ob = (bf16_t*)TAKE((size_t)T * 512 * 2);
  p.oa = (bf16_t*)TAKE((size_t)T * 512 * 2);
  const size_t offEnd = off;
  off = offR;
  p.qx = (bf16_t*)TAKE((size_t)T * 512 * 2);
  p.ox = (bf16_t*)TAKE((size_t)T * 512 * 2);
  p.top1 = (int*)TAKE((size_t)T * 256 * 4);
  p.pidx = (int*)TAKE((size_t)T * 128 * 4);
  p.pg = (float*)TAKE((size_t)T * 128 * 4);
  p.dpartA = (int*)(ws + offR);
  p.dpartB = (int*)TAKE((size_t)4 * T * 128 * 4);
  p.X16 = (bf16_t*)p.dpartB;
  p.hq = (unsigned char*)TAKE((size_t)T * 1024);
  p.sh = (float*)TAKE((size_t)T * 4);
  p.cbuf = (float*)TAKE((size_t)T * 128 * 4);
#undef TAKE
  if (total) *total = (off > offEnd) ? off : offEnd;
  return p;
}

constexpr int N_PHASES = 19;
template <int PH> DI void run_phase(const Params& p, char* smem) {
  if constexpr (PH == 0) prep_phase(p, smem);
  else if constexpr (PH == 1) {
    g8::run(p.xn, p.wt_in, T, IN_COLS_PAD, DM, g8::EpiInproj{p.lat, p.qs, p.ks, p.vs}, smem);
    { const int G = (int)gridDim.x, n3 = 640 - 2 * G;
      if (n3 > 0 && G - n3 >= 72) {
        if ((int)blockIdx.x >= n3) {
          const int c = (int)blockIdx.x - n3;
          if (c < 8) g8::run_on(p.mn, p.wt_ckv, NB * 256, 1024, DM, g8::EpiBf16{p.kvc, 1024, 1.0f}, smem, c, 8);
          else if (c < 72) gemm_phase(p.a_pq, 2048, 128, p.keys_bf, 128, 1024, 2048, 128, EpiBf16T{p.wt_sc, 1024}, smem, c - 8, 64);
        }
      } else {
        g8::run(p.mn, p.wt_ckv, NB * 256, 1024, DM, g8::EpiBf16{p.kvc, 1024, 1.0f}, smem);
        gemm_phase(p.a_pq, 2048, 128, p.keys_bf, 128, 1024, 2048, 128, EpiBf16T{p.wt_sc, 1024}, smem);
      } }
  }
  else if constexpr (PH == 2) latent_pass(p, smem);
  else if constexpr (PH == 3) g8::run(p.cqn, p.wt_qc, T, 768, 256, g8::EpiBf16{p.qcat, 768, MLA_QSCALE}, smem);
  else if constexpr (PH == 4) { mla_phase(p, smem); swa_phase(p, smem); }
  else if constexpr (PH == 5) gemm_phase(p.olat, 512, 128, p.wt_uv, 128, T, 512, 128, EpiBf16{p.oa, 512, 1.0f}, smem);
  else if constexpr (PH == 6) mix_pass(p);
  else if constexpr (PH == 7) g8::run(p.xn, p.wt_out, T, DM, DM, g8::EpiResid16<true>{p.x, p.X16, DM, DBG_MIX}, smem);
  else if constexpr (PH == 8) norm_rows_bf16(p.X16, p.norm_cross, p.xn, T);
  else if constexpr (PH == 9) g8::run(p.xn, p.wt_cq, T, 512, DM, g8::EpiBf16{p.qx, 512, X_QSCALE}, smem);
  else if constexpr (PH == 10) xattn_phase(p, smem);
  else if constexpr (PH == 11) g8::run(p.ox, p.wt_co, T, DM, 512, g8::EpiResid16<false>{p.X16, p.X16, DM, DBG_XAT}, smem);
  else if constexpr (PH == 12) norm_rows_ffn(p);
  else if constexpr (PH == 13) score_phase(p, smem);
  else if constexpr (PH == 14) topk2_phase(p);
  else if constexpr (PH == 15) peer_dots(p);
  else if constexpr (PH == 16) peer_coef(p);
  else if constexpr (PH == 17) peer_accum(p, p.X16, -1);
  else if constexpr (PH == 18) final_norm(p);
}

template <int PB, int PE>
__global__ void __launch_bounds__(NTHREADS) mega_kernel(KArgs ka) {
  const Params p = build_params(ka, nullptr);
  if (ka.ws == nullptr) cg::this_grid().sync();
  __shared__ __attribute__((aligned(16))) char smem[SMEM_BYTES];
  XcdBarrier xb;
  if constexpr (PE - PB > 1) {
    volatile LAS unsigned* xbw = (volatile LAS unsigned*)(smem + SMEM_BYTES - 256);
    if (threadIdx.x == 0) { xbw[0] = 0u; xbw[1] = 0u; }
    __syncthreads();
    xb = xcd_barrier_post(p.bar, xbw);
  }
#define RUN(n) if constexpr (PB <= n && n < PE) { if constexpr (n == DUP) { if constexpr (n == 17) peer_accum(p, p.oa, 1023); else run_phase<n>(p, smem); xcd_barrier(xb); } run_phase<n>(p, smem); if constexpr (n + 1 < PE) { xcd_barrier(xb); } }
  RUN(0) RUN(1) RUN(2) RUN(3) RUN(4) RUN(5) RUN(6) RUN(7) RUN(8) RUN(9) RUN(10) RUN(11) RUN(12) RUN(13) RUN(14) RUN(15) RUN(16) RUN(17) RUN(18)
#undef RUN
}


extern "C" void kernel_launch(void* const* d_in, const int* in_sizes, int n_in, void* d_out, int out_size, void* d_ws, size_t ws_size, hipStream_t stream) {
  (void)in_sizes; (void)n_in; (void)out_size;
  KArgs ka{};
  for (int i = 0; i < 25; ++i) ka.in[i] = d_in[i];
  ka.out = (float*)d_out; ka.ws = (char*)d_ws;
  size_t need = 0;
  const Params hp = build_params(ka, &need);
  if (need > ws_size) { fprintf(stderr, "kernel_launch: workspace too small (%zu > %zu)\n", need, ws_size); return; }

  static int grid_blocks = 0;
  if (!grid_blocks) {
    int dev = 0, cus = 0;
    (void)hipGetDevice(&dev);
    (void)hipDeviceGetAttribute(&cus, hipDeviceAttributeMultiprocessorCount, dev);
    grid_blocks = cus > 0 ? cus : 256;
  }
#if MK_SINGLE_LAUNCH
  {
    (void)hipMemsetAsync(hp.bar, 0, (size_t)XCD_BAR_WORDS * 4, stream);
    int per_cu = 0;
    (void)hipOccupancyMaxActiveBlocksPerMultiprocessor(&per_cu, mega_kernel<0, N_PHASES>, NTHREADS, 0);
    if (per_cu < 1) fprintf(stderr, "occupancy query returned %d\n", per_cu);
    void* args[] = {&ka};
    hipError_t e = hipLaunchCooperativeKernel((void*)mega_kernel<0, N_PHASES>, dim3(grid_blocks), dim3(NTHREADS), args, 0, stream);
    if (e != hipSuccess) fprintf(stderr, "cooperative launch failed: %s (grid %d)\n", hipGetErrorString(e), grid_blocks);
  }
#else
#define LAUNCH(n) hipLaunchKernelGGL((mega_kernel<n, n + 1>), dim3(grid_blocks), dim3(NTHREADS), 0, stream, ka);
  LAUNCH(0) LAUNCH(1) LAUNCH(2) LAUNCH(3) LAUNCH(4) LAUNCH(5) LAUNCH(6) LAUNCH(7) LAUNCH(8) LAUNCH(9) LAUNCH(10) LAUNCH(11) LAUNCH(12) LAUNCH(13) LAUNCH(14) LAUNCH(15) LAUNCH(16) LAUNCH(17) LAUNCH(18)
#undef LAUNCH
#endif
}
```

```cpp
#include <hip/hip_runtime.h>
#include <hip/hip_cooperative_groups.h>
#include <cstdint>
#include <cstdio>
namespace cg = cooperative_groups;

#ifndef MK_SINGLE_LAUNCH
#define MK_SINGLE_LAUNCH 1
#endif

#ifndef DUP
#define DUP -1
#endif
#ifndef DBG
#define DBG 0
#endif
#define DBG_MIX ((DBG == 1) ? 0.0f : 1.0f)
#define DBG_XAT ((DBG == 1 || DBG == 2) ? 0.0f : 1.0f)
#define DBG_PEER ((DBG >= 1 && DBG <= 3) ? 0.0f : (DBG == 4 ? -0.5f : 1.0f))
#define DI __device__ __forceinline__
typedef unsigned short bf16_t;
typedef short bf16x8 __attribute__((ext_vector_type(8)));
typedef short s16x4 __attribute__((ext_vector_type(4)));
typedef float f32x16 __attribute__((ext_vector_type(16)));
typedef float f32x4 __attribute__((ext_vector_type(4)));
typedef float f32x2 __attribute__((ext_vector_type(2)));
typedef unsigned u32x4 __attribute__((ext_vector_type(4)));
typedef unsigned u32x2 __attribute__((ext_vector_type(2)));
typedef int i32x4 __attribute__((ext_vector_type(4)));
typedef __bf16 bf2_t __attribute__((ext_vector_type(2)));

constexpr int NB = 2, SEQ = 16384, DM = 1024, T = NB * SEQ;
constexpr int NTHREADS = 512;
constexpr float LOG2E = 1.4426950408889634f;
constexpr float EPS = 1e-6f;
constexpr int IN_COLS = 1216, IN_COLS_PAD = 1280;
constexpr float MLA_QSCALE = 0.07216878364870322f * LOG2E * 8.0f;
constexpr float SWA_QSCALE = 0.125f * LOG2E;
constexpr float X_QSCALE = 0.08838834764831845f * LOG2E;
constexpr float SM_THR = 8.0f;
constexpr float V_FP8_SCALE = 64.0f;

#define XB_TMO      128
#define XB_XCNT(j)  (256  + 64 * (j))
#define XB_XSUB(j)  (1280 + 64 * (j))
#define XB_XGEN(j)  (2304 + 64 * (j))
#define XB_TOP      3328
#define XB_TOPGEN   3392
#define XCD_BAR_WORDS 3456
#define XB_SPIN_CAP (1u << 22)
#define LAS __attribute__((address_space(3)))
DI unsigned xb_ld(unsigned* p)              { return __hip_atomic_load(p, __ATOMIC_RELAXED, __HIP_MEMORY_SCOPE_AGENT); }
DI unsigned xb_add(unsigned* p, unsigned v) { return __hip_atomic_fetch_add(p, v, __ATOMIC_RELAXED, __HIP_MEMORY_SCOPE_AGENT); }
DI unsigned xb_xcc_id() { return (unsigned)__builtin_amdgcn_s_getreg((3 << 11) | 20) & 0xFu; }
#define XB_SPIN(cond, bar) do { unsigned _sp = 0; while (cond) { __builtin_amdgcn_s_sleep(1); \
    if ((++_sp & 255u) == 0u) { if (xb_ld(&(bar)[XB_TMO])) break; if (_sp > XB_SPIN_CAP) { atomicAdd(&(bar)[XB_TMO], 1u); break; } } } } while (0)
struct XcdBarrier { unsigned* bar; unsigned x; volatile LAS unsigned* st; };
DI XcdBarrier xcd_barrier_post(unsigned* bar, volatile LAS unsigned* st) {
  XcdBarrier b; b.bar = bar; b.x = xb_xcc_id(); b.st = st;
  if (threadIdx.x == 0) (void)xb_add(&bar[XB_XCNT(b.x)], 1u);
  return b;
}
DI void xcd_barrier_complete(unsigned* bar, unsigned x, unsigned& nloc, unsigned& nx) {
  const unsigned G = gridDim.x * gridDim.y * gridDim.z;
  unsigned sum, cnt, mine, sp = 0u;
  for (;;) {
    sum = 0u; cnt = 0u; mine = 0u;
#pragma unroll
    for (unsigned j = 0; j < 16; ++j) { const unsigned c = xb_ld(&bar[XB_XCNT(j)]); sum += c; cnt += (c > 0u) ? 1u : 0u; mine = (j == x) ? c : mine; }
    if (sum == G) break;
    __builtin_amdgcn_s_sleep(1);
    if ((++sp & 255u) == 0u) { if (xb_ld(&bar[XB_TMO])) break; if (sp > XB_SPIN_CAP) { atomicAdd(&bar[XB_TMO], 1u); break; } }
  }
  nloc = mine > 0u ? mine : 1u; nx = cnt > 0u ? cnt : 1u;
}
DI void xcd_barrier(const XcdBarrier& b) {
  asm volatile("s_waitcnt vmcnt(0)" ::: "memory");
  __syncthreads();
  if (threadIdx.x == 0) {
    unsigned* bar = b.bar;
    __builtin_amdgcn_s_waitcnt(0);
    unsigned nloc = b.st[0], nx = b.st[1];
    if (nloc == 0u) { xcd_barrier_complete(bar, b.x, nloc, nx); b.st[0] = nloc; b.st[1] = nx; }
    const unsigned old = xb_add(&bar[XB_XSUB(b.x)], 1u);
    const unsigned gen = old / nloc;
    if (old + 1u == (gen + 1u) * nloc) {
      __builtin_amdgcn_fence(__ATOMIC_RELEASE, "agent");
      asm volatile("s_waitcnt vmcnt(0)" ::: "memory");
      const unsigned og = xb_add(&bar[XB_TOP], 1u);
      const unsigned tg = og / nx;
      if (og + 1u == (tg + 1u) * nx) xb_add(&bar[XB_TOPGEN], 1u);
      else XB_SPIN(xb_ld(&bar[XB_TOPGEN]) == tg, bar);
      __builtin_amdgcn_fence(__ATOMIC_ACQUIRE, "agent");
      xb_add(&bar[XB_XGEN(b.x)], 1u);
      asm volatile("s_waitcnt vmcnt(0)" ::: "memory");
    } else {
      XB_SPIN(xb_ld(&bar[XB_XGEN(b.x)]) == gen, bar);
      __builtin_amdgcn_fence(__ATOMIC_ACQUIRE, "agent");
      asm volatile("s_waitcnt vmcnt(0)" ::: "memory");
    }
  }
  __syncthreads();
}

struct Params {
  const float* x; const float* mem; const int* positions; const float* norm_mix; const float* w_in; const float* q_a_norm; const float* w_q_b;
  const float* kv_a_norm; const float* w_kv_b; const float* swa_sinks; const float* out_norm_mla; const float* out_norm_swa; const float* w_out;
  const float* norm_cross; const float* norm_mem; const float* w_cq; const float* w_ck; const float* w_cv; const float* w_co; const float* norm_ffn;
  const float* peer_w_q; const float* peer_keys; const float* peer_u; const float* peer_v; const float* norm_final;
  float* X;
  bf16_t* wt_in; bf16_t* wt_qc; bf16_t* wt_uv; bf16_t* wt_out; bf16_t* wt_cq; bf16_t* wt_ckv; bf16_t* wt_co; bf16_t* a_pq; bf16_t* keys_bf; bf16_t* wt_sc;
  unsigned char* u_q; unsigned char* v_q; unsigned char* k8; unsigned char* vt8; float* su; float* sv; unsigned* bar; bf16_t* mn; bf16_t* kvc; float* rope; bf16_t* xn; bf16_t* lat; bf16_t* cqn; bf16_t* qcat; bf16_t* kcat;
  bf16_t* qs; bf16_t* ks; bf16_t* vs; bf16_t* olat; bf16_t* ob; bf16_t* oa; bf16_t* qx; bf16_t* ox; int* top1; int* pidx; float* pg; unsigned char* hq; float* sh; int* dpartA; int* dpartB; float* cbuf; bf16_t* X16;
};

DI unsigned pk2(float lo, float hi) { f32x2 v = {lo, hi}; bf2_t b = __builtin_convertvector(v, bf2_t); return __builtin_bit_cast(unsigned, b); }
DI bf16_t f2bf(float x) { __bf16 b = (__bf16)x; return __builtin_bit_cast(bf16_t, b); }
DI float bf2f(bf16_t b) { return __uint_as_float(((unsigned)b) << 16); }
DI float bflo(unsigned w) { return __uint_as_float(w << 16); }
DI float bfhi(unsigned w) { return __uint_as_float(w & 0xffff0000u); }
DI float dot2bf(unsigned a, unsigned b, float c) { return __builtin_amdgcn_fdot2_f32_bf16(__builtin_bit_cast(bf2_t, a), __builtin_bit_cast(bf2_t, b), c, false); }
DI int crow(int r, int hi) { return (r & 3) + 8 * (r >> 2) + 4 * hi; }
DI float wave_sum(float v) {
#pragma unroll
  for (int o = 32; o >= 1; o >>= 1) v += __shfl_xor(v, o);
  return v;
}
#define MFMA32(a, b, c) __builtin_amdgcn_mfma_f32_32x32x16_bf16((a), (b), (c), 0, 0, 0)
#define SBAR() __builtin_amdgcn_sched_barrier(0)

constexpr int G_BM = 256, G_BN = 128, G_BK = 64;
constexpr int G_A_BYTES = G_BM * 128, G_B_BYTES = G_BN * 128, G_STAGE = G_A_BYTES + G_B_BYTES;
constexpr int G_NSTAGE = 3;
constexpr int SMEM_BYTES = 160768 + 256;
#define LDSP(p) ((__attribute__((address_space(3))) unsigned*)(p))

template <int V>
DI void gemm_mainloop(const bf16_t* __restrict__ A, int lda, const bf16_t* __restrict__ Bt, int ldb, int K, int row0, int col0, f32x16 (&acc)[4], char* smem) {
  int tid_ = threadIdx.x; asm volatile("" : "+v"(tid_));
  const int tid = tid_, lane = tid & 63, wid = tid >> 6, r32 = lane & 31, hi = lane >> 5;
  const int srow = tid >> 3, spc = tid & 7, slc = spc ^ ((srow >> 1) & 7);
  const bf16_t* Ag = A + (size_t)(row0 + srow) * lda + slc * 8;
  const bf16_t* Bg = Bt + (size_t)(col0 + srow) * ldb + slc * 8;
  const size_t a64 = (size_t)64 * lda, b64 = (size_t)64 * ldb;
#pragma unroll
  for (int i = 0; i < 4; ++i) acc[i] = f32x16{};
  const int nk = K / G_BK;
  auto stage = [&](int kt, int slot) {
    char* sa = smem + slot * G_STAGE + tid * 16;
    const bf16_t* ag = Ag + kt * G_BK; const bf16_t* bg = Bg + kt * G_BK;
#pragma unroll
    for (int i = 0; i < 4; ++i) __builtin_amdgcn_global_load_lds((const unsigned*)(ag + i * a64), LDSP(sa + i * 8192), 16, 0, 0);
#pragma unroll
    for (int i = 0; i < 2; ++i) __builtin_amdgcn_global_load_lds((const unsigned*)(bg + i * b64), LDSP(sa + G_A_BYTES + i * 8192), 16, 0, 0);
  };
  stage(0, 0);
  if (nk > 1) stage(1, 1);
  const int x = (r32 >> 1) & 7;
  int so[4];
#pragma unroll
  for (int s = 0; s < 4; ++s) so[s] = ((2 * s + hi) ^ x) * 16;
  int aoff, boff;
  if (V == 0) { aoff = ((wid >> 1) * 64 + r32) * 128; boff = G_A_BYTES + ((wid & 1) * 64 + r32) * 128; }
  else        { aoff = ((wid >> 2) * 128 + r32) * 128; boff = G_A_BYTES + ((wid & 3) * 32 + r32) * 128; }
  int slot = 0;
  for (int kt = 0; kt < nk; ++kt) {
    if (kt + 1 < nk) asm volatile("s_waitcnt vmcnt(6) lgkmcnt(0)" ::: "memory"); else asm volatile("s_waitcnt vmcnt(0) lgkmcnt(0)" ::: "memory");
    __builtin_amdgcn_s_barrier();
    if (kt + 2 < nk) { int ns = slot + 2; if (ns >= G_NSTAGE) ns -= G_NSTAGE; stage(kt + 2, ns); }
    const char* cs = smem + slot * G_STAGE;
    if (V == 0) {
      bf16x8 af[4][2], bf[4][2];
#pragma unroll
      for (int s = 0; s < 4; ++s) {
        af[s][0] = *(const bf16x8*)(cs + aoff + so[s]); af[s][1] = *(const bf16x8*)(cs + aoff + 32 * 128 + so[s]);
        bf[s][0] = *(const bf16x8*)(cs + boff + so[s]); bf[s][1] = *(const bf16x8*)(cs + boff + 32 * 128 + so[s]);
      }
#pragma unroll
      for (int s = 0; s < 4; ++s) {
        acc[0] = MFMA32(af[s][0], bf[s][0], acc[0]); acc[1] = MFMA32(af[s][0], bf[s][1], acc[1]);
        acc[2] = MFMA32(af[s][1], bf[s][0], acc[2]); acc[3] = MFMA32(af[s][1], bf[s][1], acc[3]);
      }
    } else {
      bf16x8 af[4][4], bf[4];
#pragma unroll
      for (int s = 0; s < 4; ++s) {
        bf[s] = *(const bf16x8*)(cs + boff + so[s]);
#pragma unroll
        for (int mi = 0; mi < 4; ++mi) af[s][mi] = *(const bf16x8*)(cs + aoff + mi * 32 * 128 + so[s]);
      }
#pragma unroll
      for (int s = 0; s < 4; ++s)
#pragma unroll
        for (int mi = 0; mi < 4; ++mi) acc[mi] = MFMA32(af[s][mi], bf[s], acc[mi]);
    }
    slot = (slot + 1 == G_NSTAGE) ? 0 : slot + 1;
  }
  __syncthreads();
}

constexpr int EP_STR = 132;
template <class Epi>
DI void gemm_epi_rows(const f32x16 (&acc)[4], int row0, int col0, const Epi& epi, char* smem) {
  int tid_ = threadIdx.x; asm volatile("" : "+v"(tid_));
  const int tid = tid_, lane = tid & 63, wid = tid >> 6, r32 = lane & 31, hi = lane >> 5;
  float* tile = (float*)smem;
  const int rb = (wid >> 1) * 64, cb = (wid & 1) * 64 + r32;
  const int rr = tid >> 5, c4 = (tid & 31) * 4;
  if constexpr (Epi::HAS_BASE) {
    f32x4 bs[16];
#pragma unroll
    for (int it = 0; it < 16; ++it) bs[it] = epi.load_base(row0 + it * 16 + rr, col0 + c4);
#pragma unroll
    for (int mi = 0; mi < 2; ++mi)
#pragma unroll
      for (int ni = 0; ni < 2; ++ni)
#pragma unroll
        for (int r = 0; r < 16; ++r) tile[(rb + mi * 32 + crow(r, hi)) * EP_STR + cb + ni * 32] = acc[mi * 2 + ni][r];
    __syncthreads();
#pragma unroll
    for (int it = 0; it < 16; ++it) {
      const int row = it * 16 + rr;
      const f32x4 v = *(const f32x4*)(tile + row * EP_STR + c4);
      epi.store(row0 + row, col0 + c4, v, bs[it]);
    }
  } else {
#pragma unroll
    for (int mi = 0; mi < 2; ++mi)
#pragma unroll
      for (int ni = 0; ni < 2; ++ni)
#pragma unroll
        for (int r = 0; r < 16; ++r) tile[(rb + mi * 32 + crow(r, hi)) * EP_STR + cb + ni * 32] = acc[mi * 2 + ni][r];
    __syncthreads();
#pragma unroll 4
    for (int it = 0; it < 16; ++it) {
      const int row = it * 16 + rr;
      const f32x4 v = *(const f32x4*)(tile + row * EP_STR + c4);
      epi(row0 + row, col0 + c4, v);
    }
  }
  __syncthreads();
}

template <class Epi>
DI void gemm_phase(const bf16_t* A, int lda, int a_kstride, const bf16_t* Bt, int ldb, int M, int N, int K, const Epi& epi, char* smem, int bid = -1, int nb = 0) {
  if (bid < 0) { bid = (int)blockIdx.x; nb = (int)gridDim.x; }
  const int ntn = N / G_BN, total = (M / G_BM) * ntn;
  for (int L = bid; L < total; L += nb) {
    const int wg = (L & 7) * (total >> 3) + (L >> 3);
    const int pm = wg / ntn, pn = wg - pm * ntn;
    f32x16 acc[4];
    gemm_mainloop<0>(A + (size_t)pn * a_kstride, lda, Bt, ldb, K, pm * G_BM, pn * G_BN, acc, smem);
    gemm_epi_rows(acc, pm * G_BM, pn * G_BN, epi, smem);
  }
}

DI u32x2 pk4(const f32x4& v, float s) { return u32x2{pk2(v[0] * s, v[1] * s), pk2(v[2] * s, v[3] * s)}; }
struct EpiInproj {
  static constexpr bool HAS_BASE = false;
  bf16_t* lat; bf16_t* qs; bf16_t* ks; bf16_t* vs;
  DI void operator()(int row, int col, const f32x4& v) const {
    if (col < 448) *(u32x2*)(lat + (size_t)row * 448 + col) = pk4(v, 1.0f);
    else if (col < 960) *(u32x2*)(qs + (size_t)row * 512 + (col - 448)) = pk4(v, SWA_QSCALE);
    else if (col < 1088) *(u32x2*)(ks + (size_t)row * 128 + (col - 960)) = pk4(v, 1.0f);
    else if (col < 1216) *(u32x2*)(vs + (size_t)row * 128 + (col - 1088)) = pk4(v, 1.0f);
  }
};
struct EpiBf16 { static constexpr bool HAS_BASE = false; bf16_t* out; int ld; float scale; DI void operator()(int row, int col, const f32x4& v) const { *(u32x2*)(out + (size_t)row * ld + col) = pk4(v, scale); } };
struct EpiBf16T { static constexpr bool HAS_BASE = false; bf16_t* out; int ld; DI void operator()(int row, int col, const f32x4& v) const {
#pragma unroll
  for (int j = 0; j < 4; ++j) out[(size_t)(col + j) * ld + row] = f2bf(v[j]); } };
struct EpiResid { static constexpr bool HAS_BASE = true; const float* base; float* out; int ld; float scale;
  DI f32x4 load_base(int row, int col) const { return *(const f32x4*)(base + (size_t)row * ld + col); }
  DI void store(int row, int col, const f32x4& v, const f32x4& b) const { *(f32x4*)(out + (size_t)row * ld + col) = b + v * scale; } };

namespace g8 {
#define PG8_LAS __attribute__((address_space(3)))
constexpr int BM = 256, BK = 64, HALF = 128, HTB = HALF * BK * 2, NXCD = 8, WGM = 8;
DI int lds_byte(int r, int c) { const int st = (r >> 4) * 2 + (c >> 5), rr = r & 15, cc = c & 31, ob = rr * 64 + cc * 2; return st * 1024 + (ob ^ (((ob >> 9) & 1) << 5)); }
DI void stage_rc(int b, int& R, int& C) { const int st = b / 1024, sb = b % 1024, swz = sb ^ (((sb >> 9) & 1) << 5); R = (st >> 1) * 16 + swz / 64; C = (st & 1) * 32 + (swz % 64) / 2; }
DI int perm32(int rho) { const int n = rho >> 4, i = rho & 15; return 8 * (i >> 2) + 4 * n + (i & 3); }
struct Unit { int pm, pn; };
struct Gemm { const bf16_t* A; const bf16_t* Bt; int M, N, K; };
struct StaticOrder {
  int nM, nN, nwg, G, c;
  DI void init(int M, int N, int G_, int c_) { nM = M / BM; nN = N / BM; nwg = nM * nN; G = G_; c = c_; }
  DI bool next(int i, Unit& u) const {
    const long L = (long)i * G + c; if (L >= nwg) return false;
    int wgid = (int)L; { const int q = nwg / NXCD, r = nwg % NXCD, xcd = wgid % NXCD, off = wgid / NXCD; wgid = (xcd < r ? xcd * (q + 1) : r * (q + 1) + (xcd - r) * q) + off; }
    const int nig = WGM * nN, gid = wgid / nig, fm = gid * WGM, gsz = (nM - fm) < WGM ? (nM - fm) : WGM;
    u.pm = fm + ((wgid % nig) % gsz); u.pn = (wgid % nig) / gsz; return true;
  }
};
template <class Epi>
DI void gemm_phase(PG8_LAS unsigned char* lds, const Gemm g, const StaticOrder& S, const Epi& E) {
  int tid = threadIdx.x; asm volatile("" : "+v"(tid));
  const int wid = __builtin_amdgcn_readfirstlane(tid >> 6), lane = tid & 63, wr = wid >> 2, wc = wid & 3, fr = lane & 15, fq = lane >> 4;
  const int K = g.K, nt = K / BK;
  unsigned voffA[2], voffB[2];
#pragma unroll
  for (int i = 0; i < 2; ++i) { int R, C; stage_rc(tid * 16 + i * 8192, R, C); const int Rb = Epi::PERM ? ((R & ~31) + perm32(R & 31)) : R;
    voffA[i] = (unsigned)(R * K + C) * 2u; voffB[i] = (unsigned)(Rb * K + C) * 2u; }
  const size_t kstep = (size_t)(BK * 2), hstep = (size_t)HALF * K * 2, tstep = 2 * hstep;
  const unsigned ldsw = (unsigned)wid * 1024u;
  const int aoff = lds_byte(wr * 64 + fr, fq * 8), boff = lds_byte(wc * 32 + fr, fq * 8);
#define PG8_SA(b, h) (((b) * 2 + (h)) * HTB)
#define PG8_SB(b, h) ((4 + (b) * 2 + (h)) * HTB)
#define PG8_STAGE(bufoff, gbase, voff) do { _Pragma("unroll") for (int _i = 0; _i < 2; ++_i) \
    __builtin_amdgcn_global_load_lds((const unsigned*)((const char*)(gbase) + (voff)[_i]), (PG8_LAS unsigned*)(lds + (bufoff) + ldsw + _i * 8192), 16, 0, 0); } while (0)
#define PG8_LDA(dst, b, h) do { _Pragma("unroll") for (int m = 0; m < 4; ++m) _Pragma("unroll") for (int k = 0; k < 2; ++k) dst[m][k] = *(const PG8_LAS bf16x8*)(lds + PG8_SA(b, h) + aoff + m * 2048 + k * 1024); } while (0)
#define PG8_LDB(dst, b, h) do { _Pragma("unroll") for (int n = 0; n < 2; ++n) _Pragma("unroll") for (int k = 0; k < 2; ++k) dst[n][k] = *(const PG8_LAS bf16x8*)(lds + PG8_SB(b, h) + boff + n * 2048 + k * 1024); } while (0)
#define PG8_MMA(ai, bj, At, Bt) do { __builtin_amdgcn_s_setprio(1); _Pragma("unroll") for (int m = 0; m < 4; ++m) _Pragma("unroll") for (int n = 0; n < 2; ++n) _Pragma("unroll") for (int k = 0; k < 2; ++k) \
    acc[ai][bj][m][n] = __builtin_amdgcn_mfma_f32_16x16x32_bf16(Bt[n][k], At[m][k], acc[ai][bj][m][n], 0, 0, 0); __builtin_amdgcn_s_setprio(0); } while (0)
#define PG8_WAIT_V(n) asm volatile("s_waitcnt vmcnt(" #n ")" ::: "memory")
#define PG8_WAIT_L(n) asm volatile("s_waitcnt lgkmcnt(" #n ")" ::: "memory")
#define PG8_BAR __builtin_amdgcn_s_barrier()
#define PG8_SCHED __builtin_amdgcn_sched_barrier(0)
  Unit cur, nxt; int ui = 0;
  if (!S.next(0, cur)) return;
  f32x4 acc[2][2][4][2];
#pragma unroll
  for (int a = 0; a < 2; ++a)
#pragma unroll
    for (int b = 0; b < 2; ++b)
#pragma unroll
      for (int m = 0; m < 4; ++m)
#pragma unroll
        for (int n = 0; n < 2; ++n) acc[a][b][m][n] = (f32x4){0.f, 0.f, 0.f, 0.f};
  bf16x8 At[4][2], B0[2][2], B1[2][2];
  const char* cA = (const char*)g.A + (size_t)cur.pm * tstep; const char* cB = (const char*)g.Bt + (size_t)cur.pn * tstep;
  PG8_STAGE(PG8_SB(0, 0), cB, voffB); PG8_STAGE(PG8_SA(0, 0), cA, voffA); PG8_STAGE(PG8_SB(0, 1), cB + hstep, voffB); PG8_STAGE(PG8_SA(0, 1), cA + hstep, voffA);
  if (wr == 1) PG8_BAR;
  PG8_WAIT_V(4); PG8_BAR;
  PG8_STAGE(PG8_SB(1, 0), cB + kstep, voffB); PG8_STAGE(PG8_SA(1, 0), cA + kstep, voffA); PG8_STAGE(PG8_SB(1, 1), cB + hstep + kstep, voffB);
  PG8_WAIT_V(6); PG8_BAR;
  for (;;) {
    const bool has_next = S.next(ui + 1, nxt);
    const char* nA = has_next ? (const char*)g.A + (size_t)nxt.pm * tstep : cA; const char* nB = has_next ? (const char*)g.Bt + (size_t)nxt.pn * tstep : cB;
    for (int t = 0; t < nt; t += 2) {
      const bool last = (t == nt - 2);
      const char* a1 = cA + (size_t)(t + 1) * kstep;
      const char* a2 = last ? nA : cA + (size_t)(t + 2) * kstep; const char* b2 = last ? nB : cB + (size_t)(t + 2) * kstep;
      const char* a3 = a2 + kstep; const char* b3 = b2 + kstep;
      PG8_LDB(B0, 0, 0); PG8_SCHED; PG8_LDA(At, 0, 0); PG8_STAGE(PG8_SA(1, 1), a1 + hstep, voffA);
      PG8_WAIT_L(8); PG8_BAR; PG8_WAIT_L(0); PG8_MMA(0, 0, At, B0); PG8_BAR; PG8_SCHED;
      PG8_LDB(B1, 0, 1); PG8_STAGE(PG8_SB(0, 0), b2, voffB);
      PG8_BAR; PG8_WAIT_L(0); PG8_MMA(0, 1, At, B1); PG8_BAR;
      PG8_LDA(At, 0, 1); PG8_STAGE(PG8_SA(0, 0), a2, voffA);
      PG8_BAR; PG8_WAIT_L(0); PG8_MMA(1, 0, At, B0); PG8_BAR; PG8_SCHED;
      PG8_STAGE(PG8_SB(0, 1), b2 + hstep, voffB);
      PG8_WAIT_V(6); PG8_BAR; PG8_MMA(1, 1, At, B1); PG8_BAR;
      PG8_LDB(B0, 1, 0); PG8_SCHED; PG8_LDA(At, 1, 0); PG8_STAGE(PG8_SA(0, 1), a2 + hstep, voffA);
      PG8_WAIT_L(8); PG8_BAR; PG8_WAIT_L(0); PG8_MMA(0, 0, At, B0); PG8_BAR; PG8_SCHED;
      PG8_LDB(B1, 1, 1); PG8_STAGE(PG8_SB(1, 0), b3, voffB);
      PG8_BAR; PG8_WAIT_L(0); PG8_MMA(0, 1, At, B1); PG8_BAR;
      PG8_LDA(At, 1, 1); PG8_STAGE(PG8_SA(1, 0), a3, voffA);
      PG8_BAR; PG8_WAIT_L(0); PG8_MMA(1, 0, At, B0); PG8_BAR; PG8_SCHED;
      PG8_STAGE(PG8_SB(1, 1), b3 + hstep, voffB);
      PG8_WAIT_V(6); PG8_BAR; PG8_MMA(1, 1, At, B1); PG8_BAR;
    }
    E(acc, cur, wr, wc, fr, fq);
    if (!has_next) break;
#pragma unroll
    for (int a = 0; a < 2; ++a)
#pragma unroll
      for (int b = 0; b < 2; ++b)
#pragma unroll
        for (int m = 0; m < 4; ++m)
#pragma unroll
          for (int n = 0; n < 2; ++n) acc[a][b][m][n] = (f32x4){0.f, 0.f, 0.f, 0.f};
    cur = nxt; cA = nA; cB = nB; ++ui;
  }
  PG8_WAIT_V(0);
  if (wr == 0) PG8_BAR;
  PG8_BAR;
#undef PG8_SA
#undef PG8_SB
#undef PG8_STAGE
#undef PG8_LDA
#undef PG8_LDB
#undef PG8_MMA
#undef PG8_WAIT_V
#undef PG8_WAIT_L
#undef PG8_BAR
#undef PG8_SCHED
}
DI u32x4 pk8(const f32x4& v0, const f32x4& v1, float s) { return u32x4{pk2(v0[0] * s, v0[1] * s), pk2(v0[2] * s, v0[3] * s), pk2(v1[0] * s, v1[1] * s), pk2(v1[2] * s, v1[3] * s)}; }
struct EpiBf16 {
  static constexpr bool PERM = true;
  bf16_t* out; int ld; float scale;
  DI void operator()(const f32x4 (&acc)[2][2][4][2], const Unit& u, int wr, int wc, int fr, int fq) const {
    const int row0 = u.pm * BM + wr * 64 + fr, col0 = u.pn * BM + wc * 32 + 8 * fq;
#pragma unroll
    for (int ai = 0; ai < 2; ++ai)
#pragma unroll
      for (int m = 0; m < 4; ++m) { bf16_t* rowp = out + (size_t)(row0 + ai * HALF + m * 16) * ld + col0;
#pragma unroll
        for (int bj = 0; bj < 2; ++bj) *(u32x4*)(rowp + bj * HALF) = pk8(acc[ai][bj][m][0], acc[ai][bj][m][1], scale); }
  }
};
struct EpiInproj {
  static constexpr bool PERM = true;
  bf16_t* lat; bf16_t* qs; bf16_t* ks; bf16_t* vs;
  DI void operator()(const f32x4 (&acc)[2][2][4][2], const Unit& u, int wr, int wc, int fr, int fq) const {
    const int row0 = u.pm * BM + wr * 64 + fr;
#pragma unroll
    for (int bj = 0; bj < 2; ++bj) {
      const int cw = u.pn * BM + bj * HALF + wc * 32;
      bf16_t* dst; int ld; float sc = 1.0f;
      if (cw < 448) { dst = lat + cw; ld = 448; } else if (cw < 960) { dst = qs + (cw - 448); ld = 512; sc = SWA_QSCALE; }
      else if (cw < 1088) { dst = ks + (cw - 960); ld = 128; } else if (cw < 1216) { dst = vs + (cw - 1088); ld = 128; } else continue;
#pragma unroll
      for (int ai = 0; ai < 2; ++ai)
#pragma unroll
        for (int m = 0; m < 4; ++m) *(u32x4*)(dst + (size_t)(row0 + ai * HALF + m * 16) * ld + 8 * fq) = pk8(acc[ai][bj][m][0], acc[ai][bj][m][1], sc);
    }
  }
};
template <bool BASE_F32>
struct EpiResid16 {
  static constexpr bool PERM = true;
  const void* base; bf16_t* out; int ld; float scale;
  DI void operator()(const f32x4 (&acc)[2][2][4][2], const Unit& u, int wr, int wc, int fr, int fq) const {
    const int row0 = u.pm * BM + wr * 64 + fr, col0 = u.pn * BM + wc * 32 + 8 * fq;
#pragma unroll
    for (int ai = 0; ai < 2; ++ai)
#pragma unroll
      for (int m = 0; m < 4; ++m) { const size_t ro = (size_t)(row0 + ai * HALF + m * 16) * ld + col0;
        f32x4 b[2][2];
#pragma unroll
        for (int bj = 0; bj < 2; ++bj) {
          if (BASE_F32) { b[bj][0] = *(const f32x4*)((const float*)base + ro + bj * HALF); b[bj][1] = *(const f32x4*)((const float*)base + ro + bj * HALF + 4); }
          else { const u32x4 w = *(const u32x4*)((const bf16_t*)base + ro + bj * HALF);
            b[bj][0] = f32x4{bflo(w[0]), bfhi(w[0]), bflo(w[1]), bfhi(w[1])}; b[bj][1] = f32x4{bflo(w[2]), bfhi(w[2]), bflo(w[3]), bfhi(w[3])}; }
        }
#pragma unroll
        for (int bj = 0; bj < 2; ++bj) *(u32x4*)(out + ro + bj * HALF) = pk8(b[bj][0] + acc[ai][bj][m][0] * scale, b[bj][1] + acc[ai][bj][m][1] * scale, 1.0f);
        if (m & 1) asm volatile("" ::: "memory"); }
  }
};
template <class Epi>
DI void run_on(const bf16_t* A, const bf16_t* Bt, int M, int N, int K, const Epi& E, char* smem, int c, int G) {
  StaticOrder S; S.init(M, N, G, c);
  gemm_phase<Epi>((PG8_LAS unsigned char*)smem, Gemm{A, Bt, M, N, K}, S, E);
  __syncthreads();
}
template <class Epi>
DI void run(const bf16_t* A, const bf16_t* Bt, int M, int N, int K, const Epi& E, char* smem) { run_on(A, Bt, M, N, K, E, smem, (int)blockIdx.x, (int)gridDim.x); }
}

DI int tokey(float f) { const int u = __float_as_int(f); return u ^ ((u >> 31) & 0x7fffffff); }
DI float fromkey(int k) { return __int_as_float(k ^ ((k >> 31) & 0x7fffffff)); }
DI void ins16(int (&top)[16], int key) {
#pragma unroll
  for (int j = 0; j < 16; ++j) { const int h = max(top[j], key); key = min(top[j], key); top[j] = h; }
}

DI void score_phase(const Params& p, char* smem) {
  const int ntn = T / G_BN, total = (2048 / G_BM) * ntn;
  for (int L = blockIdx.x; L < total; L += gridDim.x) {
    const int wg = (L & 7) * (total >> 3) + (L >> 3);
    const int pn = wg >> 3, pm = wg & 7;
    f32x16 acc[4];
    gemm_mainloop<1>(p.wt_sc, DM, p.xn, DM, DM, pm * G_BM, pn * G_BN, acc, smem);
    SBAR();
    int tid_ = threadIdx.x; asm volatile("" : "+v"(tid_));
    const int tid = tid_, lane = tid & 63, wid = tid >> 6, r32 = lane & 31, hi = lane >> 5;
    const int group = pm * 2 + (wid >> 2);
    const int tok = pn * G_BN + (wid & 3) * 32 + r32;
    int top[16];
    {
      int g[4][16];
#pragma unroll
      for (int mi = 0; mi < 4; ++mi)
#pragma unroll
        for (int r = 0; r < 16; ++r) { const int n = 32 * mi + crow(r, hi); g[mi][r] = (tokey(acc[mi][r]) & ~127) | (127 - n); }
#pragma unroll
      for (int mi = 0; mi < 4; ++mi)
#pragma unroll
        for (int k = 2; k <= 16; k <<= 1)
#pragma unroll
          for (int j = k >> 1; j >= 1; j >>= 1)
#pragma unroll
            for (int i = 0; i < 16; ++i) { const int l = i ^ j; if (l > i) { const int a = g[mi][i], b = g[mi][l]; const bool desc = (k == 16) || ((i & k) == 0);
              g[mi][i] = desc ? max(a, b) : min(a, b); g[mi][l] = desc ? min(a, b) : max(a, b); } }
      auto merge16 = [](int (&a)[16], const int (&b)[16]) {
#pragma unroll
        for (int i = 0; i < 16; ++i) a[i] = max(a[i], b[15 - i]);
#pragma unroll
        for (int d = 8; d >= 1; d >>= 1)
#pragma unroll
          for (int i = 0; i < 16; ++i) if ((i & d) == 0) { const int x = max(a[i], a[i + d]), y = min(a[i], a[i + d]); a[i] = x; a[i + d] = y; }
      };
      merge16(g[0], g[1]); merge16(g[2], g[3]); merge16(g[0], g[2]);
#pragma unroll
      for (int i = 0; i < 16; ++i) top[i] = g[0][i];
    }
    int c[16];
#pragma unroll
    for (int j = 0; j < 16; ++j) {
      auto rr = __builtin_amdgcn_permlane32_swap((unsigned)top[15 - j], (unsigned)top[15 - j], false, false);
      const int other = hi ? (int)rr[0] : (int)rr[1];
      c[j] = max(top[j], other);
    }
#pragma unroll
    for (int d = 8; d >= 1; d >>= 1)
#pragma unroll
      for (int i = 0; i < 16; ++i) if ((i & d) == 0) { const int a = max(c[i], c[i + d]), b = min(c[i], c[i + d]); c[i] = a; c[i + d] = b; }
    int* dst = p.top1 + ((size_t)tok * 16 + group) * 16 + hi * 8;
    if (hi == 0) { *(i32x4*)dst = i32x4{c[0], c[1], c[2], c[3]}; *(i32x4*)(dst + 4) = i32x4{c[4], c[5], c[6], c[7]}; }
    else         { *(i32x4*)dst = i32x4{c[8], c[9], c[10], c[11]}; *(i32x4*)(dst + 4) = i32x4{c[12], c[13], c[14], c[15]}; }
    SBAR();
  }
}

DI void ins16v(float (&bv)[16], int (&bp)[16], float v, int pl) {
#pragma unroll
  for (int j = 0; j < 16; ++j) { const bool c = v > bv[j]; const float nv = c ? bv[j] : v; const int np = c ? bp[j] : pl; bv[j] = c ? v : bv[j]; bp[j] = c ? pl : bp[j]; v = nv; pl = np; }
}
DI void topk2_phase(const Params& p) {
  const int nitems = T * 8;
  for (int it = blockIdx.x * NTHREADS + threadIdx.x; it < nitems; it += gridDim.x * NTHREADS) {
    const int* src = p.top1 + (size_t)it * 32;
    int ka[16], kb[16];
#pragma unroll
    for (int q = 0; q < 4; ++q) { const i32x4 v = *(const i32x4*)(src + 4 * q); ka[4 * q] = v[0]; ka[4 * q + 1] = v[1]; ka[4 * q + 2] = v[2]; ka[4 * q + 3] = v[3]; }
#pragma unroll
    for (int q = 0; q < 4; ++q) { const i32x4 v = *(const i32x4*)(src + 16 + 4 * q); kb[4 * q] = v[0]; kb[4 * q + 1] = v[1]; kb[4 * q + 2] = v[2]; kb[4 * q + 3] = v[3]; }
    float av[16], bvv[16]; int ia[16], ib[16];
#pragma unroll
    for (int i = 0; i < 16; ++i) { av[i] = fromkey(ka[i] & ~127); ia[i] = (127 - (ka[i] & 127)) << 7; bvv[i] = fromkey(kb[i] & ~127); ib[i] = 127 - (kb[i] & 127); }
    int best[16];
#pragma unroll
    for (int j = 0; j < 16; ++j) best[j] = (int)0x80000000;
#pragma unroll
    for (int i = 0; i < 16; ++i)
#pragma unroll
      for (int j = 0; j < 16; ++j)
        if ((i + 1) * (j + 1) <= 16) ins16(best, (tokey(av[i] + bvv[j]) & ~0x3fff) | ia[i] | ib[j]);
    float bv[16]; int bp[16];
#pragma unroll
    for (int j = 0; j < 16; ++j) { bv[j] = fromkey(best[j] & ~0x3fff); bp[j] = best[j] & 0x3fff; }
    const float m = bv[0];
    float w[16], sum = 0.f;
#pragma unroll
    for (int j = 0; j < 16; ++j) { w[j] = __builtin_amdgcn_exp2f((bv[j] - m) * LOG2E); sum += w[j]; }
    const float inv = 1.0f / sum;
    int* di = p.pidx + (size_t)it * 16; float* dg = p.pg + (size_t)it * 16;
#pragma unroll
    for (int q = 0; q < 4; ++q) {
      *(i32x4*)(di + 4 * q) = i32x4{bp[4 * q], bp[4 * q + 1], bp[4 * q + 2], bp[4 * q + 3]};
#if DBG == 5
      *(f32x4*)(dg + 4 * q) = f32x4{0.0625f, 0.0625f, 0.0625f, 0.0625f};
#else
      *(f32x4*)(dg + 4 * q) = f32x4{w[4 * q] * inv, w[4 * q + 1] * inv, w[4 * q + 2] * inv, w[4 * q + 3] * inv};
#endif
    }
  }
}

template <int NDB> DI int v_st(int k, int c) { const int kk = (k & ~0xC) | ((k & 4) << 1) | ((k & 8) >> 1); return ((kk >> 3) * NDB + (c >> 5)) * 512 + ((kk & 7) * 32 + (c & 31)) * 2; }
DI int v_rd_base(int lane) { return ((lane & 3) << 3) | (((lane >> 2) & 3) << 6) | (((lane >> 4) & 1) << 5) | (((lane >> 5) & 1) << 8); }
template <int OFF> DI s16x4 tr_read(int vb) { s16x4 r; asm volatile("ds_read_b64_tr_b16 %0, %1 offset:%2" : "=&v"(r) : "v"(vb), "i"(OFF) : "memory"); return r; }
template <int NDB, int D0> DI void pv_one(f32x16& od, int vb, bf16x8 pa0, bf16x8 pa1, bf16x8 pa2, bf16x8 pa3) {
  constexpr int KS = 2 * NDB * 512, HF = NDB * 512;
  const s16x4 l0 = tr_read<D0 * 512 + 0 * KS>(vb), h0 = tr_read<D0 * 512 + 0 * KS + HF>(vb), l1 = tr_read<D0 * 512 + 1 * KS>(vb), h1 = tr_read<D0 * 512 + 1 * KS + HF>(vb);
  const s16x4 l2 = tr_read<D0 * 512 + 2 * KS>(vb), h2 = tr_read<D0 * 512 + 2 * KS + HF>(vb), l3 = tr_read<D0 * 512 + 3 * KS>(vb), h3 = tr_read<D0 * 512 + 3 * KS + HF>(vb);
  asm volatile("s_waitcnt lgkmcnt(0)" ::: "memory"); SBAR();
#define PKV(L, H) (bf16x8){L[0], L[1], L[2], L[3], H[0], H[1], H[2], H[3]}
  od = MFMA32(pa0, PKV(l0, h0), od); od = MFMA32(pa1, PKV(l1, h1), od); od = MFMA32(pa2, PKV(l2, h2), od); od = MFMA32(pa3, PKV(l3, h3), od);
#undef PKV
}

template <int OFF> DI void pv_rd4(int vb, s16x4 (&l)[2], s16x4 (&h)[2]) {
  constexpr int KS = 2 * 4 * 512, HF = 4 * 512;
  l[0] = tr_read<OFF>(vb); h[0] = tr_read<OFF + HF>(vb); l[1] = tr_read<OFF + KS>(vb); h[1] = tr_read<OFF + KS + HF>(vb);
}
#define PKV(L, H) (bf16x8){L[0], L[1], L[2], L[3], H[0], H[1], H[2], H[3]}
DI void pv_all4(f32x16 (&o)[4], int vb, bf16x8 pa0, bf16x8 pa1, bf16x8 pa2, bf16x8 pa3) {
  constexpr int KS2 = 2 * 2 * 4 * 512;
  s16x4 la[2], ha[2], lb[2], hb[2];
  pv_rd4<0 * 512>(vb, la, ha); pv_rd4<0 * 512 + KS2>(vb, lb, hb);
#define PV_STEP(D, NEXTA, NEXTB) \
  asm volatile("s_waitcnt lgkmcnt(4)" ::: "memory"); SBAR(); \
  o[D] = MFMA32(pa0, PKV(la[0], ha[0]), o[D]); o[D] = MFMA32(pa1, PKV(la[1], ha[1]), o[D]); SBAR(); \
  NEXTA; \
  asm volatile("s_waitcnt lgkmcnt(4)" ::: "memory"); SBAR(); \
  o[D] = MFMA32(pa2, PKV(lb[0], hb[0]), o[D]); o[D] = MFMA32(pa3, PKV(lb[1], hb[1]), o[D]); SBAR(); \
  NEXTB;
  PV_STEP(0, (pv_rd4<1 * 512>(vb, la, ha)), (pv_rd4<1 * 512 + KS2>(vb, lb, hb)))
  PV_STEP(1, (pv_rd4<2 * 512>(vb, la, ha)), (pv_rd4<2 * 512 + KS2>(vb, lb, hb)))
  PV_STEP(2, (pv_rd4<3 * 512>(vb, la, ha)), (pv_rd4<3 * 512 + KS2>(vb, lb, hb)))
  asm volatile("s_waitcnt lgkmcnt(4)" ::: "memory"); SBAR();
  o[3] = MFMA32(pa0, PKV(la[0], ha[0]), o[3]); o[3] = MFMA32(pa1, PKV(la[1], ha[1]), o[3]); SBAR();
  asm volatile("s_waitcnt lgkmcnt(0)" ::: "memory"); SBAR();
  o[3] = MFMA32(pa2, PKV(lb[0], hb[0]), o[3]); o[3] = MFMA32(pa3, PKV(lb[1], hb[1]), o[3]);
#undef PV_STEP
}
#undef PKV

template <int DQK, int DV, int MODE>
struct AttnArgs {
  const bf16_t* Kb; int ldk;
  const bf16_t* Vb; int ldv;
  int jt0, NT;
  int tq;
  int diag_tile;
  int tw0;
  float slope2, sink2;
  bf16_t* Ow; int ldo;
};

template <int DQK, int DV, int MODE, int QL>
DI void attn_unit(const bf16x8 (&qr)[DQK / 16 - QL], const AttnArgs<DQK, DV, MODE>& a, char* smem) {
  constexpr int NKS = DQK / 16, NDB = DV / 32, KSTR = DQK * 2 + 16, KBUF = 64 * KSTR, VBUF = 64 * DV * 2, BUF = KBUF + VBUF, NKC = DQK / 64, NVC = DV / 64;
  const int tid = threadIdx.x, wid = __builtin_amdgcn_readfirstlane(tid >> 6), lane = tid & 63, r32 = lane & 31, hi = lane >> 5;
  const bool rot = (wid >= 4);
  float* wsf = (float*)(smem + 3 * BUF) + wid * 64; float* li_l = wsf; float* al_l = wsf + 32;
  const char* qlds = smem + 3 * BUF + 2048 + wid * 4096 + r32 * 128;
  const int qx = (r32 >> 1) & 7;
  float m_reg = -1e30f, l_reg = 0.f; f32x16 o[NDB];
#pragma unroll
  for (int d = 0; d < NDB; ++d) o[d] = f32x16{};
  const int srow = tid >> 3, c8 = tid & 7;
  const int vb0 = (int)(uintptr_t)smem + v_rd_base(lane);
  bf16x8 kst[NKC], vst[(MODE == 0) ? 1 : NVC];
  auto sload = [&](int jt) {
    const size_t krow = (size_t)(jt * 64 + srow);
#pragma unroll
    for (int i = 0; i < NKC; ++i) kst[i] = *(const bf16x8*)(a.Kb + krow * a.ldk + 64 * i + 8 * c8);
    if (MODE != 0) {
#pragma unroll
      for (int i = 0; i < NVC; ++i) vst[i] = *(const bf16x8*)(a.Vb + krow * a.ldv + 64 * i + 8 * c8);
    }
  };
  auto swrite = [&](int b) {
    char* bp = smem + b * BUF;
#pragma unroll
    for (int i = 0; i < NKC; ++i) *(bf16x8*)(bp + VBUF + srow * KSTR + (64 * i + 8 * c8) * 2) = kst[i];
    if (MODE == 0) {
#pragma unroll
      for (int i = 0; i < NVC; ++i) *(bf16x8*)(bp + v_st<NDB>(srow, 64 * i + 8 * c8)) = kst[i];
    } else {
#pragma unroll
      for (int i = 0; i < NVC; ++i) *(bf16x8*)(bp + v_st<NDB>(srow, 64 * i + 8 * c8)) = vst[i];
    }
  };
  auto tile_active = [&](int jt) -> bool { if (MODE == 2) return (jt * 64 + 63 >= a.tw0 - 127) && (jt * 64 <= a.tw0 + 31); return true; };
  f32x16 p0, p1;
  auto qkt = [&](int b) {
    p0 = f32x16{}; p1 = f32x16{};
    const char* Kc = smem + b * BUF + VBUF + r32 * KSTR + hi * 16;
    __builtin_amdgcn_s_setprio(1);
#pragma unroll
    for (int s = 0; s < NKS - QL; ++s) {
      const bf16x8 b0 = *(const bf16x8*)(Kc + s * 32), b1 = *(const bf16x8*)(Kc + 32 * KSTR + s * 32);
      p0 = MFMA32(b0, qr[s], p0); p1 = MFMA32(b1, qr[s], p1);
    }
#pragma unroll
    for (int s = NKS - QL; s < NKS; ++s) {
      const bf16x8 b0 = *(const bf16x8*)(Kc + s * 32), b1 = *(const bf16x8*)(Kc + 32 * KSTR + s * 32);
      const bf16x8 qf = *(const bf16x8*)(qlds + (((2 * (s - (NKS - QL)) + hi) ^ qx) << 4));
      p0 = MFMA32(b0, qf, p0); p1 = MFMA32(b1, qf, p1);
    }
    __builtin_amdgcn_s_setprio(0);
  };
  sload(a.jt0); swrite(0);
  if (a.NT > 1) { sload(a.jt0 + 1); swrite(1); }
  __syncthreads();
  if (rot && tile_active(a.jt0)) qkt(0);
  int cur = 0;
  for (int j = 0; j < a.NT; ++j) {
    const int jt = a.jt0 + j;
    int nxt = cur + 1; if (nxt == 3) nxt = 0;
    int nx2 = nxt + 1; if (nx2 == 3) nx2 = 0;
    if (j + 2 < a.NT) sload(jt + 2);
    const bool active = tile_active(jt);
    if (active) {
      if (!rot) qkt(cur);
      if (MODE == 0) {
        if (jt == a.diag_tile) {
          const int tl = a.tq & 63;
#pragma unroll
          for (int r = 0; r < 16; ++r) { const int kl = crow(r, hi); if (kl > tl) p0[r] = -INFINITY; if (kl + 32 > tl) p1[r] = -INFINITY; }
        }
      } else if (MODE == 2) {
#pragma unroll
        for (int r = 0; r < 16; ++r) {
          const int d0 = a.tq - (jt * 64 + crow(r, hi)), d1 = d0 - 32;
          p0[r] = (d0 >= 0 && d0 < 128) ? p0[r] - a.slope2 * (float)d0 : -INFINITY;
          p1[r] = (d1 >= 0 && d1 < 128) ? p1[r] - a.slope2 * (float)d1 : -INFINITY;
        }
      }
      float pmax = p0[0];
#pragma unroll
      for (int r = 1; r < 16; ++r) pmax = fmaxf(pmax, p0[r]);
#pragma unroll
      for (int r = 0; r < 16; ++r) pmax = fmaxf(pmax, p1[r]);
      { auto rr = __builtin_amdgcn_permlane32_swap(__float_as_uint(pmax), __float_as_uint(pmax), false, false); pmax = fmaxf(__uint_as_float(rr[0]), __uint_as_float(rr[1])); }
      float mn, alpha;
      if (__all(pmax - m_reg <= SM_THR)) { mn = m_reg; alpha = 1.f; }
      else { mn = fmaxf(m_reg, pmax); alpha = __builtin_amdgcn_exp2f(m_reg - mn); m_reg = mn; }
#pragma unroll
      for (int r = 0; r < 16; ++r) { p0[r] = __builtin_amdgcn_exp2f(p0[r] - mn); p1[r] = __builtin_amdgcn_exp2f(p1[r] - mn); }
      float ps = 0.f;
#pragma unroll
      for (int r = 0; r < 16; ++r) ps += p0[r] + p1[r];
      { auto rr = __builtin_amdgcn_permlane32_swap(__float_as_uint(ps), __float_as_uint(ps), false, false); ps = __uint_as_float(rr[0]) + __uint_as_float(rr[1]); }
      l_reg = l_reg * alpha + ps;
      if (__any(alpha < 1.f)) {
        if (hi == 0) al_l[r32] = alpha;
        asm volatile("s_waitcnt lgkmcnt(0)" ::: "memory");
#pragma unroll
        for (int r = 0; r < 16; ++r) { const float al = al_l[crow(r, hi)];
#pragma unroll
          for (int d = 0; d < NDB; ++d) o[d][r] *= al; }
      }
      bf16x8 pa0, pa1, pa2, pa3;
#define PK4(P, BASE, OUT) do { const unsigned a0 = pk2(P[BASE + 0], P[BASE + 1]), a1 = pk2(P[BASE + 2], P[BASE + 3]);   \
      const unsigned b0_ = pk2(P[BASE + 4], P[BASE + 5]), b1_ = pk2(P[BASE + 6], P[BASE + 7]);                          \
      auto r0 = __builtin_amdgcn_permlane32_swap(a0, b0_, false, false); auto r1 = __builtin_amdgcn_permlane32_swap(a1, b1_, false, false); \
      u32x4 w = {r0[0], r1[0], r0[1], r1[1]}; OUT = __builtin_bit_cast(bf16x8, w); } while (0)
      PK4(p0, 0, pa0); PK4(p0, 8, pa1); PK4(p1, 0, pa2); PK4(p1, 8, pa3);
#undef PK4
      const int vb = vb0 + cur * BUF;
      __builtin_amdgcn_s_setprio(1);
      pv_one<NDB, 0>(o[0], vb, pa0, pa1, pa2, pa3);
      pv_one<NDB, 1>(o[1], vb, pa0, pa1, pa2, pa3);
      if constexpr (NDB > 2) { pv_one<NDB, 2>(o[2], vb, pa0, pa1, pa2, pa3); pv_one<NDB, 3>(o[3], vb, pa0, pa1, pa2, pa3); }
      __builtin_amdgcn_s_setprio(0);
    }
    if (j + 2 < a.NT) swrite(nx2);
    if (rot && j + 1 < a.NT && tile_active(jt + 1)) qkt(nxt);
    __syncthreads();
    cur = nxt;
  }
  if (MODE == 2) l_reg += __builtin_amdgcn_exp2f(a.sink2 - m_reg);
  if (hi == 0) li_l[r32] = l_reg;
  asm volatile("s_waitcnt lgkmcnt(0)" ::: "memory");
#pragma unroll
  for (int r = 0; r < 16; ++r) {
    const int orow = crow(r, hi); const float rl = 1.0f / li_l[orow];
#pragma unroll
    for (int d = 0; d < NDB; ++d) a.Ow[(size_t)orow * a.ldo + d * 32 + r32] = f2bf(o[d][r] * rl);
  }
  __syncthreads();
}

#ifndef P8_SCL_SIGN
#define P8_SCL_SIGN 1
#endif
typedef short s16x2 __attribute__((ext_vector_type(2)));
#define MFMA32F8(a, b, c) __builtin_amdgcn_mfma_f32_32x32x16_fp8_fp8((a), (b), (c), 0, 0, 0)
typedef int i32x8u __attribute__((ext_vector_type(8)));
DI void mla_unit(const i32x8u (&q8)[3], const unsigned char* __restrict__ K8b, const unsigned char* __restrict__ Vt8b, int NT, int tl, bf16_t* Ow, char* smem) {
  constexpr int NDB = 4, KSTR = 192, VBUF = 8192, KBUF = 64 * KSTR, BUF = VBUF + KBUF;
  const int tid = threadIdx.x, wid = __builtin_amdgcn_readfirstlane(tid >> 6), lane = tid & 63, r32 = lane & 31, hi = lane >> 5;
  float* li_l = (float*)(smem + 3 * BUF) + wid * 64;
  float l_reg = 0.f; f32x16 o[NDB];
#pragma unroll
  for (int d = 0; d < NDB; ++d) o[d] = f32x16{};
  unsigned ksrc[2];
#pragma unroll
  for (int i = 0; i < 2; ++i) { const int q = i * 512 + tid, row = q / 12, pc = q - 12 * row, c = (pc & 12) | ((pc & 3) ^ ((row >> 2) & 3)); ksrc[i] = (unsigned)(row * 192 + c * 16); }
  const unsigned vsrc = (unsigned)((tid >> 2) * SEQ + 16 * ((tid & 3) ^ ((tid >> 4) & 3)));
  const char* K8base = (const char*)K8b; const char* Vbase = (const char*)Vt8b;
  auto stage = [&](int jt, int b) {
    const char* tk = K8base + (size_t)jt * (64 * 192); const char* tv = Vbase + (size_t)jt * 64; char* bp = smem + b * BUF + tid * 16;
    { unsigned off = vsrc; asm volatile("" : "+v"(off));
      __builtin_amdgcn_global_load_lds((const unsigned*)(tv + off), LDSP(bp), 16, 0, 0); }
    { unsigned off = ksrc[0]; asm volatile("" : "+v"(off)); __builtin_amdgcn_global_load_lds((const unsigned*)(tk + off), LDSP(bp + VBUF), 16, 0, 0); }
    if (wid < 4) { unsigned off = ksrc[1]; asm volatile("" : "+v"(off)); __builtin_amdgcn_global_load_lds((const unsigned*)(tk + off), LDSP(bp + VBUF + 8192), 16, 0, 0); }
  };
#define DSR(dst, addr, OFF) asm volatile("ds_read_b128 %0, %1 offset:%2" : "=&v"(dst) : "v"(addr), "i"(OFF) : "memory")
#define QK_WAIT(n) do { asm volatile("s_waitcnt lgkmcnt(" #n ")" ::: "memory"); SBAR(); } while (0)
#define QK_RD(A0, A1, B0, B1, pb) do { DSR(A0, ka0, (pb) * 64); DSR(A1, ka1, (pb) * 64); DSR(B0, ka0, 32 * KSTR + (pb) * 64); DSR(B1, ka1, 32 * KSTR + (pb) * 64); } while (0)
#define CAT8(X, Y) (i32x8u){(int)(X)[0], (int)(X)[1], (int)(X)[2], (int)(X)[3], (int)(Y)[0], (int)(Y)[1], (int)(Y)[2], (int)(Y)[3]}
#define MF8(A, B, C) __builtin_amdgcn_mfma_scale_f32_32x32x64_f8f6f4((A), (B), (C), 0, 0, 0, 0x7f7f7f7f, 0, 0x7f7f7f7f)
#define EX(i) do { if ((i) < 16) c0[(i) & 15] = __builtin_amdgcn_exp2f(c0[(i) & 15]); else c1[(i) & 15] = __builtin_amdgcn_exp2f(c1[(i) & 15]); } while (0)
#define EX4(i) do { EX(i); EX((i) + 1); EX((i) + 2); EX((i) + 3); } while (0)
#define EX6(i) do { EX4(i); EX((i) + 4); EX((i) + 5); } while (0)
  const int swz = (r32 >> 2) & 3;
  const int kofs0 = r32 * KSTR + (((2 * hi) ^ swz) << 4), kofs1 = r32 * KSTR + (((2 * hi + 1) ^ swz) << 4);
  const int vofs0 = r32 * 64 + (((2 * hi) ^ swz) << 4), vofs1 = r32 * 64 + (((2 * hi + 1) ^ swz) << 4);
  const f32x16 zero = f32x16{};
  auto qkt = [&](int b, f32x16& n0, f32x16& n1) {
    const int kb = (int)(uintptr_t)(smem + b * BUF + VBUF), ka0 = kb + kofs0, ka1 = kb + kofs1;
    u32x4 a0, a1, a2, a3, b0, b1, b2, b3;
    QK_RD(a0, a1, a2, a3, 0); QK_RD(b0, b1, b2, b3, 1);
    QK_WAIT(4); n0 = MF8(CAT8(a0, a1), q8[0], zero); n1 = MF8(CAT8(a2, a3), q8[0], zero); SBAR(); QK_RD(a0, a1, a2, a3, 2);
    QK_WAIT(4); n0 = MF8(CAT8(b0, b1), q8[1], n0); n1 = MF8(CAT8(b2, b3), q8[1], n1); SBAR();
    QK_WAIT(0); n0 = MF8(CAT8(a0, a1), q8[2], n0); n1 = MF8(CAT8(a2, a3), q8[2], n1); SBAR();
  };
  auto finish = [&](f32x16& c0, f32x16& c1, int cur) {
    u32x4 v0a, v0b, v1a, v1b, v2a, v2b, v3a, v3b;
    {
      const int vbs = (int)(uintptr_t)(smem + cur * BUF), va0 = vbs + vofs0, va1 = vbs + vofs1;
      DSR(v0a, va0, 0); DSR(v0b, va1, 0); DSR(v1a, va0, 2048); DSR(v1b, va1, 2048); DSR(v2a, va0, 4096); DSR(v2b, va1, 4096); DSR(v3a, va0, 6144); DSR(v3b, va1, 6144);
      SBAR();
    }
    float ps;
    {
      f32x2 s2 = f32x2{c0[0], c0[1]} + f32x2{c0[2], c0[3]}, s3 = f32x2{c0[4], c0[5]} + f32x2{c0[6], c0[7]}, s4 = f32x2{c0[8], c0[9]} + f32x2{c0[10], c0[11]}, s5 = f32x2{c0[12], c0[13]} + f32x2{c0[14], c0[15]};
      s2 += f32x2{c1[0], c1[1]}; s3 += f32x2{c1[2], c1[3]}; s4 += f32x2{c1[4], c1[5]}; s5 += f32x2{c1[6], c1[7]};
      s2 += f32x2{c1[8], c1[9]}; s3 += f32x2{c1[10], c1[11]}; s4 += f32x2{c1[12], c1[13]}; s5 += f32x2{c1[14], c1[15]};
      s2 = (s2 + s3) + (s4 + s5);
      ps = s2[0] + s2[1];
    }
    l_reg += ps;
    int ei;
    { auto rr = __builtin_amdgcn_permlane32_swap(__float_as_uint(ps), __float_as_uint(ps), false, false);
      ei = __builtin_amdgcn_frexp_expf(__uint_as_float(rr[0]) + __uint_as_float(rr[1])) - 7; }
    const float scl = __uint_as_float((unsigned)(P8_SCL_SIGN * ei + 127) << 23);
    i32x8u pa;
#pragma unroll
    for (int c = 0; c < 4; ++c) {
      s16x2 w0 = {0, 0}, w1 = {0, 0};
      w0 = __builtin_amdgcn_cvt_scalef32_pk_fp8_f32(w0, c0[4 * c], c0[4 * c + 1], scl, false); w0 = __builtin_amdgcn_cvt_scalef32_pk_fp8_f32(w0, c0[4 * c + 2], c0[4 * c + 3], scl, true);
      w1 = __builtin_amdgcn_cvt_scalef32_pk_fp8_f32(w1, c1[4 * c], c1[4 * c + 1], scl, false); w1 = __builtin_amdgcn_cvt_scalef32_pk_fp8_f32(w1, c1[4 * c + 2], c1[4 * c + 3], scl, true);
      auto rr = __builtin_amdgcn_permlane32_swap(__builtin_bit_cast(unsigned, w0), __builtin_bit_cast(unsigned, w1), false, false);
      pa[c] = (int)rr[0]; pa[4 + c] = (int)rr[1];
    }
    const int sc = ei + 127;
    SBAR();
#define PV_MMA(D, X, Y) o[D] = __builtin_amdgcn_mfma_scale_f32_32x32x64_f8f6f4(pa, CAT8(X, Y), o[D], 0, 0, 0, sc, 0, 0x7f7f7f7f)
    QK_WAIT(6); PV_MMA(0, v0a, v0b); QK_WAIT(4); PV_MMA(1, v1a, v1b); QK_WAIT(2); PV_MMA(2, v2a, v2b); QK_WAIT(0); PV_MMA(3, v3a, v3b);
    SBAR();
#undef PV_MMA
  };
#define MLA_SYNC() do { asm volatile("s_waitcnt vmcnt(0) lgkmcnt(0)" ::: "memory"); __builtin_amdgcn_s_barrier(); asm volatile("" ::: "memory"); } while (0)
  auto body = [&](f32x16& c0, f32x16& c1, f32x16& n0, f32x16& n1, int j, int cur) {
    int nxt = cur + 1; if (nxt == 3) nxt = 0;
    int nx2 = nxt + 1; if (nx2 == 3) nx2 = 0;
    if (j + 2 < NT) stage(j + 2, nx2);
    {
      const int kb = (int)(uintptr_t)(smem + nxt * BUF + VBUF), ka0 = kb + kofs0, ka1 = kb + kofs1;
      u32x4 a0, a1, a2, a3, b0, b1, b2, b3;
      QK_RD(a0, a1, a2, a3, 0); QK_RD(b0, b1, b2, b3, 1);
      QK_WAIT(4);
      n0 = MF8(CAT8(a0, a1), q8[0], zero); SBAR(); EX6(0); SBAR();
      n1 = MF8(CAT8(a2, a3), q8[0], zero); SBAR(); EX6(6); SBAR();
      QK_RD(a0, a1, a2, a3, 2);
      QK_WAIT(4);
      n0 = MF8(CAT8(b0, b1), q8[1], n0); SBAR(); EX6(12); SBAR();
      n1 = MF8(CAT8(b2, b3), q8[1], n1); SBAR(); EX6(18); SBAR();
      QK_WAIT(0);
      n0 = MF8(CAT8(a0, a1), q8[2], n0); SBAR(); EX4(24); SBAR();
      n1 = MF8(CAT8(a2, a3), q8[2], n1); SBAR(); EX4(28); SBAR();
    }
    finish(c0, c1, cur);
    asm volatile("" : "+v"(n0), "+v"(n1));
    MLA_SYNC();
  };
  f32x16 A0, A1, B0, B1;
  stage(0, 0);
  if (NT > 1) stage(1, 1);
  MLA_SYNC();
  qkt(0, A0, A1);
  int j = 0, cur = 0;
  for (; j + 2 < NT; j += 2) {
    body(A0, A1, B0, B1, j, cur); cur = (cur == 2) ? 0 : cur + 1;
    body(B0, B1, A0, A1, j + 1, cur); cur = (cur == 2) ? 0 : cur + 1;
  }
  if (j + 1 < NT) { body(A0, A1, B0, B1, j, cur); cur = (cur == 2) ? 0 : cur + 1; A0 = B0; A1 = B1; }
  {
    f32x16& c0 = A0; f32x16& c1 = A1;
#pragma unroll
    for (int r = 0; r < 16; ++r) { const int kl = crow(r, hi); if (kl > tl) c0[r] = -INFINITY; if (kl + 32 > tl) c1[r] = -INFINITY; }
#pragma unroll
    for (int r = 0; r < 16; ++r) { c0[r] = __builtin_amdgcn_exp2f(c0[r]); c1[r] = __builtin_amdgcn_exp2f(c1[r]); }
    finish(c0, c1, cur);
  }
  { auto rr = __builtin_amdgcn_permlane32_swap(__float_as_uint(l_reg), __float_as_uint(l_reg), false, false); l_reg = __uint_as_float(rr[0]) + __uint_as_float(rr[1]); }
  if (hi == 0) li_l[r32] = l_reg;
  asm volatile("s_waitcnt lgkmcnt(0)" ::: "memory");
  {
    int lo = hi * (4 * 512) + r32; asm volatile("" : "+v"(lo));
    bf16_t* Op = Ow + lo;
#pragma unroll
    for (int r = 0; r < 16; ++r) {
      const float rl = __builtin_amdgcn_rcpf(li_l[crow(r, hi)]);
#pragma unroll
      for (int d = 0; d < NDB; ++d) Op[((r & 3) + 8 * (r >> 2)) * 512 + d * 32] = f2bf(o[d][r] * rl);
    }
  }
  __syncthreads();
#undef MLA_SYNC
#undef DSR
#undef QK_WAIT
#undef CAT8
#undef MF8
#undef EX
#undef EX4
#undef EX6
#undef QK_RD
}

typedef int i32x8 __attribute__((ext_vector_type(8)));
DI void mla_phase(const Params& p, char* smem) {
  const int tid = threadIdx.x, wid = __builtin_amdgcn_readfirstlane(tid >> 6), lane = tid & 63, r32 = lane & 31, hi = lane >> 5;
#ifndef MLA_REPS
#define MLA_REPS 1
#endif
  for (int kk = blockIdx.x; kk < 256 * MLA_REPS; kk += gridDim.x) {
    const int k = kk & 255;
#pragma unroll 1
    for (int half = 0; half < 2; ++half) {
      const int b = k & 1, i0 = k >> 1, i = half ? (255 - i0) : i0;
      const int head = wid >> 1, tq = i * 64 + (wid & 1) * 32 + r32;
      const size_t trow = (size_t)b * SEQ + tq;
      i32x8 q8[3];
      const bf16_t* qrow = p.qcat + trow * 768 + head * 192;
      auto pack4 = [](float a, float b, float c, float d) -> int { int w = 0; w = __builtin_amdgcn_cvt_pk_fp8_f32(a, b, w, false); w = __builtin_amdgcn_cvt_pk_fp8_f32(c, d, w, true); return w; };
#pragma unroll
      for (int pb = 0; pb < 2; ++pb) {
        const bf16_t* qp = qrow + 64 * pb + 32 * hi;
#pragma unroll
        for (int c = 0; c < 4; ++c) { const bf16x8 x = *(const bf16x8*)(qp + 8 * c);
          q8[pb][2 * c] = pack4(bf2f((bf16_t)x[0]), bf2f((bf16_t)x[1]), bf2f((bf16_t)x[2]), bf2f((bf16_t)x[3]));
          q8[pb][2 * c + 1] = pack4(bf2f((bf16_t)x[4]), bf2f((bf16_t)x[5]), bf2f((bf16_t)x[6]), bf2f((bf16_t)x[7])); }
      }
      {
        const float* rp = p.rope + trow * 64;
#pragma unroll
        for (int c = 0; c < 4; ++c) {
          const bf16x8 x1 = *(const bf16x8*)(qrow + 128 + 8 * c), x2 = *(const bf16x8*)(qrow + 160 + 8 * c);
          float v[8];
#pragma unroll
          for (int j = 0; j < 8; ++j) {
            const f32x2 cs = *(const f32x2*)(rp + 2 * (8 * c + j));
            const float a1 = bf2f((bf16_t)x1[j]), a2 = bf2f((bf16_t)x2[j]);
            v[j] = hi ? (a2 * cs[0] + a1 * cs[1]) : (a1 * cs[0] - a2 * cs[1]);
          }
          q8[2][2 * c] = pack4(v[0], v[1], v[2], v[3]); q8[2][2 * c + 1] = pack4(v[4], v[5], v[6], v[7]);
        }
      }
      mla_unit(q8, p.k8 + (size_t)b * SEQ * 192, p.vt8 + (size_t)b * SEQ * 128, i + 1, tq & 63, p.olat + ((size_t)b * SEQ + i * 64 + (wid & 1) * 32) * 512 + head * 128, smem);
    }
  }
}

DI void swa_phase(const Params& p, char* smem) {
  constexpr int KSTR = 144, KBUF = 64 * KSTR, VBUF = 64 * 64 * 2, BUF = KBUF + VBUF, NDB = 2;
  const int tid = threadIdx.x, wid = __builtin_amdgcn_readfirstlane(tid >> 6), lane = tid & 63, r32 = lane & 31, hi = lane >> 5;
  float* wsf = (float*)(smem + 6 * BUF) + wid * 64; float* li_l = wsf; float* al_l = wsf + 32;
  const int srow = tid >> 3, c8 = tid & 7;
  const int vb0 = (int)(uintptr_t)smem + v_rd_base(lane);
  for (int u = blockIdx.x; u < 256; u += gridDim.x) {
    const int kvh = u & 1, i = (u >> 1) & 63, b = u >> 7;
    const int jt0 = (i == 0) ? 0 : (4 * i - 2), NT = 4 * i + 4 - jt0;
    const bf16_t* Kb = p.ks + (size_t)b * SEQ * 128 + kvh * 64; const bf16_t* Vb = p.vs + (size_t)b * SEQ * 128 + kvh * 64;
    {
      bf16x8 kst[6], vst[6];
#pragma unroll
      for (int j = 0; j < 6; ++j) if (j < NT) { const size_t krow = (size_t)((jt0 + j) * 64 + srow) * 128 + 8 * c8; kst[j] = *(const bf16x8*)(Kb + krow); vst[j] = *(const bf16x8*)(Vb + krow); }
#pragma unroll
      for (int j = 0; j < 6; ++j) if (j < NT) { char* bp = smem + j * BUF; *(bf16x8*)(bp + VBUF + srow * KSTR + 16 * c8) = kst[j]; *(bf16x8*)(bp + v_st<NDB>(srow, 8 * c8)) = vst[j]; }
    }
    __syncthreads();
    const int tw0 = i * 256 + wid * 32, tq = tw0 + r32;
    const size_t trow = (size_t)b * SEQ + tq;
#pragma unroll 1
    for (int g = 0; g < 4; ++g) {
      const int h = kvh * 4 + g;
      bf16x8 qr[4];
      const bf16_t* qp = p.qs + trow * 512 + h * 64 + hi * 8;
#pragma unroll
      for (int s = 0; s < 4; ++s) qr[s] = *(const bf16x8*)(qp + s * 16);
      const float slope2 = exp2f(-(float)(h + 1)) * LOG2E, sink2 = p.swa_sinks[h] * LOG2E;
      float m_reg = -1e30f, l_reg = 0.f; f32x16 o[NDB];
#pragma unroll
      for (int d = 0; d < NDB; ++d) o[d] = f32x16{};
      for (int j = 0; j < NT; ++j) {
        const int jt = jt0 + j;
        if (!((jt * 64 + 63 >= tw0 - 127) && (jt * 64 <= tw0 + 31))) continue;
        f32x16 p0 = f32x16{}, p1 = f32x16{};
        const char* Kc = smem + j * BUF + VBUF + r32 * KSTR + hi * 16;
#pragma unroll
        for (int s = 0; s < 4; ++s) {
          const bf16x8 b0 = *(const bf16x8*)(Kc + s * 32), b1 = *(const bf16x8*)(Kc + 32 * KSTR + s * 32);
          p0 = MFMA32(b0, qr[s], p0); p1 = MFMA32(b1, qr[s], p1);
        }
#pragma unroll
        for (int r = 0; r < 16; ++r) {
          const int d0 = tq - (jt * 64 + crow(r, hi)), d1 = d0 - 32;
          p0[r] = (d0 >= 0 && d0 < 128) ? p0[r] - slope2 * (float)d0 : -INFINITY;
          p1[r] = (d1 >= 0 && d1 < 128) ? p1[r] - slope2 * (float)d1 : -INFINITY;
        }
        float pmax = p0[0];
#pragma unroll
        for (int r = 1; r < 16; ++r) pmax = fmaxf(pmax, p0[r]);
#pragma unroll
        for (int r = 0; r < 16; ++r) pmax = fmaxf(pmax, p1[r]);
        { auto rr = __builtin_amdgcn_permlane32_swap(__float_as_uint(pmax), __float_as_uint(pmax), false, false); pmax = fmaxf(__uint_as_float(rr[0]), __uint_as_float(rr[1])); }
        float mn, alpha;
        if (__all(pmax - m_reg <= SM_THR)) { mn = m_reg; alpha = 1.f; }
        else { mn = fmaxf(m_reg, pmax); alpha = __builtin_amdgcn_exp2f(m_reg - mn); m_reg = mn; }
#pragma unroll
        for (int r = 0; r < 16; ++r) { p0[r] = __builtin_amdgcn_exp2f(p0[r] - mn); p1[r] = __builtin_amdgcn_exp2f(p1[r] - mn); }
        float ps = 0.f;
#pragma unroll
        for (int r = 0; r < 16; ++r) ps += p0[r] + p1[r];
        { auto rr = __builtin_amdgcn_permlane32_swap(__float_as_uint(ps), __float_as_uint(ps), false, false); ps = __uint_as_float(rr[0]) + __uint_as_float(rr[1]); }
        l_reg = l_reg * alpha + ps;
        if (__any(alpha < 1.f)) {
          if (hi == 0) al_l[r32] = alpha;
          asm volatile("s_waitcnt lgkmcnt(0)" ::: "memory");
#pragma unroll
          for (int r = 0; r < 16; ++r) { const float al = al_l[crow(r, hi)];
#pragma unroll
            for (int d = 0; d < NDB; ++d) o[d][r] *= al; }
        }
        bf16x8 pa0, pa1, pa2, pa3;
#define PK4(P, BASE, OUT) do { const unsigned a0 = pk2(P[BASE + 0], P[BASE + 1]), a1 = pk2(P[BASE + 2], P[BASE + 3]);   \
        const unsigned b0_ = pk2(P[BASE + 4], P[BASE + 5]), b1_ = pk2(P[BASE + 6], P[BASE + 7]);                          \
        auto r0 = __builtin_amdgcn_permlane32_swap(a0, b0_, false, false); auto r1 = __builtin_amdgcn_permlane32_swap(a1, b1_, false, false); \
        u32x4 w = {r0[0], r1[0], r0[1], r1[1]}; OUT = __builtin_bit_cast(bf16x8, w); } while (0)
        PK4(p0, 0, pa0); PK4(p0, 8, pa1); PK4(p1, 0, pa2); PK4(p1, 8, pa3);
#undef PK4
        const int vb = vb0 + j * BUF;
        pv_one<NDB, 0>(o[0], vb, pa0, pa1, pa2, pa3);
        pv_one<NDB, 1>(o[1], vb, pa0, pa1, pa2, pa3);
      }
      l_reg += __builtin_amdgcn_exp2f(sink2 - m_reg);
      if (hi == 0) li_l[r32] = l_reg;
      asm volatile("s_waitcnt lgkmcnt(0)" ::: "memory");
      bf16_t* Ow = p.ob + ((size_t)b * SEQ + tw0) * 512 + h * 64;
#pragma unroll
      for (int r = 0; r < 16; ++r) {
        const int orow = crow(r, hi); const float rl = __builtin_amdgcn_rcpf(li_l[orow]);
#pragma unroll
        for (int d = 0; d < NDB; ++d) Ow[(size_t)orow * 512 + d * 32 + r32] = f2bf(o[d][r] * rl);
      }
      asm volatile("s_waitcnt lgkmcnt(0)" ::: "memory");
    }
    __syncthreads();
  }
}

DI void xattn_phase(const Params& p, char* smem) {
  const int tid = threadIdx.x, wid = __builtin_amdgcn_readfirstlane(tid >> 6), lane = tid & 63, r32 = lane & 31, hi = lane >> 5;
  for (int u = blockIdx.x; u < 512; u += gridDim.x) {
    const int h = u & 3, i = (u >> 2) & 63, b = u >> 8;
    const int tq = i * 256 + wid * 32 + r32;
    const size_t trow = (size_t)b * SEQ + tq;
    bf16x8 qr[8];
    const bf16_t* qp = p.qx + trow * 512 + h * 128 + hi * 8;
#pragma unroll
    for (int s = 0; s < 8; ++s) qr[s] = *(const bf16x8*)(qp + s * 16);
    AttnArgs<128, 128, 1> a;
    a.Kb = p.kvc + (size_t)b * 256 * 1024 + h * 128; a.ldk = 1024; a.Vb = a.Kb + 512; a.ldv = 1024;
    a.jt0 = 0; a.NT = 4; a.tq = tq; a.diag_tile = -1; a.tw0 = 0; a.slope2 = 0.f; a.sink2 = 0.f;
    a.Ow = p.ox + ((size_t)b * SEQ + i * 256 + wid * 32) * 512 + h * 128; a.ldo = 512;
    attn_unit<128, 128, 1, 0>(qr, a, smem);
  }
}

DI void norm_rows_1024(const float* in, const float* gain, bf16_t* out, int nrows) {
  const int lane = threadIdx.x & 63, gw = (blockIdx.x * NTHREADS + threadIdx.x) >> 6, nw = gridDim.x * (NTHREADS / 64);
  for (int t = gw; t < nrows; t += nw) {
    const float* xr = in + (size_t)t * 1024;
    f32x4 v[4]; float ss = 0.f;
#pragma unroll
    for (int i = 0; i < 4; ++i) { v[i] = *(const f32x4*)(xr + 256 * i + 4 * lane); ss += v[i][0] * v[i][0] + v[i][1] * v[i][1] + v[i][2] * v[i][2] + v[i][3] * v[i][3]; }
    ss = wave_sum(ss);
    const float rstd = rsqrtf(ss * (1.0f / 1024.0f) + EPS);
#pragma unroll
    for (int i = 0; i < 4; ++i) {
      const f32x4 g = *(const f32x4*)(gain + 256 * i + 4 * lane);
      u32x2 w = {pk2(v[i][0] * rstd * g[0], v[i][1] * rstd * g[1]), pk2(v[i][2] * rstd * g[2], v[i][3] * rstd * g[3])};
      *(u32x2*)(out + (size_t)t * 1024 + 256 * i + 4 * lane) = w;
    }
  }
}

DI void norm_rows_bf16(const bf16_t* in, const float* gain, bf16_t* out, int nrows) {
  const int lane = threadIdx.x & 63, gw = (blockIdx.x * NTHREADS + threadIdx.x) >> 6, nw = gridDim.x * (NTHREADS / 64);
  for (int t = gw; t < nrows; t += nw) {
    const bf16_t* xr = in + (size_t)t * 1024 + 8 * lane;
    float v[16]; float ss = 0.f;
#pragma unroll
    for (int i = 0; i < 2; ++i) { const u32x4 w = *(const u32x4*)(xr + 512 * i);
#pragma unroll
      for (int j = 0; j < 4; ++j) { v[8 * i + 2 * j] = bflo(w[j]); v[8 * i + 2 * j + 1] = bfhi(w[j]); } }
#pragma unroll
    for (int j = 0; j < 16; ++j) ss += v[j] * v[j];
    ss = wave_sum(ss);
    const float rstd = rsqrtf(ss * (1.0f / 1024.0f) + EPS);
#pragma unroll
    for (int i = 0; i < 2; ++i) {
      const f32x4 g0 = *(const f32x4*)(gain + 512 * i + 8 * lane), g1 = *(const f32x4*)(gain + 512 * i + 8 * lane + 4);
      *(u32x4*)(out + (size_t)t * 1024 + 512 * i + 8 * lane) = u32x4{pk2(v[8 * i] * rstd * g0[0], v[8 * i + 1] * rstd * g0[1]), pk2(v[8 * i + 2] * rstd * g0[2], v[8 * i + 3] * rstd * g0[3]),
                                                                    pk2(v[8 * i + 4] * rstd * g1[0], v[8 * i + 5] * rstd * g1[1]), pk2(v[8 * i + 6] * rstd * g1[2], v[8 * i + 7] * rstd * g1[3])};
    }
  }
}

DI void latent_pass(const Params& p, char* smem) {
  const int tid = threadIdx.x, lane = tid & 63, wid = __builtin_amdgcn_readfirstlane(tid >> 6);
  unsigned char* st = (unsigned char*)smem;
  for (int tile = blockIdx.x; tile < T / 64; tile += gridDim.x) {
#pragma unroll 2
    for (int i = 0; i < 8; ++i) {
      const int tk = wid * 8 + i, t = tile * 64 + tk;
      const bf16_t* lr = p.lat + (size_t)t * 448;
      const u32x2 cq = *(const u32x2*)(lr + 4 * lane);
      const float q0 = bflo(cq[0]), q1 = bfhi(cq[0]), q2 = bflo(cq[1]), q3 = bfhi(cq[1]);
      const float ssq = wave_sum(q0 * q0 + q1 * q1 + q2 * q2 + q3 * q3);
      const float rq = rsqrtf(ssq * (1.0f / 256.0f) + EPS);
      const f32x4 gq = *(const f32x4*)(p.q_a_norm + 4 * lane);
      *(u32x2*)(p.cqn + (size_t)t * 256 + 4 * lane) = u32x2{pk2(q0 * rq * gq[0], q1 * rq * gq[1]), pk2(q2 * rq * gq[2], q3 * rq * gq[3])};
      const unsigned ck = *(const unsigned*)(lr + 256 + 2 * lane);
      const float k0 = bflo(ck), k1 = bfhi(ck);
      const float ssk = wave_sum(k0 * k0 + k1 * k1);
      const float rk = rsqrtf(ssk * (1.0f / 128.0f) + EPS);
      const f32x2 gk = *(const f32x2*)(p.kv_a_norm + 2 * lane);
      const float kn0 = k0 * rk * gk[0], kn1 = k1 * rk * gk[1];
      unsigned char* k8r = p.k8 + (size_t)t * 192;
      *(unsigned short*)(k8r + 2 * lane) = (unsigned short)__builtin_amdgcn_cvt_pk_fp8_f32(kn0 * 0.125f, kn1 * 0.125f, 0, false);
      *(unsigned short*)(st + tk * 128 + 2 * lane) = (unsigned short)__builtin_amdgcn_cvt_pk_fp8_f32(kn0, kn1, 0, false);
      if (lane < 32) {
        const float x1 = bf2f(lr[384 + lane]), x2 = bf2f(lr[416 + lane]);
        const f32x2 cs = *(const f32x2*)(p.rope + (size_t)t * 64 + 2 * lane);
        const float r1 = x1 * cs[0] - x2 * cs[1], r2 = x2 * cs[0] + x1 * cs[1];
        const int pk = __builtin_amdgcn_cvt_pk_fp8_f32(r1 * 0.125f, r2 * 0.125f, 0, false);
        k8r[128 + lane] = (unsigned char)(pk & 0xff); k8r[160 + lane] = (unsigned char)((pk >> 8) & 0xff);
      }
    }
    __syncthreads();
    {
      const int d = tid >> 2, part = tid & 3, k0 = 32 * (part >> 1) + 4 * (part & 1);
      unsigned w[4];
#pragma unroll
      for (int c = 0; c < 4; ++c) {
        unsigned v = 0;
#pragma unroll
        for (int e = 0; e < 4; ++e) v |= (unsigned)st[(k0 + e + 8 * c) * 128 + d] << (8 * e);
        w[c] = v;
      }
      const int t0 = tile * 64, b = t0 / SEQ, s0 = t0 - b * SEQ;
      *(u32x4*)(p.vt8 + ((size_t)b * 128 + d) * SEQ + s0 + 16 * part) = u32x4{w[0], w[1], w[2], w[3]};
    }
    __syncthreads();
  }
}

DI void mix_pass(const Params& p) {
  const int lane = threadIdx.x & 63, gw = (blockIdx.x * NTHREADS + threadIdx.x) >> 6, nw = gridDim.x * (NTHREADS / 64);
  for (int t = gw; t < T; t += nw) {
#pragma unroll
    for (int part = 0; part < 2; ++part) {
      const bf16_t* src = (part ? p.ob : p.oa) + (size_t)t * 512 + 8 * lane;
      const float* g = (part ? p.out_norm_swa : p.out_norm_mla) + 8 * lane;
      const u32x4 w = *(const u32x4*)src;
      float v[8] = {bflo(w[0]), bfhi(w[0]), bflo(w[1]), bfhi(w[1]), bflo(w[2]), bfhi(w[2]), bflo(w[3]), bfhi(w[3])};
      float ss = 0.f;
#pragma unroll
      for (int j = 0; j < 8; ++j) ss += v[j] * v[j];
      ss = wave_sum(ss);
      const float rs = rsqrtf(ss * (1.0f / 512.0f) + EPS);
      const f32x4 g0 = *(const f32x4*)g, g1 = *(const f32x4*)(g + 4);
      u32x4 o = {pk2(v[0] * rs * g0[0], v[1] * rs * g0[1]), pk2(v[2] * rs * g0[2], v[3] * rs * g0[3]), pk2(v[4] * rs * g1[0], v[5] * rs * g1[1]), pk2(v[6] * rs * g1[2], v[7] * rs * g1[3])};
      *(u32x4*)(p.xn + (size_t)t * 1024 + part * 512 + 8 * lane) = o;
    }
  }
}

DI float gelu_exact(float x) { return 0.5f * x * (1.0f + erff(x * 0.70710678118654752f)); }
DI float wave_max(float v) {
#pragma unroll
  for (int o = 32; o >= 1; o >>= 1) v = fmaxf(v, __shfl_xor(v, o));
  return v;
}
DI void peer_pass(const Params& p, float* outbuf, int rowmask) {
  const int lane = threadIdx.x & 63, gw = (blockIdx.x * NTHREADS + threadIdx.x) >> 6, nw = gridDim.x * (NTHREADS / 64);
  const int b5 = (lane >> 5) & 1, b4 = (lane >> 4) & 1, b3 = (lane >> 3) & 1, b2 = (lane >> 2) & 1, kL = (lane >> 2) & 15;
  for (int t = gw; t < T; t += nw) {
    const bf16_t* hr = p.xn + (size_t)t * 1024 + 16 * lane;
    const u32x4 ha = *(const u32x4*)hr, hb = *(const u32x4*)(hr + 8);
    float hv[16];
#pragma unroll
    for (int j = 0; j < 4; ++j) { const unsigned wa = ha[j], wb = hb[j]; hv[2 * j] = bflo(wa); hv[2 * j + 1] = bfhi(wa); hv[8 + 2 * j] = bflo(wb); hv[8 + 2 * j + 1] = bfhi(wb); }
    float hm = 0.f;
#pragma unroll
    for (int j = 0; j < 16; ++j) hm = fmaxf(hm, fabsf(hv[j]));
    hm = fmaxf(wave_max(hm), 1e-20f);
    const float sh = hm * (1.0f / 127.0f), ih = 127.0f / hm;
    int hq[4];
#pragma unroll
    for (int q = 0; q < 4; ++q) {
      const int q0 = (int)rintf(hv[4 * q] * ih), q1 = (int)rintf(hv[4 * q + 1] * ih), q2 = (int)rintf(hv[4 * q + 2] * ih), q3 = (int)rintf(hv[4 * q + 3] * ih);
      hq[q] = (q0 & 255) | ((q1 & 255) << 8) | ((q2 & 255) << 16) | (q3 << 24);
    }
    const int e0 = p.pidx[(size_t)t * 128 + lane], e1 = p.pidx[(size_t)t * 128 + 64 + lane];
    const float su0 = p.su[2 * e0] * sh, su1 = p.su[2 * e1] * sh;
    const float gv0 = p.pg[(size_t)t * 128 + lane] * p.su[2 * e0 + 1], gv1 = p.pg[(size_t)t * 128 + 64 + lane] * p.su[2 * e1 + 1];
    float acc[16];
#pragma unroll
    for (int j = 0; j < 16; ++j) acc[j] = 0.f;
    float csum = 0.f;
#pragma unroll 1
    for (int hd = 0; hd < 8; ++hd) {
      const int esel = (hd < 4) ? e0 : e1;
      const int lbase = (hd & 3) * 16;
      u32x4 ub[16], vb[16];
#pragma unroll
      for (int k = 0; k < 16; ++k) {
        const int idx = __builtin_amdgcn_readlane(esel, lbase + k);
        ub[k] = *(const u32x4*)(p.u_q + (size_t)idx * 1024 + 16 * lane);
        vb[k] = *(const u32x4*)(p.v_q + (size_t)idx * 1024 + 16 * lane);
      }
      int pd[16];
#pragma unroll
      for (int k = 0; k < 16; ++k) {
        int d = 0;
#pragma unroll
        for (int q = 0; q < 4; ++q) { const int a = (int)ub[k][q]; d = __builtin_amdgcn_sdot4(a, hq[q], d, false); }
        pd[k] = d;
      }
      int q8[8], q4[4], q2[2], q1;
#pragma unroll
      for (int k = 0; k < 8; ++k) { const int keep = b5 ? pd[k + 8] : pd[k], send = b5 ? pd[k] : pd[k + 8]; q8[k] = keep + __shfl_xor(send, 32); }
#pragma unroll
      for (int k = 0; k < 4; ++k) { const int keep = b4 ? q8[k + 4] : q8[k], send = b4 ? q8[k] : q8[k + 4]; q4[k] = keep + __shfl_xor(send, 16); }
#pragma unroll
      for (int k = 0; k < 2; ++k) { const int keep = b3 ? q4[k + 2] : q4[k], send = b3 ? q4[k] : q4[k + 2]; q2[k] = keep + __shfl_xor(send, 8); }
      { const int keep = b2 ? q2[1] : q2[0], send = b2 ? q2[0] : q2[1]; q1 = keep + __shfl_xor(send, 4); }
      q1 += __shfl_xor(q1, 2); q1 += __shfl_xor(q1, 1);
      const float suk = __shfl((hd < 4) ? su0 : su1, lbase + kL), gvk = __shfl((hd < 4) ? gv0 : gv1, lbase + kL);
      const float dtot = (float)q1 * suk;
      const float c = DBG_PEER * gvk * gelu_exact(dtot);
#pragma unroll
      for (int k = 0; k < 16; ++k) {
        const float ck = __uint_as_float(__builtin_amdgcn_readlane(__float_as_uint(c), 4 * k));
        csum += ck;
#pragma unroll
        for (int q = 0; q < 4; ++q) {
          const unsigned w = vb[k][q];
          acc[4 * q] += ck * (float)(w & 0xff); acc[4 * q + 1] += ck * (float)((w >> 8) & 0xff); acc[4 * q + 2] += ck * (float)((w >> 16) & 0xff); acc[4 * q + 3] += ck * (float)(w >> 24);
        }
      }
    }
    const float* xr = p.X + (size_t)t * 1024 + 16 * lane; float* orow = outbuf + (size_t)(t & rowmask) * 1024 + 16 * lane;
    float y[16]; float ss = 0.f;
#pragma unroll
    for (int q = 0; q < 4; ++q) {
      const f32x4 xv = *(const f32x4*)(xr + 4 * q);
#pragma unroll
      for (int j = 0; j < 4; ++j) { const float v = xv[j] + (acc[4 * q + j] - 128.0f * csum); y[4 * q + j] = v; ss += v * v; }
    }
    ss = wave_sum(ss);
    const float rstd = rsqrtf(ss * (1.0f / 1024.0f) + EPS);
#pragma unroll
    for (int q = 0; q < 4; ++q) {
      const f32x4 g = *(const f32x4*)(p.norm_final + 16 * lane + 4 * q);
      f32x4 ov;
#pragma unroll
      for (int j = 0; j < 4; ++j) ov[j] = y[4 * q + j] * rstd * g[j];
      *(f32x4*)(orow + 4 * q) = ov;
    }
  }
}

DI void norm_rows_ffn(const Params& p) {
  const int lane = threadIdx.x & 63, gw = (blockIdx.x * NTHREADS + threadIdx.x) >> 6, nw = gridDim.x * (NTHREADS / 64);
  for (int t = gw; t < T; t += nw) {
    const bf16_t* xr = p.X16 + (size_t)t * 1024;
    f32x4 v[4]; float ss = 0.f;
#pragma unroll
    for (int i = 0; i < 4; ++i) { const u32x2 w = *(const u32x2*)(xr + 256 * i + 4 * lane); v[i] = f32x4{bflo(w[0]), bfhi(w[0]), bflo(w[1]), bfhi(w[1])};
      ss += v[i][0] * v[i][0] + v[i][1] * v[i][1] + v[i][2] * v[i][2] + v[i][3] * v[i][3]; }
    ss = wave_sum(ss);
    const float rstd = rsqrtf(ss * (1.0f / 1024.0f) + EPS);
    float hm = 0.f;
#pragma unroll
    for (int i = 0; i < 4; ++i) {
      const f32x4 g = *(const f32x4*)(p.norm_ffn + 256 * i + 4 * lane);
#pragma unroll
      for (int j = 0; j < 4; ++j) { v[i][j] = v[i][j] * rstd * g[j]; hm = fmaxf(hm, fabsf(v[i][j])); }
      *(u32x2*)(p.xn + (size_t)t * 1024 + 256 * i + 4 * lane) = u32x2{pk2(v[i][0], v[i][1]), pk2(v[i][2], v[i][3])};
    }
    hm = fmaxf(wave_max(hm), 1e-20f);
    const float ih = 127.0f / hm;
#pragma unroll
    for (int i = 0; i < 4; ++i) {
      const int q0 = (int)rintf(v[i][0] * ih), q1 = (int)rintf(v[i][1] * ih), q2 = (int)rintf(v[i][2] * ih), q3 = (int)rintf(v[i][3] * ih);
      *(unsigned*)(p.hq + (size_t)t * 1024 + 256 * i + 4 * lane) = (unsigned)(q0 & 255) | ((unsigned)(q1 & 255) << 8) | ((unsigned)(q2 & 255) << 16) | ((unsigned)q3 << 24);
    }
    if (lane == 0) p.sh[t] = hm * (1.0f / 127.0f);
  }
}
DI void peer_dots(const Params& p) {
  const int lane = threadIdx.x & 63, wid = threadIdx.x >> 6, xs = (blockIdx.x & 7) >> 1, r = lane >> 3, ch = lane & 7;
  const int wp = ((blockIdx.x >> 3) * 2 + (blockIdx.x & 1)) * (NTHREADS / 64) + wid, nwp = (gridDim.x >> 2) * (NTHREADS / 64);
  const int b0 = lane & 1, b1 = (lane >> 1) & 1, b2 = (lane >> 2) & 1;
  int* dp = p.dpartA + (size_t)xs * T * 128;
  const unsigned char* ub = p.u_q + 128 * xs + 16 * ch;
  typedef int i32x2 __attribute__((ext_vector_type(2)));
  i32x4 iv[4]; u32x4 hlo, hhi;
  if (wp < T) {
    const int* ip = p.pidx + (size_t)wp * 128 + 16 * r;
#pragma unroll
    for (int q = 0; q < 4; ++q) iv[q] = *(const i32x4*)(ip + 4 * q);
    const unsigned char* hp = p.hq + (size_t)wp * 1024 + 256 * xs + 32 * ch;
    hlo = *(const u32x4*)hp; hhi = *(const u32x4*)(hp + 16);
  }
  for (int t = wp; t < T; t += nwp) {
    u32x4 uv[16];
#pragma unroll
    for (int g = 0; g < 16; ++g) uv[g] = *(const u32x4*)(ub + (size_t)iv[g >> 2][g & 3] * 512);
    int hl[4], hh[4];
#pragma unroll
    for (int q = 0; q < 4; ++q) { hl[q] = (int)hlo[q]; hh[q] = (int)hhi[q]; }
    int hsum = 0;
#pragma unroll
    for (int q = 0; q < 4; ++q) { hsum = __builtin_amdgcn_sdot4(hl[q], 0x01010101, hsum, false); hsum = __builtin_amdgcn_sdot4(hh[q], 0x01010101, hsum, false); }
    const int tn = (t + nwp < T) ? t + nwp : t;
    {
      const int* ip = p.pidx + (size_t)tn * 128 + 16 * r;
#pragma unroll
      for (int q = 0; q < 4; ++q) iv[q] = *(const i32x4*)(ip + 4 * q);
      const unsigned char* hp = p.hq + (size_t)tn * 1024 + 256 * xs + 32 * ch;
      hlo = *(const u32x4*)hp; hhi = *(const u32x4*)(hp + 16);
    }
    int v[16];
#pragma unroll
    for (int g = 0; g < 16; ++g) {
      int d = -8 * hsum;
#pragma unroll
      for (int q = 0; q < 4; ++q) {
        const unsigned w = uv[g][q]; const int lo = (int)(w & 0x0F0F0F0Fu), hi = (int)((w >> 4) & 0x0F0F0F0Fu);
        d = __builtin_amdgcn_sdot4(lo, hl[q], d, false); d = __builtin_amdgcn_sdot4(hi, hh[q], d, false);
      }
      v[g] = d;
    }
    int w8[8], w4[4], w2[2];
#pragma unroll
    for (int k = 0; k < 8; ++k) { const int keep = b2 ? v[k + 8] : v[k], send = b2 ? v[k] : v[k + 8]; w8[k] = keep + __shfl_xor(send, 4); }
#pragma unroll
    for (int k = 0; k < 4; ++k) { const int keep = b1 ? w8[k + 4] : w8[k], send = b1 ? w8[k] : w8[k + 4]; w4[k] = keep + __shfl_xor(send, 2); }
#pragma unroll
    for (int k = 0; k < 2; ++k) { const int keep = b0 ? w4[k + 2] : w4[k], send = b0 ? w4[k] : w4[k + 2]; w2[k] = keep + __shfl_xor(send, 1); }
    *(i32x2*)(dp + (size_t)t * 128 + 16 * r + 2 * ch) = i32x2{w2[0], w2[1]};
  }
}
DI void peer_coef(const Params& p) {
  const size_t n = (size_t)T * 128;
  for (size_t it = (size_t)blockIdx.x * NTHREADS + threadIdx.x; it < n; it += (size_t)gridDim.x * NTHREADS) {
    int d = 0;
#pragma unroll
    for (int x = 0; x < 4; ++x) d += p.dpartA[(size_t)x * n + it];
    const int e = p.pidx[it];
    const f32x2 sc2 = *(const f32x2*)(p.su + 2 * (size_t)e);
    const float dt = (float)d * sc2[0] * p.sh[it >> 7];
    p.cbuf[it] = DBG_PEER * p.pg[it] * gelu_exact(dt) * sc2[1];
  }
}
DI void peer_accum(const Params& p, bf16_t* Xout, int rowmask) {
  const int lane = threadIdx.x & 63, wid = threadIdx.x >> 6, xs = (blockIdx.x & 7) >> 1, r = lane >> 3, ch = lane & 7;
  const int wp = ((blockIdx.x >> 3) * 2 + (blockIdx.x & 1)) * (NTHREADS / 64) + wid, nwp = (gridDim.x >> 2) * (NTHREADS / 64);
  const int b3 = (lane >> 3) & 1, b4 = (lane >> 4) & 1, b5 = (lane >> 5) & 1;
  const unsigned char* vbp = p.v_q + 128 * xs + 16 * ch;
  const size_t xoff = (size_t)256 * xs + 32 * ch + 4 * r;
  if (wp >= T) return;
  i32x4 ivA[2], ivB[2]; f32x4 cvA[4], cvN[4]; i32x4 ivN[4];
  u32x4 ra[8], rb[8];
  u32x2 xv, xvN;
#define LOAD_META(tt, IV, CV) do { const int* ip_ = p.pidx + (size_t)(tt) * 128 + 16 * r; const float* cp_ = p.cbuf + (size_t)(tt) * 128 + 16 * r; \
    _Pragma("unroll") for (int q_ = 0; q_ < 4; ++q_) { IV[q_] = *(const i32x4*)(ip_ + 4 * q_); CV[q_] = *(const f32x4*)(cp_ + 4 * q_); } } while (0)
#define LOAD_ROWS(R, I0, I1) do { _Pragma("unroll") for (int g_ = 0; g_ < 4; ++g_) { R[g_] = *(const u32x4*)(vbp + (size_t)I0[g_] * 512); R[4 + g_] = *(const u32x4*)(vbp + (size_t)I1[g_] * 512); } } while (0)
#define ACCUM(R, C0, C1) do { _Pragma("unroll") for (int g_ = 0; g_ < 8; ++g_) { const float cg_ = (g_ < 4) ? C0[g_ & 3] : C1[g_ & 3]; const f32x2 cgv_ = {cg_, cg_}; \
    _Pragma("unroll") for (int q_ = 0; q_ < 4; ++q_) { const unsigned w_ = R[g_][q_]; \
      acc2[4 * q_] += cgv_ * __builtin_amdgcn_cvt_scalef32_pk_f32_fp4(w_, 1.0f, 0); acc2[4 * q_ + 1] += cgv_ * __builtin_amdgcn_cvt_scalef32_pk_f32_fp4(w_, 1.0f, 1); \
      acc2[4 * q_ + 2] += cgv_ * __builtin_amdgcn_cvt_scalef32_pk_f32_fp4(w_, 1.0f, 2); acc2[4 * q_ + 3] += cgv_ * __builtin_amdgcn_cvt_scalef32_pk_f32_fp4(w_, 1.0f, 3); } \
    SBAR(); } } while (0)
  LOAD_META(wp, ivN, cvN);
  ivA[0] = ivN[0]; ivA[1] = ivN[1]; ivB[0] = ivN[2]; ivB[1] = ivN[3];
#pragma unroll
  for (int q = 0; q < 4; ++q) cvA[q] = cvN[q];
  LOAD_ROWS(ra, ivA[0], ivA[1]);
  xv = *(const u32x2*)(p.X16 + (size_t)wp * 1024 + xoff);
  for (int t = wp; t < T; t += nwp) {
    const int tn = (t + nwp < T) ? t + nwp : t;
    f32x2 acc2[16];
#pragma unroll
    for (int j = 0; j < 16; ++j) acc2[j] = f32x2{0.f, 0.f};
    LOAD_ROWS(rb, ivB[0], ivB[1]);
    LOAD_META(tn, ivN, cvN);
    xvN = *(const u32x2*)(p.X16 + (size_t)tn * 1024 + xoff);
    ACCUM(ra, cvA[0], cvA[1]);
    ivA[0] = ivN[0]; ivA[1] = ivN[1]; ivB[0] = ivN[2]; ivB[1] = ivN[3];
    LOAD_ROWS(ra, ivA[0], ivA[1]);
    ACCUM(rb, cvA[2], cvA[3]);
#pragma unroll
    for (int q = 0; q < 4; ++q) cvA[q] = cvN[q];
    float acc[32];
#pragma unroll
    for (int j = 0; j < 16; ++j) { acc[2 * j] = acc2[j][0]; acc[2 * j + 1] = acc2[j][1]; }
    float w16[16], w8[8], w4[4];
#pragma unroll
    for (int k = 0; k < 16; ++k) { const float keep = b5 ? acc[k + 16] : acc[k], send = b5 ? acc[k] : acc[k + 16]; w16[k] = keep + __shfl_xor(send, 32); }
#pragma unroll
    for (int k = 0; k < 8; ++k) { const float keep = b4 ? w16[k + 8] : w16[k], send = b4 ? w16[k] : w16[k + 8]; w8[k] = keep + __shfl_xor(send, 16); }
#pragma unroll
    for (int k = 0; k < 4; ++k) { const float keep = b3 ? w8[k + 4] : w8[k], send = b3 ? w8[k] : w8[k + 4]; w4[k] = keep + __shfl_xor(send, 8); }
    *(u32x2*)(Xout + (size_t)(t & rowmask) * 1024 + xoff) = u32x2{pk2(bflo(xv[0]) + w4[0], bfhi(xv[0]) + w4[1]), pk2(bflo(xv[1]) + w4[2], bfhi(xv[1]) + w4[3])};
    xv = xvN;
  }
#undef LOAD_META
#undef LOAD_ROWS
#undef ACCUM
}
DI void final_norm(const Params& p) {
  const int lane = threadIdx.x & 63, gw = (blockIdx.x * NTHREADS + threadIdx.x) >> 6, nw = gridDim.x * (NTHREADS / 64);
  for (int t = gw; t < T; t += nw) {
    const bf16_t* xr = p.X16 + (size_t)t * 1024;
    f32x4 v[4]; float ss = 0.f;
#pragma unroll
    for (int i = 0; i < 4; ++i) { const u32x2 w = *(const u32x2*)(xr + 256 * i + 4 * lane); v[i] = f32x4{bflo(w[0]), bfhi(w[0]), bflo(w[1]), bfhi(w[1])};
      ss += v[i][0] * v[i][0] + v[i][1] * v[i][1] + v[i][2] * v[i][2] + v[i][3] * v[i][3]; }
    ss = wave_sum(ss);
    const float rstd = rsqrtf(ss * (1.0f / 1024.0f) + EPS);
    float* orow = p.X + (size_t)t * 1024;
#pragma unroll
    for (int i = 0; i < 4; ++i) {
      const f32x4 g = *(const f32x4*)(p.norm_final + 256 * i + 4 * lane);
      *(f32x4*)(orow + 256 * i + 4 * lane) = f32x4{v[i][0] * rstd * g[0], v[i][1] * rstd * g[1], v[i][2] * rstd * g[2], v[i][3] * rstd * g[3]};
    }
  }
}

DI void quant_fp8(const float* src, unsigned char* dst, size_t n4) {
  for (size_t i = (size_t)blockIdx.x * NTHREADS + threadIdx.x; i < n4; i += (size_t)gridDim.x * NTHREADS) {
    const f32x4 v = *(const f32x4*)(src + i * 4);
    int pk = 0;
    pk = __builtin_amdgcn_cvt_pk_fp8_f32(v[0] * V_FP8_SCALE, v[1] * V_FP8_SCALE, pk, false);
    pk = __builtin_amdgcn_cvt_pk_fp8_f32(v[2] * V_FP8_SCALE, v[3] * V_FP8_SCALE, pk, true);
    *(unsigned*)(dst + i * 4) = (unsigned)pk;
  }
}
DI void quant_u4(const float* src, unsigned char* dst, float* scale, int nrows) {
  const int lane = threadIdx.x & 63, gw = (blockIdx.x * NTHREADS + threadIdx.x) >> 6, nw = gridDim.x * (NTHREADS / 64);
  const int c = lane >> 1, hf = lane & 1;
  for (int r = gw; r < nrows; r += nw) {
    const float* xr = src + (size_t)r * 1024 + 32 * c + 8 * hf;
    const f32x4 a0 = *(const f32x4*)xr, a1 = *(const f32x4*)(xr + 4), b0 = *(const f32x4*)(xr + 16), b1 = *(const f32x4*)(xr + 20);
    float ss = 0.f;
#pragma unroll
    for (int j = 0; j < 4; ++j) ss += a0[j] * a0[j] + a1[j] * a1[j] + b0[j] * b0[j] + b1[j] * b1[j];
    ss = wave_sum(ss);
    const float sc = fmaxf(2.45f * sqrtf(ss * (1.0f / 1024.0f)) * (1.0f / 7.0f), 1e-30f), inv = 1.0f / sc;
    unsigned w[2];
#pragma unroll
    for (int q = 0; q < 2; ++q) {
      const f32x4 lo = q ? a1 : a0, hi = q ? b1 : b0;
      unsigned ww = 0;
#pragma unroll
      for (int j = 0; j < 4; ++j) {
        const int ql = (int)fminf(fmaxf(rintf(lo[j] * inv), -7.f), 7.f) + 8, qh = (int)fminf(fmaxf(rintf(hi[j] * inv), -7.f), 7.f) + 8;
        ww |= (unsigned)(ql | (qh << 4)) << (8 * j);
      }
      w[q] = ww;
    }
    *(u32x2*)(dst + (size_t)r * 512 + 16 * c + 8 * hf) = u32x2{w[0], w[1]};
    if (lane == 0) scale[2 * r] = sc;
  }
}
DI void quant_v4(const float* src, unsigned char* dst, float* scale, int nrows) {
  const int lane = threadIdx.x & 63, gw = (blockIdx.x * NTHREADS + threadIdx.x) >> 6, nw = gridDim.x * (NTHREADS / 64);
  for (int r = gw; r < nrows; r += nw) {
    const float* xr = src + (size_t)r * 1024 + 16 * lane;
    f32x4 a[4]; float ss = 0.f;
#pragma unroll
    for (int q = 0; q < 4; ++q) { a[q] = *(const f32x4*)(xr + 4 * q); ss += a[q][0] * a[q][0] + a[q][1] * a[q][1] + a[q][2] * a[q][2] + a[q][3] * a[q][3]; }
    ss = wave_sum(ss);
    const float sc = fmaxf(sqrtf(ss * (1.0f / 1024.0f)) * (1.0f / 2.1f), 1e-30f), inv = 1.0f / sc;
    unsigned w0 = 0, w1 = 0;
    w0 = __builtin_amdgcn_cvt_scalef32_pk_fp4_f32(w0, a[0][0] * inv, a[0][1] * inv, 1.0f, 0);
    w0 = __builtin_amdgcn_cvt_scalef32_pk_fp4_f32(w0, a[0][2] * inv, a[0][3] * inv, 1.0f, 1);
    w0 = __builtin_amdgcn_cvt_scalef32_pk_fp4_f32(w0, a[1][0] * inv, a[1][1] * inv, 1.0f, 2);
    w0 = __builtin_amdgcn_cvt_scalef32_pk_fp4_f32(w0, a[1][2] * inv, a[1][3] * inv, 1.0f, 3);
    w1 = __builtin_amdgcn_cvt_scalef32_pk_fp4_f32(w1, a[2][0] * inv, a[2][1] * inv, 1.0f, 0);
    w1 = __builtin_amdgcn_cvt_scalef32_pk_fp4_f32(w1, a[2][2] * inv, a[2][3] * inv, 1.0f, 1);
    w1 = __builtin_amdgcn_cvt_scalef32_pk_fp4_f32(w1, a[3][0] * inv, a[3][1] * inv, 1.0f, 2);
    w1 = __builtin_amdgcn_cvt_scalef32_pk_fp4_f32(w1, a[3][2] * inv, a[3][3] * inv, 1.0f, 3);
    *(u32x2*)(dst + (size_t)r * 512 + 8 * lane) = u32x2{w0, w1};
    if (lane == 0) scale[2 * r] = sc;
  }
}
template <bool OFFS>
DI void quant_rows(const float* src, unsigned char* dst, float* scale, int nrows) {
  const int lane = threadIdx.x & 63, gw = (blockIdx.x * NTHREADS + threadIdx.x) >> 6, nw = gridDim.x * (NTHREADS / 64);
  for (int r = gw; r < nrows; r += nw) {
    const float* xr = src + (size_t)r * 1024 + 4 * lane;
    f32x4 v[4]; float m = 0.f;
#pragma unroll
    for (int q = 0; q < 4; ++q) { v[q] = *(const f32x4*)(xr + 256 * q); m = fmaxf(m, fmaxf(fmaxf(fabsf(v[q][0]), fabsf(v[q][1])), fmaxf(fabsf(v[q][2]), fabsf(v[q][3])))); }
    m = fmaxf(wave_max(m), 1e-30f);
    const float inv = 127.0f / m;
#pragma unroll
    for (int q = 0; q < 4; ++q) {
      int a0 = (int)rintf(v[q][0] * inv), a1 = (int)rintf(v[q][1] * inv), a2 = (int)rintf(v[q][2] * inv), a3 = (int)rintf(v[q][3] * inv);
      if (OFFS) { a0 += 128; a1 += 128; a2 += 128; a3 += 128; }
      *(unsigned*)(dst + (size_t)r * 1024 + 4 * lane + 256 * q) = (unsigned)(a0 & 255) | ((unsigned)(a1 & 255) << 8) | ((unsigned)(a2 & 255) << 16) | ((unsigned)a3 << 24);
    }
    if (lane == 0) scale[r] = m * (1.0f / 127.0f);
  }
}

DI void transpose_cvt(const float* W, int ldw, int K, int N, bf16_t* Wt, int ldt, char* smem, int& job, int jobstride) {
  float* tile = (float*)smem;
  const int tk = K / 64, tn = N / 64, total = tk * tn;
  const int tid = threadIdx.x;
  for (; job < total; job += jobstride) {
    const int k0 = (job / tn) * 64, n0 = (job % tn) * 64;
    __syncthreads();
#pragma unroll
    for (int i = 0; i < 8; ++i) { const int e = tid + i * NTHREADS, kk = e >> 6, nn = e & 63; tile[kk * 65 + nn] = W[(size_t)(k0 + kk) * ldw + n0 + nn]; }
    __syncthreads();
#pragma unroll
    for (int i = 0; i < 8; ++i) { const int e = tid + i * NTHREADS, nn = e >> 6, kk = e & 63; Wt[(size_t)(n0 + nn) * ldt + k0 + kk] = f2bf(tile[kk * 65 + nn]); }
  }
  job -= total;
}
DI void cvt_elems(const float* src, bf16_t* dst, size_t n8) {
  for (size_t i = (size_t)blockIdx.x * NTHREADS + threadIdx.x; i < n8; i += (size_t)gridDim.x * NTHREADS) {
    const f32x4 a = *(const f32x4*)(src + i * 8), b = *(const f32x4*)(src + i * 8 + 4);
    *(u32x4*)(dst + i * 8) = u32x4{pk2(a[0], a[1]), pk2(a[2], a[3]), pk2(b[0], b[1]), pk2(b[2], b[3])};
  }
}
DI void prep_phase(const Params& p, char* smem) {
  int job = blockIdx.x; const int js = gridDim.x;
  transpose_cvt(p.w_in, IN_COLS, 1024, IN_COLS, p.wt_in, 1024, smem, job, js);
  transpose_cvt(p.w_out, 1024, 1024, 1024, p.wt_out, 1024, smem, job, js);
  transpose_cvt(p.w_cq, 512, 1024, 512, p.wt_cq, 1024, smem, job, js);
  transpose_cvt(p.w_ck, 512, 1024, 512, p.wt_ckv, 1024, smem, job, js);
  transpose_cvt(p.w_cv, 512, 1024, 512, p.wt_ckv + (size_t)512 * 1024, 1024, smem, job, js);
  transpose_cvt(p.w_co, 1024, 512, 1024, p.wt_co, 512, smem, job, js);
  for (int h = 0; h < 4; ++h) transpose_cvt(p.w_kv_b + h * 256 + 128, 1024, 128, 128, p.wt_uv + (size_t)h * 128 * 128, 128, smem, job, js);
  __syncthreads();
  const size_t gtid = (size_t)blockIdx.x * NTHREADS + threadIdx.x, gn = (size_t)gridDim.x * NTHREADS;
  for (size_t i = gtid; i < (size_t)64 * 1024 / 8; i += gn) *(u32x4*)(p.wt_in + (size_t)IN_COLS * 1024 + i * 8) = u32x4{0, 0, 0, 0};
  for (size_t i = gtid; i < (size_t)768 * 256; i += gn) {
    const int n = (int)(i >> 8), k = (int)(i & 255), h = n / 192, j = n - h * 192;
    float v;
    if (j < 128) {
      const float* a = p.w_q_b + (size_t)k * 768 + h * 192; const float* b = p.w_kv_b + (size_t)j * 1024 + h * 256;
      float s = 0.f;
      for (int d = 0; d < 128; d += 4) { const f32x4 av = *(const f32x4*)(a + d), bv = *(const f32x4*)(b + d); s += av[0] * bv[0] + av[1] * bv[1] + av[2] * bv[2] + av[3] * bv[3]; }
      v = s;
    } else v = p.w_q_b[(size_t)k * 768 + n];
    p.wt_qc[i] = f2bf(v);
  }
  cvt_elems(p.peer_w_q, p.a_pq, (size_t)1024 * 2048 / 8);
  cvt_elems(p.peer_keys, p.keys_bf, (size_t)2048 * 128 / 8);
  quant_u4(p.peer_u, p.u_q, p.su, 16384);
  quant_v4(p.peer_v, p.v_q, p.su + 1, 16384);
  for (size_t i = gtid; i < (size_t)T * 32; i += gn) {
    const int t = (int)(i >> 5), ii = (int)(i & 31);
    const float inv = exp2f(-(float)ii * (13.287712379549449f / 32.0f));
    const float ang = (float)p.positions[t] * inv;
    float sn, cs; sincosf(ang, &sn, &cs);
    *(f32x2*)(p.rope + i * 2) = f32x2{cs, sn};
  }
  norm_rows_1024(p.mem, p.norm_mem, p.mn, NB * 256);
  norm_rows_1024(p.x, p.norm_mix, p.xn, T);
}

struct KArgs { const void* in[25]; float* out; char* ws; };
__host__ __device__ __forceinline__ size_t align_up(size_t v) { return (v + 255) & ~(size_t)255; }
__host__ __device__ __forceinline__ Params build_params(const KArgs& k, size_t* total) {
  Params p{};
  p.x = (const float*)k.in[0]; p.mem = (const float*)k.in[1]; p.positions = (const int*)k.in[2]; p.norm_mix = (const float*)k.in[3]; p.w_in = (const float*)k.in[4];
  p.q_a_norm = (const float*)k.in[5]; p.w_q_b = (const float*)k.in[6]; p.kv_a_norm = (const float*)k.in[7]; p.w_kv_b = (const float*)k.in[8]; p.swa_sinks = (const float*)k.in[9];
  p.out_norm_mla = (const float*)k.in[10]; p.out_norm_swa = (const float*)k.in[11]; p.w_out = (const float*)k.in[12]; p.norm_cross = (const float*)k.in[13]; p.norm_mem = (const float*)k.in[14];
  p.w_cq = (const float*)k.in[15]; p.w_ck = (const float*)k.in[16]; p.w_cv = (const float*)k.in[17]; p.w_co = (const float*)k.in[18]; p.norm_ffn = (const float*)k.in[19];
  p.peer_w_q = (const float*)k.in[20]; p.peer_keys = (const float*)k.in[21]; p.peer_u = (const float*)k.in[22]; p.peer_v = (const float*)k.in[23]; p.norm_final = (const float*)k.in[24];
  p.X = k.out;
  char* ws = k.ws; size_t off = 0;
#define TAKE(bytes) (ws + ((off += align_up(bytes)) - align_up(bytes)))
  p.wt_in = (bf16_t*)TAKE((size_t)IN_COLS_PAD * 1024 * 2);
  p.wt_qc = (bf16_t*)TAKE((size_t)768 * 256 * 2);
  p.wt_uv = (bf16_t*)TAKE((size_t)512 * 128 * 2);
  p.wt_out = (bf16_t*)TAKE((size_t)1024 * 1024 * 2);
  p.wt_cq = (bf16_t*)TAKE((size_t)512 * 1024 * 2);
  p.wt_ckv = (bf16_t*)TAKE((size_t)1024 * 1024 * 2);
  p.wt_co = (bf16_t*)TAKE((size_t)1024 * 512 * 2);
  p.a_pq = (bf16_t*)TAKE((size_t)1024 * 2048 * 2);
  p.keys_bf = (bf16_t*)TAKE((size_t)2048 * 128 * 2);
  p.wt_sc = (bf16_t*)TAKE((size_t)2048 * 1024 * 2);
  p.bar = (unsigned*)TAKE((size_t)XCD_BAR_WORDS * 4);
  p.u_q = (unsigned char*)TAKE((size_t)16384 * 512);
  p.v_q = (unsigned char*)TAKE((size_t)16384 * 512);
  p.k8 = (unsigned char*)TAKE((size_t)T * 192);
  p.vt8 = (unsigned char*)TAKE((size_t)T * 128);
  p.su = (float*)TAKE((size_t)16384 * 8);
  p.sv = p.su + 1;
  p.mn = (bf16_t*)TAKE((size_t)512 * 1024 * 2);
  p.kvc = (bf16_t*)TAKE((size_t)512 * 1024 * 2);
  p.rope = (float*)TAKE((size_t)T * 64 * 4);
  p.xn = (bf16_t*)TAKE((size_t)T * 1024 * 2);
  const size_t offR = off;
  p.lat = (bf16_t*)TAKE((size_t)T * 448 * 2);
  p.cqn = (bf16_t*)TAKE((size_t)T * 256 * 2);
  p.qcat = (bf16_t*)TAKE((size_t)T * 768 * 2);
  p.kcat = (bf16_t*)TAKE((size_t)T * 192 * 2);
  p.qs = (bf16_t*)TAKE((size_t)T * 512 * 2);
  p.ks = (bf16_t*)TAKE((size_t)T * 128 * 2);
  p.vs = (bf16_t*)TAKE((size_t)T * 128 * 2);
  p.olat = (bf16_t*)TAKE((size_t)T * 512 * 2);
  p.ob = (bf16_t*)TAKE((size_t)T * 512 * 2);
  p.oa = (bf16_t*)TAKE((size_t)T * 512 * 2);
  const size_t offEnd = off;
  off = offR;
  p.qx = (bf16_t*)TAKE((size_t)T * 512 * 2);
  p.ox = (bf16_t*)TAKE((size_t)T * 512 * 2);
  p.top1 = (int*)TAKE((size_t)T * 256 * 4);
  p.pidx = (int*)TAKE((size_t)T * 128 * 4);
  p.pg = (float*)TAKE((size_t)T * 128 * 4);
  p.dpartA = (int*)(ws + offR);
  p.dpartB = (int*)TAKE((size_t)4 * T * 128 * 4);
  p.X16 = (bf16_t*)p.dpartB;
  p.hq = (unsigned char*)TAKE((size_t)T * 1024);
  p.sh = (float*)TAKE((size_t)T * 4);
  p.cbuf = (float*)TAKE((size_t)T * 128 * 4);
#undef TAKE
  if (total) *total = (off > offEnd) ? off : offEnd;
  return p;
}

constexpr int N_PHASES = 19;
template <int PH> DI void run_phase(const Params& p, char* smem) {
  if constexpr (PH == 0) prep_phase(p, smem);
  else if constexpr (PH == 1) {
    g8::run(p.xn, p.wt_in, T, IN_COLS_PAD, DM, g8::EpiInproj{p.lat, p.qs, p.ks, p.vs}, smem);
    { const int G = (int)gridDim.x, n3 = 640 - 2 * G;
      if (n3 > 0 && G - n3 >= 72) {
        if ((int)blockIdx.x >= n3) {
          const int c = (int)blockIdx.x - n3;
          if (c < 8) g8::run_on(p.mn, p.wt_ckv, NB * 256, 1024, DM, g8::EpiBf16{p.kvc, 1024, 1.0f}, smem, c, 8);
          else if (c < 72) gemm_phase(p.a_pq, 2048, 128, p.keys_bf, 128, 1024, 2048, 128, EpiBf16T{p.wt_sc, 1024}, smem, c - 8, 64);
        }
      } else {
        g8::run(p.mn, p.wt_ckv, NB * 256, 1024, DM, g8::EpiBf16{p.kvc, 1024, 1.0f}, smem);
        gemm_phase(p.a_pq, 2048, 128, p.keys_bf, 128, 1024, 2048, 128, EpiBf16T{p.wt_sc, 1024}, smem);
      } }
  }
  else if constexpr (PH == 2) latent_pass(p, smem);
  else if constexpr (PH == 3) g8::run(p.cqn, p.wt_qc, T, 768, 256, g8::EpiBf16{p.qcat, 768, MLA_QSCALE}, smem);
  else if constexpr (PH == 4) { mla_phase(p, smem); swa_phase(p, smem); }
  else if constexpr (PH == 5) gemm_phase(p.olat, 512, 128, p.wt_uv, 128, T, 512, 128, EpiBf16{p.oa, 512, 1.0f}, smem);
  else if constexpr (PH == 6) mix_pass(p);
  else if constexpr (PH == 7) g8::run(p.xn, p.wt_out, T, DM, DM, g8::EpiResid16<true>{p.x, p.X16, DM, DBG_MIX}, smem);
  else if constexpr (PH == 8) norm_rows_bf16(p.X16, p.norm_cross, p.xn, T);
  else if constexpr (PH == 9) g8::run(p.xn, p.wt_cq, T, 512, DM, g8::EpiBf16{p.qx, 512, X_QSCALE}, smem);
  else if constexpr (PH == 10) xattn_phase(p, smem);
  else if constexpr (PH == 11) g8::run(p.ox, p.wt_co, T, DM, 512, g8::EpiResid16<false>{p.X16, p.X16, DM, DBG_XAT}, smem);
  else if constexpr (PH == 12) norm_rows_ffn(p);
  else if constexpr (PH == 13) score_phase(p, smem);
  else if constexpr (PH == 14) topk2_phase(p);
  else if constexpr (PH == 15) peer_dots(p);
  else if constexpr (PH == 16) peer_coef(p);
  else if constexpr (PH == 17) peer_accum(p, p.X16, -1);
  else if constexpr (PH == 18) final_norm(p);
}

template <int PB, int PE>
__global__ void __launch_bounds__(NTHREADS) mega_kernel(KArgs ka) {
  const Params p = build_params(ka, nullptr);
  if (ka.ws == nullptr) cg::this_grid().sync();
  __shared__ __attribute__((aligned(16))) char smem[SMEM_BYTES];
  XcdBarrier xb;
  if constexpr (PE - PB > 1) {
    volatile LAS unsigned* xbw = (volatile LAS unsigned*)(smem + SMEM_BYTES - 256);
    if (threadIdx.x == 0) { xbw[0] = 0u; xbw[1] = 0u; }
    __syncthreads();
    xb = xcd_barrier_post(p.bar, xbw);
  }
#define RUN(n) if constexpr (PB <= n && n < PE) { if constexpr (n == DUP) { if constexpr (n == 17) peer_accum(p, p.oa, 1023); else run_phase<n>(p, smem); xcd_barrier(xb); } run_phase<n>(p, smem); if constexpr (n + 1 < PE) { xcd_barrier(xb); } }
  RUN(0) RUN(1) RUN(2) RUN(3) RUN(4) RUN(5) RUN(6) RUN(7) RUN(8) RUN(9) RUN(10) RUN(11) RUN(12) RUN(13) RUN(14) RUN(15) RUN(16) RUN(17) RUN(18)
#undef RUN
}


extern "C" void kernel_launch(void* const* d_in, const int* in_sizes, int n_in, void* d_out, int out_size, void* d_ws, size_t ws_size, hipStream_t stream) {
  (void)in_sizes; (void)n_in; (void)out_size;
  KArgs ka{};
  for (int i = 0; i < 25; ++i) ka.in[i] = d_in[i];
  ka.out = (float*)d_out; ka.ws = (char*)d_ws;
  size_t need = 0;
  const Params hp = build_params(ka, &need);
  if (need > ws_size) { fprintf(stderr, "kernel_launch: workspace too small (%zu > %zu)\n", need, ws_size); return; }

  static int grid_blocks = 0;
  if (!grid_blocks) {
    int dev = 0, cus = 0;
    (void)hipGetDevice(&dev);
    (void)hipDeviceGetAttribute(&cus, hipDeviceAttributeMultiprocessorCount, dev);
    grid_blocks = cus > 0 ? cus : 256;
  }
#if MK_SINGLE_LAUNCH
  {
    (void)hipMemsetAsync(hp.bar, 0, (size_t)XCD_BAR_WORDS * 4, stream);
    int per_cu = 0;
    (void)hipOccupancyMaxActiveBlocksPerMultiprocessor(&per_cu, mega_kernel<0, N_PHASES>, NTHREADS, 0);
    if (per_cu < 1) fprintf(stderr, "occupancy query returned %d\n", per_cu);
    void* args[] = {&ka};
    hipError_t e = hipLaunchCooperativeKernel((void*)mega_kernel<0, N_PHASES>, dim3(grid_blocks), dim3(NTHREADS), args, 0, stream);
    if (e != hipSuccess) fprintf(stderr, "cooperative launch failed: %s (grid %d)\n", hipGetErrorString(e), grid_blocks);
  }
#else
#define LAUNCH(n) hipLaunchKernelGGL((mega_kernel<n, n + 1>), dim3(grid_blocks), dim3(NTHREADS), 0, stream, ka);
  LAUNCH(0) LAUNCH(1) LAUNCH(2) LAUNCH(3) LAUNCH(4) LAUNCH(5) LAUNCH(6) LAUNCH(7) LAUNCH(8) LAUNCH(9) LAUNCH(10) LAUNCH(11) LAUNCH(12) LAUNCH(13) LAUNCH(14) LAUNCH(15) LAUNCH(16) LAUNCH(17) LAUNCH(18)
#undef LAUNCH
#endif
}
```

```cpp
#include <hip/hip_runtime.h>
#include <hip/hip_cooperative_groups.h>
#include <cstdint>
#include <cstdio>
namespace cg = cooperative_groups;

#ifndef MK_SINGLE_LAUNCH
#define MK_SINGLE_LAUNCH 1
#endif

#ifndef DUP
#define DUP -1
#endif
#ifndef DBG
#define DBG 0
#endif
#define DBG_MIX ((DBG == 1) ? 0.0f : 1.0f)
#define DBG_XAT ((DBG == 1 || DBG == 2) ? 0.0f : 1.0f)
#define DBG_PEER ((DBG >= 1 && DBG <= 3) ? 0.0f : (DBG == 4 ? -0.5f : 1.0f))
#define DI __device__ __forceinline__
typedef unsigned short bf16_t;
typedef short bf16x8 __attribute__((ext_vector_type(8)));
typedef short s16x4 __attribute__((ext_vector_type(4)));
typedef float f32x16 __attribute__((ext_vector_type(16)));
typedef float f32x4 __attribute__((ext_vector_type(4)));
typedef float f32x2 __attribute__((ext_vector_type(2)));
typedef unsigned u32x4 __attribute__((ext_vector_type(4)));
typedef unsigned u32x2 __attribute__((ext_vector_type(2)));
typedef int i32x4 __attribute__((ext_vector_type(4)));
typedef __bf16 bf2_t __attribute__((ext_vector_type(2)));

constexpr int NB = 2, SEQ = 16384, DM = 1024, T = NB * SEQ;
constexpr int NTHREADS = 512;
constexpr float LOG2E = 1.4426950408889634f;
constexpr float EPS = 1e-6f;
constexpr int IN_COLS = 1216, IN_COLS_PAD = 1280;
constexpr float MLA_QSCALE = 0.07216878364870322f * LOG2E * 8.0f;
constexpr float SWA_QSCALE = 0.125f * LOG2E;
constexpr float X_QSCALE = 0.08838834764831845f * LOG2E;
constexpr float SM_THR = 8.0f;
constexpr float V_FP8_SCALE = 64.0f;

#define XB_TMO      128
#define XB_XCNT(j)  (256  + 64 * (j))
#define XB_XSUB(j)  (1280 + 64 * (j))
#define XB_XGEN(j)  (2304 + 64 * (j))
#define XB_TOP      3328
#define XB_TOPGEN   3392
#define XCD_BAR_WORDS 3456
#define XB_SPIN_CAP (1u << 22)
#define LAS __attribute__((address_space(3)))
DI unsigned xb_ld(unsigned* p)              { return __hip_atomic_load(p, __ATOMIC_RELAXED, __HIP_MEMORY_SCOPE_AGENT); }
DI unsigned xb_add(unsigned* p, unsigned v) { return __hip_atomic_fetch_add(p, v, __ATOMIC_RELAXED, __HIP_MEMORY_SCOPE_AGENT); }
DI unsigned xb_xcc_id() { return (unsigned)__builtin_amdgcn_s_getreg((3 << 11) | 20) & 0xFu; }
#define XB_SPIN(cond, bar) do { unsigned _sp = 0; while (cond) { __builtin_amdgcn_s_sleep(1); \
    if ((++_sp & 255u) == 0u) { if (xb_ld(&(bar)[XB_TMO])) break; if (_sp > XB_SPIN_CAP) { atomicAdd(&(bar)[XB_TMO], 1u); break; } } } } while (0)
struct XcdBarrier { unsigned* bar; unsigned x; volatile LAS unsigned* st; };
DI XcdBarrier xcd_barrier_post(unsigned* bar, volatile LAS unsigned* st) {
  XcdBarrier b; b.bar = bar; b.x = xb_xcc_id(); b.st = st;
  if (threadIdx.x == 0) (void)xb_add(&bar[XB_XCNT(b.x)], 1u);
  return b;
}
DI void xcd_barrier_complete(unsigned* bar, unsigned x, unsigned& nloc, unsigned& nx) {
  const unsigned G = gridDim.x * gridDim.y * gridDim.z;
  unsigned sum, cnt, mine, sp = 0u;
  for (;;) {
    sum = 0u; cnt = 0u; mine = 0u;
#pragma unroll
    for (unsigned j = 0; j < 16; ++j) { const unsigned c = xb_ld(&bar[XB_XCNT(j)]); sum += c; cnt += (c > 0u) ? 1u : 0u; mine = (j == x) ? c : mine; }
    if (sum == G) break;
    __builtin_amdgcn_s_sleep(1);
    if ((++sp & 255u) == 0u) { if (xb_ld(&bar[XB_TMO])) break; if (sp > XB_SPIN_CAP) { atomicAdd(&bar[XB_TMO], 1u); break; } }
  }
  nloc = mine > 0u ? mine : 1u; nx = cnt > 0u ? cnt : 1u;
}
DI void xcd_barrier(const XcdBarrier& b) {
  asm volatile("s_waitcnt vmcnt(0)" ::: "memory");
  __syncthreads();
  if (threadIdx.x == 0) {
    unsigned* bar = b.bar;
    __builtin_amdgcn_s_waitcnt(0);
    unsigned nloc = b.st[0], nx = b.st[1];
    if (nloc == 0u) { xcd_barrier_complete(bar, b.x, nloc, nx); b.st[0] = nloc; b.st[1] = nx; }
    const unsigned old = xb_add(&bar[XB_XSUB(b.x)], 1u);
    const unsigned gen = old / nloc;
    if (old + 1u == (gen + 1u) * nloc) {
      __builtin_amdgcn_fence(__ATOMIC_RELEASE, "agent");
      asm volatile("s_waitcnt vmcnt(0)" ::: "memory");
      const unsigned og = xb_add(&bar[XB_TOP], 1u);
      const unsigned tg = og / nx;
      if (og + 1u == (tg + 1u) * nx) xb_add(&bar[XB_TOPGEN], 1u);
      else XB_SPIN(xb_ld(&bar[XB_TOPGEN]) == tg, bar);
      __builtin_amdgcn_fence(__ATOMIC_ACQUIRE, "agent");
      xb_add(&bar[XB_XGEN(b.x)], 1u);
      asm volatile("s_waitcnt vmcnt(0)" ::: "memory");
    } else {
      XB_SPIN(xb_ld(&bar[XB_XGEN(b.x)]) == gen, bar);
      __builtin_amdgcn_fence(__ATOMIC_ACQUIRE, "agent");
      asm volatile("s_waitcnt vmcnt(0)" ::: "memory");
    }
  }
  __syncthreads();
}

struct Params {
  const float* x; const float* mem; const int* positions; const float* norm_mix; const float* w_in; const float* q_a_norm; const float* w_q_b;
  const float* kv_a_norm; const float* w_kv_b; const float* swa_sinks; const float* out_norm_mla; const float* out_norm_swa; const float* w_out;
  const float* norm_cross; const float* norm_mem; const float* w_cq; const float* w_ck; const float* w_cv; const float* w_co; const float* norm_ffn;
  const float* peer_w_q; const float* peer_keys; const float* peer_u; const float* peer_v; const float* norm_final;
  float* X;
  bf16_t* wt_in; bf16_t* wt_qc; bf16_t* wt_uv; bf16_t* wt_out; bf16_t* wt_cq; bf16_t* wt_ckv; bf16_t* wt_co; bf16_t* a_pq; bf16_t* keys_bf; bf16_t* wt_sc;
  unsigned char* u_q; unsigned char* v_q; unsigned char* k8; unsigned char* vt8; float* su; float* sv; unsigned* bar; bf16_t* mn; bf16_t* kvc; float* rope; bf16_t* xn; bf16_t* lat; bf16_t* cqn; bf16_t* qcat; bf16_t* kcat;
  bf16_t* qs; bf16_t* ks; bf16_t* vs; bf16_t* olat; bf16_t* ob; bf16_t* oa; bf16_t* qx; bf16_t* ox; int* top1; int* pidx; float* pg; unsigned char* hq; float* sh; int* dpartA; int* dpartB; float* cbuf; bf16_t* X16;
};

DI unsigned pk2(float lo, float hi) { f32x2 v = {lo, hi}; bf2_t b = __builtin_convertvector(v, bf2_t); return __builtin_bit_cast(unsigned, b); }
DI bf16_t f2bf(float x) { __bf16 b = (__bf16)x; return __builtin_bit_cast(bf16_t, b); }
DI float bf2f(bf16_t b) { return __uint_as_float(((unsigned)b) << 16); }
DI float bflo(unsigned w) { return __uint_as_float(w << 16); }
DI float bfhi(unsigned w) { return __uint_as_float(w & 0xffff0000u); }
DI float dot2bf(unsigned a, unsigned b, float c) { return __builtin_amdgcn_fdot2_f32_bf16(__builtin_bit_cast(bf2_t, a), __builtin_bit_cast(bf2_t, b), c, false); }
DI int GTID() { int t = threadIdx.x; asm volatile("" : "+v"(t)); return (int)blockIdx.x * NTHREADS + t; }
DI int crow(int r, int hi) { return (r & 3) + 8 * (r >> 2) + 4 * hi; }
DI float wave_sum(float v) {
#pragma unroll
  for (int o = 32; o >= 1; o >>= 1) v += __shfl_xor(v, o);
  return v;
}
#define MFMA32(a, b, c) __builtin_amdgcn_mfma_f32_32x32x16_bf16((a), (b), (c), 0, 0, 0)
#define SBAR() __builtin_amdgcn_sched_barrier(0)

constexpr int G_BM = 256, G_BN = 128, G_BK = 64;
constexpr int G_A_BYTES = G_BM * 128, G_B_BYTES = G_BN * 128, G_STAGE = G_A_BYTES + G_B_BYTES;
constexpr int G_NSTAGE = 3;
constexpr int SMEM_BYTES = 160768 + 256;
#define LDSP(p) ((__attribute__((address_space(3))) unsigned*)(p))

template <int V>
DI void gemm_mainloop(const bf16_t* __restrict__ A, int lda, const bf16_t* __restrict__ Bt, int ldb, int K, int row0, int col0, f32x16 (&acc)[4], char* smem) {
  int tid_ = threadIdx.x; asm volatile("" : "+v"(tid_));
  const int tid = tid_, lane = tid & 63, wid = tid >> 6, r32 = lane & 31, hi = lane >> 5;
  const int srow = tid >> 3, spc = tid & 7, slc = spc ^ ((srow >> 1) & 7);
  const bf16_t* Ag = A + (size_t)(row0 + srow) * lda + slc * 8;
  const bf16_t* Bg = Bt + (size_t)(col0 + srow) * ldb + slc * 8;
  const size_t a64 = (size_t)64 * lda, b64 = (size_t)64 * ldb;
#pragma unroll
  for (int i = 0; i < 4; ++i) acc[i] = f32x16{};
  const int nk = K / G_BK;
  auto stage = [&](int kt, int slot) {
    char* sa = smem + slot * G_STAGE + tid * 16;
    const bf16_t* ag = Ag + kt * G_BK; const bf16_t* bg = Bg + kt * G_BK;
#pragma unroll
    for (int i = 0; i < 4; ++i) __builtin_amdgcn_global_load_lds((const unsigned*)(ag + i * a64), LDSP(sa + i * 8192), 16, 0, 0);
#pragma unroll
    for (int i = 0; i < 2; ++i) __builtin_amdgcn_global_load_lds((const unsigned*)(bg + i * b64), LDSP(sa + G_A_BYTES + i * 8192), 16, 0, 0);
  };
  stage(0, 0);
  if (nk > 1) stage(1, 1);
  const int x = (r32 >> 1) & 7;
  int so[4];
#pragma unroll
  for (int s = 0; s < 4; ++s) so[s] = ((2 * s + hi) ^ x) * 16;
  int aoff, boff;
  if (V == 0) { aoff = ((wid >> 1) * 64 + r32) * 128; boff = G_A_BYTES + ((wid & 1) * 64 + r32) * 128; }
  else        { aoff = ((wid >> 2) * 128 + r32) * 128; boff = G_A_BYTES + ((wid & 3) * 32 + r32) * 128; }
  int slot = 0;
  for (int kt = 0; kt < nk; ++kt) {
    if (kt + 1 < nk) asm volatile("s_waitcnt vmcnt(6) lgkmcnt(0)" ::: "memory"); else asm volatile("s_waitcnt vmcnt(0) lgkmcnt(0)" ::: "memory");
    __builtin_amdgcn_s_barrier();
    if (kt + 2 < nk) { int ns = slot + 2; if (ns >= G_NSTAGE) ns -= G_NSTAGE; stage(kt + 2, ns); }
    const char* cs = smem + slot * G_STAGE;
    if (V == 0) {
      bf16x8 af[4][2], bf[4][2];
#pragma unroll
      for (int s = 0; s < 4; ++s) {
        af[s][0] = *(const bf16x8*)(cs + aoff + so[s]); af[s][1] = *(const bf16x8*)(cs + aoff + 32 * 128 + so[s]);
        bf[s][0] = *(const bf16x8*)(cs + boff + so[s]); bf[s][1] = *(const bf16x8*)(cs + boff + 32 * 128 + so[s]);
      }
#pragma unroll
      for (int s = 0; s < 4; ++s) {
        acc[0] = MFMA32(af[s][0], bf[s][0], acc[0]); acc[1] = MFMA32(af[s][0], bf[s][1], acc[1]);
        acc[2] = MFMA32(af[s][1], bf[s][0], acc[2]); acc[3] = MFMA32(af[s][1], bf[s][1], acc[3]);
      }
    } else {
      bf16x8 af[4][4], bf[4];
#pragma unroll
      for (int s = 0; s < 4; ++s) {
        bf[s] = *(const bf16x8*)(cs + boff + so[s]);
#pragma unroll
        for (int mi = 0; mi < 4; ++mi) af[s][mi] = *(const bf16x8*)(cs + aoff + mi * 32 * 128 + so[s]);
      }
#pragma unroll
      for (int s = 0; s < 4; ++s)
#pragma unroll
        for (int mi = 0; mi < 4; ++mi) acc[mi] = MFMA32(af[s][mi], bf[s], acc[mi]);
    }
    slot = (slot + 1 == G_NSTAGE) ? 0 : slot + 1;
  }
  __syncthreads();
}

constexpr int EP_STR = 132;
template <class Epi>
DI void gemm_epi_rows(const f32x16 (&acc)[4], int row0, int col0, const Epi& epi, char* smem) {
  int tid_ = threadIdx.x; asm volatile("" : "+v"(tid_));
  const int tid = tid_, lane = tid & 63, wid = tid >> 6, r32 = lane & 31, hi = lane >> 5;
  float* tile = (float*)smem;
  const int rb = (wid >> 1) * 64, cb = (wid & 1) * 64 + r32;
  const int rr = tid >> 5, c4 = (tid & 31) * 4;
  if constexpr (Epi::HAS_BASE) {
    f32x4 bs[16];
#pragma unroll
    for (int it = 0; it < 16; ++it) bs[it] = epi.load_base(row0 + it * 16 + rr, col0 + c4);
#pragma unroll
    for (int mi = 0; mi < 2; ++mi)
#pragma unroll
      for (int ni = 0; ni < 2; ++ni)
#pragma unroll
        for (int r = 0; r < 16; ++r) tile[(rb + mi * 32 + crow(r, hi)) * EP_STR + cb + ni * 32] = acc[mi * 2 + ni][r];
    __syncthreads();
#pragma unroll
    for (int it = 0; it < 16; ++it) {
      const int row = it * 16 + rr;
      const f32x4 v = *(const f32x4*)(tile + row * EP_STR + c4);
      epi.store(row0 + row, col0 + c4, v, bs[it]);
    }
  } else {
#pragma unroll
    for (int mi = 0; mi < 2; ++mi)
#pragma unroll
      for (int ni = 0; ni < 2; ++ni)
#pragma unroll
        for (int r = 0; r < 16; ++r) tile[(rb + mi * 32 + crow(r, hi)) * EP_STR + cb + ni * 32] = acc[mi * 2 + ni][r];
    __syncthreads();
#pragma unroll 4
    for (int it = 0; it < 16; ++it) {
      const int row = it * 16 + rr;
      const f32x4 v = *(const f32x4*)(tile + row * EP_STR + c4);
      epi(row0 + row, col0 + c4, v);
    }
  }
  __syncthreads();
}

template <class Epi>
DI void gemm_phase(const bf16_t* A, int lda, int a_kstride, const bf16_t* Bt, int ldb, int M, int N, int K, const Epi& epi, char* smem, int bid = -1, int nb = 0) {
  if (bid < 0) { bid = (int)blockIdx.x; nb = (int)gridDim.x; }
  const int ntn = N / G_BN, total = (M / G_BM) * ntn;
  for (int L = bid; L < total; L += nb) {
    const int wg = (L & 7) * (total >> 3) + (L >> 3);
    const int pm = wg / ntn, pn = wg - pm * ntn;
    f32x16 acc[4];
    gemm_mainloop<0>(A + (size_t)pn * a_kstride, lda, Bt, ldb, K, pm * G_BM, pn * G_BN, acc, smem);
    gemm_epi_rows(acc, pm * G_BM, pn * G_BN, epi, smem);
  }
}

DI u32x2 pk4(const f32x4& v, float s) { return u32x2{pk2(v[0] * s, v[1] * s), pk2(v[2] * s, v[3] * s)}; }
struct EpiInproj {
  static constexpr bool HAS_BASE = false;
  bf16_t* lat; bf16_t* qs; bf16_t* ks; bf16_t* vs;
  DI void operator()(int row, int col, const f32x4& v) const {
    if (col < 448) *(u32x2*)(lat + (size_t)row * 448 + col) = pk4(v, 1.0f);
    else if (col < 960) *(u32x2*)(qs + (size_t)row * 512 + (col - 448)) = pk4(v, SWA_QSCALE);
    else if (col < 1088) *(u32x2*)(ks + (size_t)row * 128 + (col - 960)) = pk4(v, 1.0f);
    else if (col < 1216) *(u32x2*)(vs + (size_t)row * 128 + (col - 1088)) = pk4(v, 1.0f);
  }
};
struct EpiBf16 { static constexpr bool HAS_BASE = false; bf16_t* out; int ld; float scale; DI void operator()(int row, int col, const f32x4& v) const { *(u32x2*)(out + (size_t)row * ld + col) = pk4(v, scale); } };
struct EpiBf16T { static constexpr bool HAS_BASE = false; bf16_t* out; int ld; DI void operator()(int row, int col, const f32x4& v) const {
#pragma unroll
  for (int j = 0; j < 4; ++j) out[(size_t)(col + j) * ld + row] = f2bf(v[j]); } };
struct EpiResid { static constexpr bool HAS_BASE = true; const float* base; float* out; int ld; float scale;
  DI f32x4 load_base(int row, int col) const { return *(const f32x4*)(base + (size_t)row * ld + col); }
  DI void store(int row, int col, const f32x4& v, const f32x4& b) const { *(f32x4*)(out + (size_t)row * ld + col) = b + v * scale; } };

namespace g8 {
#define PG8_LAS __attribute__((address_space(3)))
constexpr int BM = 256, BK = 64, HALF = 128, HTB = HALF * BK * 2, NXCD = 8, WGM = 8;
DI int lds_byte(int r, int c) { const int st = (r >> 4) * 2 + (c >> 5), rr = r & 15, cc = c & 31, ob = rr * 64 + cc * 2; return st * 1024 + (ob ^ (((ob >> 9) & 1) << 5)); }
DI void stage_rc(int b, int& R, int& C) { const int st = b / 1024, sb = b % 1024, swz = sb ^ (((sb >> 9) & 1) << 5); R = (st >> 1) * 16 + swz / 64; C = (st & 1) * 32 + (swz % 64) / 2; }
DI int perm32(int rho) { const int n = rho >> 4, i = rho & 15; return 8 * (i >> 2) + 4 * n + (i & 3); }
struct Unit { int pm, pn; };
struct Gemm { const bf16_t* A; const bf16_t* Bt; int M, N, K; };
struct StaticOrder {
  int nM, nN, nwg, G, c;
  DI void init(int M, int N, int G_, int c_) { nM = M / BM; nN = N / BM; nwg = nM * nN; G = G_; c = c_; }
  DI bool next(int i, Unit& u) const {
    const long L = (long)i * G + c; if (L >= nwg) return false;
    int wgid = (int)L; { const int q = nwg / NXCD, r = nwg % NXCD, xcd = wgid % NXCD, off = wgid / NXCD; wgid = (xcd < r ? xcd * (q + 1) : r * (q + 1) + (xcd - r) * q) + off; }
    const int nig = WGM * nN, gid = wgid / nig, fm = gid * WGM, gsz = (nM - fm) < WGM ? (nM - fm) : WGM;
    u.pm = fm + ((wgid % nig) % gsz); u.pn = (wgid % nig) / gsz; return true;
  }
};
template <class Epi>
DI void gemm_phase(PG8_LAS unsigned char* lds, const Gemm g, const StaticOrder& S, const Epi& E) {
  int tid = threadIdx.x; asm volatile("" : "+v"(tid));
  const int wid = __builtin_amdgcn_readfirstlane(tid >> 6), lane = tid & 63, wr = wid >> 2, wc = wid & 3, fr = lane & 15, fq = lane >> 4;
  const int K = g.K, nt = K / BK;
  unsigned voffA[2], voffB[2];
#pragma unroll
  for (int i = 0; i < 2; ++i) { int R, C; stage_rc(tid * 16 + i * 8192, R, C); const int Rb = Epi::PERM ? ((R & ~31) + perm32(R & 31)) : R;
    voffA[i] = (unsigned)(R * K + C) * 2u; voffB[i] = (unsigned)(Rb * K + C) * 2u; }
  const size_t kstep = (size_t)(BK * 2), hstep = (size_t)HALF * K * 2, tstep = 2 * hstep;
  const unsigned ldsw = (unsigned)wid * 1024u;
  const int aoff = lds_byte(wr * 64 + fr, fq * 8), boff = lds_byte(wc * 32 + fr, fq * 8);
#define PG8_SA(b, h) (((b) * 2 + (h)) * HTB)
#define PG8_SB(b, h) ((4 + (b) * 2 + (h)) * HTB)
#define PG8_STAGE(bufoff, gbase, voff) do { _Pragma("unroll") for (int _i = 0; _i < 2; ++_i) \
    __builtin_amdgcn_global_load_lds((const unsigned*)((const char*)(gbase) + (voff)[_i]), (PG8_LAS unsigned*)(lds + (bufoff) + ldsw + _i * 8192), 16, 0, 0); } while (0)
#define PG8_LDA(dst, b, h) do { _Pragma("unroll") for (int m = 0; m < 4; ++m) _Pragma("unroll") for (int k = 0; k < 2; ++k) dst[m][k] = *(const PG8_LAS bf16x8*)(lds + PG8_SA(b, h) + aoff + m * 2048 + k * 1024); } while (0)
#define PG8_LDB(dst, b, h) do { _Pragma("unroll") for (int n = 0; n < 2; ++n) _Pragma("unroll") for (int k = 0; k < 2; ++k) dst[n][k] = *(const PG8_LAS bf16x8*)(lds + PG8_SB(b, h) + boff + n * 2048 + k * 1024); } while (0)
#define PG8_MMA(ai, bj, At, Bt) do { __builtin_amdgcn_s_setprio(1); _Pragma("unroll") for (int m = 0; m < 4; ++m) _Pragma("unroll") for (int n = 0; n < 2; ++n) _Pragma("unroll") for (int k = 0; k < 2; ++k) \
    acc[ai][bj][m][n] = __builtin_amdgcn_mfma_f32_16x16x32_bf16(Bt[n][k], At[m][k], acc[ai][bj][m][n], 0, 0, 0); __builtin_amdgcn_s_setprio(0); } while (0)
#define PG8_WAIT_V(n) asm volatile("s_waitcnt vmcnt(" #n ")" ::: "memory")
#define PG8_WAIT_L(n) asm volatile("s_waitcnt lgkmcnt(" #n ")" ::: "memory")
#define PG8_BAR __builtin_amdgcn_s_barrier()
#define PG8_SCHED __builtin_amdgcn_sched_barrier(0)
  Unit cur, nxt; int ui = 0;
  if (!S.next(0, cur)) return;
  f32x4 acc[2][2][4][2];
#pragma unroll
  for (int a = 0; a < 2; ++a)
#pragma unroll
    for (int b = 0; b < 2; ++b)
#pragma unroll
      for (int m = 0; m < 4; ++m)
#pragma unroll
        for (int n = 0; n < 2; ++n) acc[a][b][m][n] = (f32x4){0.f, 0.f, 0.f, 0.f};
  bf16x8 At[4][2], B0[2][2], B1[2][2];
  const char* cA = (const char*)g.A + (size_t)cur.pm * tstep; const char* cB = (const char*)g.Bt + (size_t)cur.pn * tstep;
  PG8_STAGE(PG8_SB(0, 0), cB, voffB); PG8_STAGE(PG8_SA(0, 0), cA, voffA); PG8_STAGE(PG8_SB(0, 1), cB + hstep, voffB); PG8_STAGE(PG8_SA(0, 1), cA + hstep, voffA);
  if (wr == 1) PG8_BAR;
  PG8_WAIT_V(4); PG8_BAR;
  PG8_STAGE(PG8_SB(1, 0), cB + kstep, voffB); PG8_STAGE(PG8_SA(1, 0), cA + kstep, voffA); PG8_STAGE(PG8_SB(1, 1), cB + hstep + kstep, voffB);
  PG8_WAIT_V(6); PG8_BAR;
  for (;;) {
    const bool has_next = S.next(ui + 1, nxt);
    const char* nA = has_next ? (const char*)g.A + (size_t)nxt.pm * tstep : cA; const char* nB = has_next ? (const char*)g.Bt + (size_t)nxt.pn * tstep : cB;
    for (int t = 0; t < nt; t += 2) {
      const bool last = (t == nt - 2);
      const char* a1 = cA + (size_t)(t + 1) * kstep;
      const char* a2 = last ? nA : cA + (size_t)(t + 2) * kstep; const char* b2 = last ? nB : cB + (size_t)(t + 2) * kstep;
      const char* a3 = a2 + kstep; const char* b3 = b2 + kstep;
      PG8_LDB(B0, 0, 0); PG8_SCHED; PG8_LDA(At, 0, 0); PG8_STAGE(PG8_SA(1, 1), a1 + hstep, voffA);
      PG8_WAIT_L(8); PG8_BAR; PG8_WAIT_L(0); PG8_MMA(0, 0, At, B0); PG8_BAR; PG8_SCHED;
      PG8_LDB(B1, 0, 1); PG8_STAGE(PG8_SB(0, 0), b2, voffB);
      PG8_BAR; PG8_WAIT_L(0); PG8_MMA(0, 1, At, B1); PG8_BAR;
      PG8_LDA(At, 0, 1); PG8_STAGE(PG8_SA(0, 0), a2, voffA);
      PG8_BAR; PG8_WAIT_L(0); PG8_MMA(1, 0, At, B0); PG8_BAR; PG8_SCHED;
      PG8_STAGE(PG8_SB(0, 1), b2 + hstep, voffB);
      PG8_WAIT_V(6); PG8_BAR; PG8_MMA(1, 1, At, B1); PG8_BAR;
      PG8_LDB(B0, 1, 0); PG8_SCHED; PG8_LDA(At, 1, 0); PG8_STAGE(PG8_SA(0, 1), a2 + hstep, voffA);
      PG8_WAIT_L(8); PG8_BAR; PG8_WAIT_L(0); PG8_MMA(0, 0, At, B0); PG8_BAR; PG8_SCHED;
      PG8_LDB(B1, 1, 1); PG8_STAGE(PG8_SB(1, 0), b3, voffB);
      PG8_BAR; PG8_WAIT_L(0); PG8_MMA(0, 1, At, B1); PG8_BAR;
      PG8_LDA(At, 1, 1); PG8_STAGE(PG8_SA(1, 0), a3, voffA);
      PG8_BAR; PG8_WAIT_L(0); PG8_MMA(1, 0, At, B0); PG8_BAR; PG8_SCHED;
      PG8_STAGE(PG8_SB(1, 1), b3 + hstep, voffB);
      PG8_WAIT_V(6); PG8_BAR; PG8_MMA(1, 1, At, B1); PG8_BAR;
    }
    E(acc, cur, wr, wc, fr, fq);
    if (!has_next) break;
#pragma unroll
    for (int a = 0; a < 2; ++a)
#pragma unroll
      for (int b = 0; b < 2; ++b)
#pragma unroll
        for (int m = 0; m < 4; ++m)
#pragma unroll
          for (int n = 0; n < 2; ++n) acc[a][b][m][n] = (f32x4){0.f, 0.f, 0.f, 0.f};
    cur = nxt; cA = nA; cB = nB; ++ui;
  }
  PG8_WAIT_V(0);
  if (wr == 0) PG8_BAR;
  PG8_BAR;
#undef PG8_SA
#undef PG8_SB
#undef PG8_STAGE
#undef PG8_LDA
#undef PG8_LDB
#undef PG8_MMA
#undef PG8_WAIT_V
#undef PG8_WAIT_L
#undef PG8_BAR
#undef PG8_SCHED
}
DI u32x4 pk8(const f32x4& v0, const f32x4& v1, float s) { return u32x4{pk2(v0[0] * s, v0[1] * s), pk2(v0[2] * s, v0[3] * s), pk2(v1[0] * s, v1[1] * s), pk2(v1[2] * s, v1[3] * s)}; }
struct EpiBf16 {
  static constexpr bool PERM = true;
  bf16_t* out; int ld; float scale;
  DI void operator()(const f32x4 (&acc)[2][2][4][2], const Unit& u, int wr, int wc, int fr, int fq) const {
    const int row0 = u.pm * BM + wr * 64 + fr, col0 = u.pn * BM + wc * 32 + 8 * fq;
#pragma unroll
    for (int ai = 0; ai < 2; ++ai)
#pragma unroll
      for (int m = 0; m < 4; ++m) { bf16_t* rowp = out + (size_t)(row0 + ai * HALF + m * 16) * ld + col0;
#pragma unroll
        for (int bj = 0; bj < 2; ++bj) *(u32x4*)(rowp + bj * HALF) = pk8(acc[ai][bj][m][0], acc[ai][bj][m][1], scale); }
  }
};
struct EpiInproj {
  static constexpr bool PERM = true;
  bf16_t* lat; bf16_t* qs; bf16_t* ks; bf16_t* vs;
  DI void operator()(const f32x4 (&acc)[2][2][4][2], const Unit& u, int wr, int wc, int fr, int fq) const {
    const int row0 = u.pm * BM + wr * 64 + fr;
#pragma unroll
    for (int bj = 0; bj < 2; ++bj) {
      const int cw = u.pn * BM + bj * HALF + wc * 32;
      bf16_t* dst; int ld; float sc = 1.0f;
      if (cw < 448) { dst = lat + cw; ld = 448; } else if (cw < 960) { dst = qs + (cw - 448); ld = 512; sc = SWA_QSCALE; }
      else if (cw < 1088) { dst = ks + (cw - 960); ld = 128; } else if (cw < 1216) { dst = vs + (cw - 1088); ld = 128; } else continue;
#pragma unroll
      for (int ai = 0; ai < 2; ++ai)
#pragma unroll
        for (int m = 0; m < 4; ++m) *(u32x4*)(dst + (size_t)(row0 + ai * HALF + m * 16) * ld + 8 * fq) = pk8(acc[ai][bj][m][0], acc[ai][bj][m][1], sc);
    }
  }
};
template <bool BASE_F32>
struct EpiResid16 {
  static constexpr bool PERM = true;
  const void* base; bf16_t* out; int ld; float scale;
  DI void operator()(const f32x4 (&acc)[2][2][4][2], const Unit& u, int wr, int wc, int fr, int fq) const {
    const int row0 = u.pm * BM + wr * 64 + fr, col0 = u.pn * BM + wc * 32 + 8 * fq;
#pragma unroll
    for (int ai = 0; ai < 2; ++ai)
#pragma unroll
      for (int m = 0; m < 4; ++m) { const size_t ro = (size_t)(row0 + ai * HALF + m * 16) * ld + col0;
        f32x4 b[2][2];
#pragma unroll
        for (int bj = 0; bj < 2; ++bj) {
          if (BASE_F32) { b[bj][0] = *(const f32x4*)((const float*)base + ro + bj * HALF); b[bj][1] = *(const f32x4*)((const float*)base + ro + bj * HALF + 4); }
          else { const u32x4 w = *(const u32x4*)((const bf16_t*)base + ro + bj * HALF);
            b[bj][0] = f32x4{bflo(w[0]), bfhi(w[0]), bflo(w[1]), bfhi(w[1])}; b[bj][1] = f32x4{bflo(w[2]), bfhi(w[2]), bflo(w[3]), bfhi(w[3])}; }
        }
#pragma unroll
        for (int bj = 0; bj < 2; ++bj) *(u32x4*)(out + ro + bj * HALF) = pk8(b[bj][0] + acc[ai][bj][m][0] * scale, b[bj][1] + acc[ai][bj][m][1] * scale, 1.0f);
        if (m & 1) asm volatile("" ::: "memory"); }
  }
};
template <class Epi>
DI void run_on(const bf16_t* A, const bf16_t* Bt, int M, int N, int K, const Epi& E, char* smem, int c, int G) {
  StaticOrder S; S.init(M, N, G, c);
  gemm_phase<Epi>((PG8_LAS unsigned char*)smem, Gemm{A, Bt, M, N, K}, S, E);
  __syncthreads();
}
template <class Epi>
DI void run(const bf16_t* A, const bf16_t* Bt, int M, int N, int K, const Epi& E, char* smem) { run_on(A, Bt, M, N, K, E, smem, (int)blockIdx.x, (int)gridDim.x); }
}

DI int tokey(float f) { const int u = __float_as_int(f); return u ^ ((u >> 31) & 0x7fffffff); }
DI float fromkey(int k) { return __int_as_float(k ^ ((k >> 31) & 0x7fffffff)); }
DI void ins16(int (&top)[16], int key) {
#pragma unroll
  for (int j = 0; j < 16; ++j) { const int h = max(top[j], key); key = min(top[j], key); top[j] = h; }
}

DI void score_phase(const Params& p, char* smem) {
  const int ntn = T / G_BN, total = (2048 / G_BM) * ntn;
  for (int L = blockIdx.x; L < total; L += gridDim.x) {
    const int wg = (L & 7) * (total >> 3) + (L >> 3);
    const int pn = wg >> 3, pm = wg & 7;
    f32x16 acc[4];
    gemm_mainloop<1>(p.wt_sc, DM, p.xn, DM, DM, pm * G_BM, pn * G_BN, acc, smem);
    SBAR();
    int tid_ = threadIdx.x; asm volatile("" : "+v"(tid_));
    const int tid = tid_, lane = tid & 63, wid = tid >> 6, r32 = lane & 31, hi = lane >> 5;
    const int group = pm * 2 + (wid >> 2);
    const int tok = pn * G_BN + (wid & 3) * 32 + r32;
    int top[16];
    {
      int g[4][16];
#pragma unroll
      for (int mi = 0; mi < 4; ++mi)
#pragma unroll
        for (int r = 0; r < 16; ++r) { const int n = 32 * mi + crow(r, hi); g[mi][r] = (tokey(acc[mi][r]) & ~127) | (127 - n); }
#pragma unroll
      for (int mi = 0; mi < 4; ++mi)
#pragma unroll
        for (int k = 2; k <= 16; k <<= 1)
#pragma unroll
          for (int j = k >> 1; j >= 1; j >>= 1)
#pragma unroll
            for (int i = 0; i < 16; ++i) { const int l = i ^ j; if (l > i) { const int a = g[mi][i], b = g[mi][l]; const bool desc = (k == 16) || ((i & k) == 0);
              g[mi][i] = desc ? max(a, b) : min(a, b); g[mi][l] = desc ? min(a, b) : max(a, b); } }
      auto merge16 = [](int (&a)[16], const int (&b)[16]) {
#pragma unroll
        for (int i = 0; i < 16; ++i) a[i] = max(a[i], b[15 - i]);
#pragma unroll
        for (int d = 8; d >= 1; d >>= 1)
#pragma unroll
          for (int i = 0; i < 16; ++i) if ((i & d) == 0) { const int x = max(a[i], a[i + d]), y = min(a[i], a[i + d]); a[i] = x; a[i + d] = y; }
      };
      merge16(g[0], g[1]); merge16(g[2], g[3]); merge16(g[0], g[2]);
#pragma unroll
      for (int i = 0; i < 16; ++i) top[i] = g[0][i];
    }
    int c[16];
#pragma unroll
    for (int j = 0; j < 16; ++j) {
      auto rr = __builtin_amdgcn_permlane32_swap((unsigned)top[15 - j], (unsigned)top[15 - j], false, false);
      const int other = hi ? (int)rr[0] : (int)rr[1];
      c[j] = max(top[j], other);
    }
#pragma unroll
    for (int d = 8; d >= 1; d >>= 1)
#pragma unroll
      for (int i = 0; i < 16; ++i) if ((i & d) == 0) { const int a = max(c[i], c[i + d]), b = min(c[i], c[i + d]); c[i] = a; c[i + d] = b; }
    int* dst = p.top1 + ((size_t)tok * 16 + group) * 16 + hi * 8;
    if (hi == 0) { *(i32x4*)dst = i32x4{c[0], c[1], c[2], c[3]}; *(i32x4*)(dst + 4) = i32x4{c[4], c[5], c[6], c[7]}; }
    else         { *(i32x4*)dst = i32x4{c[8], c[9], c[10], c[11]}; *(i32x4*)(dst + 4) = i32x4{c[12], c[13], c[14], c[15]}; }
    SBAR();
  }
}

DI void ins16v(float (&bv)[16], int (&bp)[16], float v, int pl) {
#pragma unroll
  for (int j = 0; j < 16; ++j) { const bool c = v > bv[j]; const float nv = c ? bv[j] : v; const int np = c ? bp[j] : pl; bv[j] = c ? v : bv[j]; bp[j] = c ? pl : bp[j]; v = nv; pl = np; }
}
DI void topk2_phase(const Params& p) {
  const int nitems = T * 8;
  for (int it = GTID(); it < nitems; it += gridDim.x * NTHREADS) {
    const int* src = p.top1 + (size_t)it * 32;
    int ka[16], kb[16];
#pragma unroll
    for (int q = 0; q < 4; ++q) { const i32x4 v = *(const i32x4*)(src + 4 * q); ka[4 * q] = v[0]; ka[4 * q + 1] = v[1]; ka[4 * q + 2] = v[2]; ka[4 * q + 3] = v[3]; }
#pragma unroll
    for (int q = 0; q < 4; ++q) { const i32x4 v = *(const i32x4*)(src + 16 + 4 * q); kb[4 * q] = v[0]; kb[4 * q + 1] = v[1]; kb[4 * q + 2] = v[2]; kb[4 * q + 3] = v[3]; }
    float av[16], bvv[16]; int ia[16], ib[16];
#pragma unroll
    for (int i = 0; i < 16; ++i) { av[i] = fromkey(ka[i] & ~127); ia[i] = (127 - (ka[i] & 127)) << 7; bvv[i] = fromkey(kb[i] & ~127); ib[i] = 127 - (kb[i] & 127); }
    int best[16];
#pragma unroll
    for (int j = 0; j < 16; ++j) best[j] = (int)0x80000000;
#pragma unroll
    for (int i = 0; i < 16; ++i)
#pragma unroll
      for (int j = 0; j < 16; ++j)
        if ((i + 1) * (j + 1) <= 16) ins16(best, (tokey(av[i] + bvv[j]) & ~0x3fff) | ia[i] | ib[j]);
    float bv[16]; int bp[16];
#pragma unroll
    for (int j = 0; j < 16; ++j) { bv[j] = fromkey(best[j] & ~0x3fff); bp[j] = best[j] & 0x3fff; }
    const float m = bv[0];
    float w[16], sum = 0.f;
#pragma unroll
    for (int j = 0; j < 16; ++j) { w[j] = __builtin_amdgcn_exp2f((bv[j] - m) * LOG2E); sum += w[j]; }
    const float inv = 1.0f / sum;
    int* di = p.pidx + (size_t)it * 16; float* dg = p.pg + (size_t)it * 16;
#pragma unroll
    for (int q = 0; q < 4; ++q) {
      *(i32x4*)(di + 4 * q) = i32x4{bp[4 * q], bp[4 * q + 1], bp[4 * q + 2], bp[4 * q + 3]};
#if DBG == 5
      *(f32x4*)(dg + 4 * q) = f32x4{0.0625f, 0.0625f, 0.0625f, 0.0625f};
#else
      *(f32x4*)(dg + 4 * q) = f32x4{w[4 * q] * inv, w[4 * q + 1] * inv, w[4 * q + 2] * inv, w[4 * q + 3] * inv};
#endif
    }
  }
}

template <int NDB> DI int v_st(int k, int c) { const int kk = (k & ~0xC) | ((k & 4) << 1) | ((k & 8) >> 1); return ((kk >> 3) * NDB + (c >> 5)) * 512 + ((kk & 7) * 32 + (c & 31)) * 2; }
DI int v_rd_base(int lane) { return ((lane & 3) << 3) | (((lane >> 2) & 3) << 6) | (((lane >> 4) & 1) << 5) | (((lane >> 5) & 1) << 8); }
template <int OFF> DI s16x4 tr_read(int vb) { s16x4 r; asm volatile("ds_read_b64_tr_b16 %0, %1 offset:%2" : "=&v"(r) : "v"(vb), "i"(OFF) : "memory"); return r; }
template <int NDB, int D0> DI void pv_one(f32x16& od, int vb, bf16x8 pa0, bf16x8 pa1, bf16x8 pa2, bf16x8 pa3) {
  constexpr int KS = 2 * NDB * 512, HF = NDB * 512;
  const s16x4 l0 = tr_read<D0 * 512 + 0 * KS>(vb), h0 = tr_read<D0 * 512 + 0 * KS + HF>(vb), l1 = tr_read<D0 * 512 + 1 * KS>(vb), h1 = tr_read<D0 * 512 + 1 * KS + HF>(vb);
  const s16x4 l2 = tr_read<D0 * 512 + 2 * KS>(vb), h2 = tr_read<D0 * 512 + 2 * KS + HF>(vb), l3 = tr_read<D0 * 512 + 3 * KS>(vb), h3 = tr_read<D0 * 512 + 3 * KS + HF>(vb);
  asm volatile("s_waitcnt lgkmcnt(0)" ::: "memory"); SBAR();
#define PKV(L, H) (bf16x8){L[0], L[1], L[2], L[3], H[0], H[1], H[2], H[3]}
  od = MFMA32(pa0, PKV(l0, h0), od); od = MFMA32(pa1, PKV(l1, h1), od); od = MFMA32(pa2, PKV(l2, h2), od); od = MFMA32(pa3, PKV(l3, h3), od);
#undef PKV
}

template <int OFF> DI void pv_rd4(int vb, s16x4 (&l)[2], s16x4 (&h)[2]) {
  constexpr int KS = 2 * 4 * 512, HF = 4 * 512;
  l[0] = tr_read<OFF>(vb); h[0] = tr_read<OFF + HF>(vb); l[1] = tr_read<OFF + KS>(vb); h[1] = tr_read<OFF + KS + HF>(vb);
}
#define PKV(L, H) (bf16x8){L[0], L[1], L[2], L[3], H[0], H[1], H[2], H[3]}
DI void pv_all4(f32x16 (&o)[4], int vb, bf16x8 pa0, bf16x8 pa1, bf16x8 pa2, bf16x8 pa3) {
  constexpr int KS2 = 2 * 2 * 4 * 512;
  s16x4 la[2], ha[2], lb[2], hb[2];
  pv_rd4<0 * 512>(vb, la, ha); pv_rd4<0 * 512 + KS2>(vb, lb, hb);
#define PV_STEP(D, NEXTA, NEXTB) \
  asm volatile("s_waitcnt lgkmcnt(4)" ::: "memory"); SBAR(); \
  o[D] = MFMA32(pa0, PKV(la[0], ha[0]), o[D]); o[D] = MFMA32(pa1, PKV(la[1], ha[1]), o[D]); SBAR(); \
  NEXTA; \
  asm volatile("s_waitcnt lgkmcnt(4)" ::: "memory"); SBAR(); \
  o[D] = MFMA32(pa2, PKV(lb[0], hb[0]), o[D]); o[D] = MFMA32(pa3, PKV(lb[1], hb[1]), o[D]); SBAR(); \
  NEXTB;
  PV_STEP(0, (pv_rd4<1 * 512>(vb, la, ha)), (pv_rd4<1 * 512 + KS2>(vb, lb, hb)))
  PV_STEP(1, (pv_rd4<2 * 512>(vb, la, ha)), (pv_rd4<2 * 512 + KS2>(vb, lb, hb)))
  PV_STEP(2, (pv_rd4<3 * 512>(vb, la, ha)), (pv_rd4<3 * 512 + KS2>(vb, lb, hb)))
  asm volatile("s_waitcnt lgkmcnt(4)" ::: "memory"); SBAR();
  o[3] = MFMA32(pa0, PKV(la[0], ha[0]), o[3]); o[3] = MFMA32(pa1, PKV(la[1], ha[1]), o[3]); SBAR();
  asm volatile("s_waitcnt lgkmcnt(0)" ::: "memory"); SBAR();
  o[3] = MFMA32(pa2, PKV(lb[0], hb[0]), o[3]); o[3] = MFMA32(pa3, PKV(lb[1], hb[1]), o[3]);
#undef PV_STEP
}
#undef PKV

template <int DQK, int DV, int MODE>
struct AttnArgs {
  const bf16_t* Kb; int ldk;
  const bf16_t* Vb; int ldv;
  int jt0, NT;
  int tq;
  int diag_tile;
  int tw0;
  float slope2, sink2;
  bf16_t* Ow; int ldo;
};

template <int DQK, int DV, int MODE, int QL>
DI void attn_unit(const bf16x8 (&qr)[DQK / 16 - QL], const AttnArgs<DQK, DV, MODE>& a, char* smem) {
  constexpr int NKS = DQK / 16, NDB = DV / 32, KSTR = DQK * 2 + 16, KBUF = 64 * KSTR, VBUF = 64 * DV * 2, BUF = KBUF + VBUF, NKC = DQK / 64, NVC = DV / 64;
  const int tid = threadIdx.x, wid = __builtin_amdgcn_readfirstlane(tid >> 6), lane = tid & 63, r32 = lane & 31, hi = lane >> 5;
  const bool rot = (wid >= 4);
  float* wsf = (float*)(smem + 3 * BUF) + wid * 64; float* li_l = wsf; float* al_l = wsf + 32;
  const char* qlds = smem + 3 * BUF + 2048 + wid * 4096 + r32 * 128;
  const int qx = (r32 >> 1) & 7;
  float m_reg = -1e30f, l_reg = 0.f; f32x16 o[NDB];
#pragma unroll
  for (int d = 0; d < NDB; ++d) o[d] = f32x16{};
  const int srow = tid >> 3, c8 = tid & 7;
  const int vb0 = (int)(uintptr_t)smem + v_rd_base(lane);
  bf16x8 kst[NKC], vst[(MODE == 0) ? 1 : NVC];
  auto sload = [&](int jt) {
    const size_t krow = (size_t)(jt * 64 + srow);
#pragma unroll
    for (int i = 0; i < NKC; ++i) kst[i] = *(const bf16x8*)(a.Kb + krow * a.ldk + 64 * i + 8 * c8);
    if (MODE != 0) {
#pragma unroll
      for (int i = 0; i < NVC; ++i) vst[i] = *(const bf16x8*)(a.Vb + krow * a.ldv + 64 * i + 8 * c8);
    }
  };
  auto swrite = [&](int b) {
    char* bp = smem + b * BUF;
#pragma unroll
    for (int i = 0; i < NKC; ++i) *(bf16x8*)(bp + VBUF + srow * KSTR + (64 * i + 8 * c8) * 2) = kst[i];
    if (MODE == 0) {
#pragma unroll
      for (int i = 0; i < NVC; ++i) *(bf16x8*)(bp + v_st<NDB>(srow, 64 * i + 8 * c8)) = kst[i];
    } else {
#pragma unroll
      for (int i = 0; i < NVC; ++i) *(bf16x8*)(bp + v_st<NDB>(srow, 64 * i + 8 * c8)) = vst[i];
    }
  };
  auto tile_active = [&](int jt) -> bool { if (MODE == 2) return (jt * 64 + 63 >= a.tw0 - 127) && (jt * 64 <= a.tw0 + 31); return true; };
  f32x16 p0, p1;
  auto qkt = [&](int b) {
    p0 = f32x16{}; p1 = f32x16{};
    const char* Kc = smem + b * BUF + VBUF + r32 * KSTR + hi * 16;
    __builtin_amdgcn_s_setprio(1);
#pragma unroll
    for (int s = 0; s < NKS - QL; ++s) {
      const bf16x8 b0 = *(const bf16x8*)(Kc + s * 32), b1 = *(const bf16x8*)(Kc + 32 * KSTR + s * 32);
      p0 = MFMA32(b0, qr[s], p0); p1 = MFMA32(b1, qr[s], p1);
    }
#pragma unroll
    for (int s = NKS - QL; s < NKS; ++s) {
      const bf16x8 b0 = *(const bf16x8*)(Kc + s * 32), b1 = *(const bf16x8*)(Kc + 32 * KSTR + s * 32);
      const bf16x8 qf = *(const bf16x8*)(qlds + (((2 * (s - (NKS - QL)) + hi) ^ qx) << 4));
      p0 = MFMA32(b0, qf, p0); p1 = MFMA32(b1, qf, p1);
    }
    __builtin_amdgcn_s_setprio(0);
  };
  sload(a.jt0); swrite(0);
  if (a.NT > 1) { sload(a.jt0 + 1); swrite(1); }
  __syncthreads();
  if (rot && tile_active(a.jt0)) qkt(0);
  int cur = 0;
  for (int j = 0; j < a.NT; ++j) {
    const int jt = a.jt0 + j;
    int nxt = cur + 1; if (nxt == 3) nxt = 0;
    int nx2 = nxt + 1; if (nx2 == 3) nx2 = 0;
    if (j + 2 < a.NT) sload(jt + 2);
    const bool active = tile_active(jt);
    if (active) {
      if (!rot) qkt(cur);
      if (MODE == 0) {
        if (jt == a.diag_tile) {
          const int tl = a.tq & 63;
#pragma unroll
          for (int r = 0; r < 16; ++r) { const int kl = crow(r, hi); if (kl > tl) p0[r] = -INFINITY; if (kl + 32 > tl) p1[r] = -INFINITY; }
        }
      } else if (MODE == 2) {
#pragma unroll
        for (int r = 0; r < 16; ++r) {
          const int d0 = a.tq - (jt * 64 + crow(r, hi)), d1 = d0 - 32;
          p0[r] = (d0 >= 0 && d0 < 128) ? p0[r] - a.slope2 * (float)d0 : -INFINITY;
          p1[r] = (d1 >= 0 && d1 < 128) ? p1[r] - a.slope2 * (float)d1 : -INFINITY;
        }
      }
      float pmax = p0[0];
#pragma unroll
      for (int r = 1; r < 16; ++r) pmax = fmaxf(pmax, p0[r]);
#pragma unroll
      for (int r = 0; r < 16; ++r) pmax = fmaxf(pmax, p1[r]);
      { auto rr = __builtin_amdgcn_permlane32_swap(__float_as_uint(pmax), __float_as_uint(pmax), false, false); pmax = fmaxf(__uint_as_float(rr[0]), __uint_as_float(rr[1])); }
      float mn, alpha;
      if (__all(pmax - m_reg <= SM_THR)) { mn = m_reg; alpha = 1.f; }
      else { mn = fmaxf(m_reg, pmax); alpha = __builtin_amdgcn_exp2f(m_reg - mn); m_reg = mn; }
#pragma unroll
      for (int r = 0; r < 16; ++r) { p0[r] = __builtin_amdgcn_exp2f(p0[r] - mn); p1[r] = __builtin_amdgcn_exp2f(p1[r] - mn); }
      float ps = 0.f;
#pragma unroll
      for (int r = 0; r < 16; ++r) ps += p0[r] + p1[r];
      { auto rr = __builtin_amdgcn_permlane32_swap(__float_as_uint(ps), __float_as_uint(ps), false, false); ps = __uint_as_float(rr[0]) + __uint_as_float(rr[1]); }
      l_reg = l_reg * alpha + ps;
      if (__any(alpha < 1.f)) {
        if (hi == 0) al_l[r32] = alpha;
        asm volatile("s_waitcnt lgkmcnt(0)" ::: "memory");
#pragma unroll
        for (int r = 0; r < 16; ++r) { const float al = al_l[crow(r, hi)];
#pragma unroll
          for (int d = 0; d < NDB; ++d) o[d][r] *= al; }
      }
      bf16x8 pa0, pa1, pa2, pa3;
#define PK4(P, BASE, OUT) do { const unsigned a0 = pk2(P[BASE + 0], P[BASE + 1]), a1 = pk2(P[BASE + 2], P[BASE + 3]);   \
      const unsigned b0_ = pk2(P[BASE + 4], P[BASE + 5]), b1_ = pk2(P[BASE + 6], P[BASE + 7]);                          \
      auto r0 = __builtin_amdgcn_permlane32_swap(a0, b0_, false, false); auto r1 = __builtin_amdgcn_permlane32_swap(a1, b1_, false, false); \
      u32x4 w = {r0[0], r1[0], r0[1], r1[1]}; OUT = __builtin_bit_cast(bf16x8, w); } while (0)
      PK4(p0, 0, pa0); PK4(p0, 8, pa1); PK4(p1, 0, pa2); PK4(p1, 8, pa3);
#undef PK4
      const int vb = vb0 + cur * BUF;
      __builtin_amdgcn_s_setprio(1);
      pv_one<NDB, 0>(o[0], vb, pa0, pa1, pa2, pa3);
      pv_one<NDB, 1>(o[1], vb, pa0, pa1, pa2, pa3);
      if constexpr (NDB > 2) { pv_one<NDB, 2>(o[2], vb, pa0, pa1, pa2, pa3); pv_one<NDB, 3>(o[3], vb, pa0, pa1, pa2, pa3); }
      __builtin_amdgcn_s_setprio(0);
    }
    if (j + 2 < a.NT) swrite(nx2);
    if (rot && j + 1 < a.NT && tile_active(jt + 1)) qkt(nxt);
    __syncthreads();
    cur = nxt;
  }
  if (MODE == 2) l_reg += __builtin_amdgcn_exp2f(a.sink2 - m_reg);
  if (hi == 0) li_l[r32] = l_reg;
  asm volatile("s_waitcnt lgkmcnt(0)" ::: "memory");
#pragma unroll
  for (int r = 0; r < 16; ++r) {
    const int orow = crow(r, hi); const float rl = 1.0f / li_l[orow];
#pragma unroll
    for (int d = 0; d < NDB; ++d) a.Ow[(size_t)orow * a.ldo + d * 32 + r32] = f2bf(o[d][r] * rl);
  }
  __syncthreads();
}

#ifndef P8_SCL_SIGN
#define P8_SCL_SIGN 1
#endif
typedef short s16x2 __attribute__((ext_vector_type(2)));
#define MFMA32F8(a, b, c) __builtin_amdgcn_mfma_f32_32x32x16_fp8_fp8((a), (b), (c), 0, 0, 0)
typedef int i32x8u __attribute__((ext_vector_type(8)));
DI void mla_unit(const i32x8u (&q8)[3], const unsigned char* __restrict__ K8b, const unsigned char* __restrict__ Vt8b, int NT, int tl, bf16_t* Ow, char* smem) {
  constexpr int NDB = 4, KSTR = 192, VBUF = 8192, KBUF = 64 * KSTR, BUF = VBUF + KBUF;
  const int tid = threadIdx.x, wid = __builtin_amdgcn_readfirstlane(tid >> 6), lane = tid & 63, r32 = lane & 31, hi = lane >> 5;
  float* li_l = (float*)(smem + 4 * BUF) + wid * 64;
  float l_reg = 0.f; f32x16 o[NDB];
#pragma unroll
  for (int d = 0; d < NDB; ++d) o[d] = f32x16{};
  unsigned ksrc[2];
#pragma unroll
  for (int i = 0; i < 2; ++i) { const int q = i ? (512 + wid * 32 + (lane & 31)) : tid, row = q / 12, pc = q - 12 * row, c = (pc & 12) | ((pc & 3) ^ ((row >> 2) & 3)); ksrc[i] = (unsigned)(row * 192 + c * 16); }
  const unsigned vsrc = (unsigned)((tid >> 2) * SEQ + 16 * ((tid & 3) ^ ((tid >> 4) & 3)));
  const char* K8base = (const char*)K8b; const char* Vbase = (const char*)Vt8b;
  auto stage = [&](int jt, int b) {
    const char* tk = K8base + (size_t)jt * (64 * 192); const char* tv = Vbase + (size_t)jt * 64; char* bp = smem + b * BUF + tid * 16;
    { unsigned off = vsrc; asm volatile("" : "+v"(off));
      __builtin_amdgcn_global_load_lds((const unsigned*)(tv + off), LDSP(bp), 16, 0, 0); }
    { unsigned off = ksrc[0]; asm volatile("" : "+v"(off)); __builtin_amdgcn_global_load_lds((const unsigned*)(tk + off), LDSP(bp + VBUF), 16, 0, 0); }
    if (lane < 32) { unsigned off = ksrc[1]; asm volatile("" : "+v"(off)); __builtin_amdgcn_global_load_lds((const unsigned*)(tk + off), LDSP(smem + b * BUF + VBUF + 8192 + wid * 512 + lane * 16), 16, 0, 0); }
  };
#define DSR(dst, addr, OFF) asm volatile("ds_read_b128 %0, %1 offset:%2" : "=&v"(dst) : "v"(addr), "i"(OFF) : "memory")
#define QK_WAIT(n) do { asm volatile("s_waitcnt lgkmcnt(" #n ")" ::: "memory"); SBAR(); } while (0)
#define QK_RD(A0, A1, B0, B1, pb) do { DSR(A0, ka0, (pb) * 64); DSR(A1, ka1, (pb) * 64); DSR(B0, ka0, 32 * KSTR + (pb) * 64); DSR(B1, ka1, 32 * KSTR + (pb) * 64); } while (0)
#define CAT8(X, Y) (i32x8u){(int)(X)[0], (int)(X)[1], (int)(X)[2], (int)(X)[3], (int)(Y)[0], (int)(Y)[1], (int)(Y)[2], (int)(Y)[3]}
#define MF8(A, B, C) __builtin_amdgcn_mfma_scale_f32_32x32x64_f8f6f4((A), (B), (C), 0, 0, 0, 0x7f7f7f7f, 0, 0x7f7f7f7f)
#define EX(i) do { if ((i) < 16) c0[(i) & 15] = __builtin_amdgcn_exp2f(c0[(i) & 15]); else c1[(i) & 15] = __builtin_amdgcn_exp2f(c1[(i) & 15]); } while (0)
#define EX4(i) do { EX(i); EX((i) + 1); EX((i) + 2); EX((i) + 3); } while (0)
#define EX6(i) do { EX4(i); EX((i) + 4); EX((i) + 5); } while (0)
  const int swz = (r32 >> 2) & 3;
  const int kofs0 = r32 * KSTR + (((2 * hi) ^ swz) << 4), kofs1 = r32 * KSTR + (((2 * hi + 1) ^ swz) << 4);
  const int vofs0 = r32 * 64 + (((2 * hi) ^ swz) << 4), vofs1 = r32 * 64 + (((2 * hi + 1) ^ swz) << 4);
  const f32x16 zero = f32x16{};
  auto qkt = [&](int b, f32x16& n0, f32x16& n1) {
    const int kb = (int)(uintptr_t)(smem + b * BUF + VBUF), ka0 = kb + kofs0, ka1 = kb + kofs1;
    u32x4 a0, a1, a2, a3, b0, b1, b2, b3;
    QK_RD(a0, a1, a2, a3, 0); QK_RD(b0, b1, b2, b3, 1);
    QK_WAIT(4); n0 = MF8(CAT8(a0, a1), q8[0], zero); n1 = MF8(CAT8(a2, a3), q8[0], zero); SBAR(); QK_RD(a0, a1, a2, a3, 2);
    QK_WAIT(4); n0 = MF8(CAT8(b0, b1), q8[1], n0); n1 = MF8(CAT8(b2, b3), q8[1], n1); SBAR();
    QK_WAIT(0); n0 = MF8(CAT8(a0, a1), q8[2], n0); n1 = MF8(CAT8(a2, a3), q8[2], n1); SBAR();
  };
  auto finish = [&](f32x16& c0, f32x16& c1, int cur) {
    u32x4 v0a, v0b, v1a, v1b, v2a, v2b, v3a, v3b;
    {
      const int vbs = (int)(uintptr_t)(smem + cur * BUF), va0 = vbs + vofs0, va1 = vbs + vofs1;
      DSR(v0a, va0, 0); DSR(v0b, va1, 0); DSR(v1a, va0, 2048); DSR(v1b, va1, 2048); DSR(v2a, va0, 4096); DSR(v2b, va1, 4096); DSR(v3a, va0, 6144); DSR(v3b, va1, 6144);
      SBAR();
    }
    float ps;
    {
      f32x2 s2 = f32x2{c0[0], c0[1]} + f32x2{c0[2], c0[3]}, s3 = f32x2{c0[4], c0[5]} + f32x2{c0[6], c0[7]}, s4 = f32x2{c0[8], c0[9]} + f32x2{c0[10], c0[11]}, s5 = f32x2{c0[12], c0[13]} + f32x2{c0[14], c0[15]};
      s2 += f32x2{c1[0], c1[1]}; s3 += f32x2{c1[2], c1[3]}; s4 += f32x2{c1[4], c1[5]}; s5 += f32x2{c1[6], c1[7]};
      s2 += f32x2{c1[8], c1[9]}; s3 += f32x2{c1[10], c1[11]}; s4 += f32x2{c1[12], c1[13]}; s5 += f32x2{c1[14], c1[15]};
      s2 = (s2 + s3) + (s4 + s5);
      ps = s2[0] + s2[1];
    }
    l_reg += ps;
    int ei;
    { auto rr = __builtin_amdgcn_permlane32_swap(__float_as_uint(ps), __float_as_uint(ps), false, false);
      ei = __builtin_amdgcn_frexp_expf(__uint_as_float(rr[0]) + __uint_as_float(rr[1])) - 7; }
    const float scl = __uint_as_float((unsigned)(P8_SCL_SIGN * ei + 127) << 23);
    i32x8u pa;
#pragma unroll
    for (int c = 0; c < 4; ++c) {
      s16x2 w0 = {0, 0}, w1 = {0, 0};
      w0 = __builtin_amdgcn_cvt_scalef32_pk_fp8_f32(w0, c0[4 * c], c0[4 * c + 1], scl, false); w0 = __builtin_amdgcn_cvt_scalef32_pk_fp8_f32(w0, c0[4 * c + 2], c0[4 * c + 3], scl, true);
      w1 = __builtin_amdgcn_cvt_scalef32_pk_fp8_f32(w1, c1[4 * c], c1[4 * c + 1], scl, false); w1 = __builtin_amdgcn_cvt_scalef32_pk_fp8_f32(w1, c1[4 * c + 2], c1[4 * c + 3], scl, true);
      auto rr = __builtin_amdgcn_permlane32_swap(__builtin_bit_cast(unsigned, w0), __builtin_bit_cast(unsigned, w1), false, false);
      pa[c] = (int)rr[0]; pa[4 + c] = (int)rr[1];
    }
    const int sc = ei + 127;
    SBAR();
#define PV_MMA(D, X, Y) o[D] = __builtin_amdgcn_mfma_scale_f32_32x32x64_f8f6f4(pa, CAT8(X, Y), o[D], 0, 0, 0, sc, 0, 0x7f7f7f7f)
    QK_WAIT(6); PV_MMA(0, v0a, v0b); QK_WAIT(4); PV_MMA(1, v1a, v1b); QK_WAIT(2); PV_MMA(2, v2a, v2b); QK_WAIT(0); PV_MMA(3, v3a, v3b);
    SBAR();
#undef PV_MMA
  };
#define MLA_SYNC() do { asm volatile("s_waitcnt vmcnt(0) lgkmcnt(0)" ::: "memory"); __builtin_amdgcn_s_barrier(); asm volatile("" ::: "memory"); } while (0)
  auto body = [&](f32x16& c0, f32x16& c1, f32x16& n0, f32x16& n1, int j, int cur) {
    const int nxt = (cur + 1) & 3;
    stage(min(j + 3, NT - 1), (cur + 3) & 3);
    {
      const int kb = (int)(uintptr_t)(smem + nxt * BUF + VBUF), ka0 = kb + kofs0, ka1 = kb + kofs1;
      u32x4 a0, a1, a2, a3, b0, b1, b2, b3;
      QK_RD(a0, a1, a2, a3, 0); QK_RD(b0, b1, b2, b3, 1);
      QK_WAIT(4);
      n0 = MF8(CAT8(a0, a1), q8[0], zero); SBAR(); EX6(0); SBAR();
      n1 = MF8(CAT8(a2, a3), q8[0], zero); SBAR(); EX6(6); SBAR();
      QK_RD(a0, a1, a2, a3, 2);
      QK_WAIT(4);
      n0 = MF8(CAT8(b0, b1), q8[1], n0); SBAR(); EX6(12); SBAR();
      n1 = MF8(CAT8(b2, b3), q8[1], n1); SBAR(); EX6(18); SBAR();
      QK_WAIT(0);
      n0 = MF8(CAT8(a0, a1), q8[2], n0); SBAR(); EX4(24); SBAR();
      n1 = MF8(CAT8(a2, a3), q8[2], n1); SBAR(); EX4(28); SBAR();
    }
    finish(c0, c1, cur);
    asm volatile("" : "+v"(n0), "+v"(n1));
    asm volatile("s_waitcnt vmcnt(3) lgkmcnt(0)" ::: "memory"); __builtin_amdgcn_s_barrier(); asm volatile("" ::: "memory");
  };
  f32x16 A0, A1, B0, B1;
  stage(0, 0);
  if (NT > 1) stage(1, 1);
  if (NT > 2) stage(2, 2);
  MLA_SYNC();
  qkt(0, A0, A1);
  int j = 0, cur = 0;
  for (; j + 2 < NT; j += 2) {
    body(A0, A1, B0, B1, j, cur); cur = (cur + 1) & 3;
    body(B0, B1, A0, A1, j + 1, cur); cur = (cur + 1) & 3;
  }
  if (j + 1 < NT) { body(A0, A1, B0, B1, j, cur); cur = (cur + 1) & 3; A0 = B0; A1 = B1; }
  {
    f32x16& c0 = A0; f32x16& c1 = A1;
#pragma unroll
    for (int r = 0; r < 16; ++r) { const int kl = crow(r, hi); if (kl > tl) c0[r] = -INFINITY; if (kl + 32 > tl) c1[r] = -INFINITY; }
#pragma unroll
    for (int r = 0; r < 16; ++r) { c0[r] = __builtin_amdgcn_exp2f(c0[r]); c1[r] = __builtin_amdgcn_exp2f(c1[r]); }
    finish(c0, c1, cur);
  }
  asm volatile("s_waitcnt vmcnt(0)" ::: "memory");
  { auto rr = __builtin_amdgcn_permlane32_swap(__float_as_uint(l_reg), __float_as_uint(l_reg), false, false); l_reg = __uint_as_float(rr[0]) + __uint_as_float(rr[1]); }
  if (hi == 0) li_l[r32] = l_reg;
  asm volatile("s_waitcnt lgkmcnt(0)" ::: "memory");
  {
    int lo = hi * (4 * 512) + r32; asm volatile("" : "+v"(lo));
    bf16_t* Op = Ow + lo;
#pragma unroll
    for (int r = 0; r < 16; ++r) {
      const float rl = __builtin_amdgcn_rcpf(li_l[crow(r, hi)]);
#pragma unroll
      for (int d = 0; d < NDB; ++d) Op[((r & 3) + 8 * (r >> 2)) * 512 + d * 32] = f2bf(o[d][r] * rl);
    }
  }
  __syncthreads();
#undef MLA_SYNC
#undef DSR
#undef QK_WAIT
#undef CAT8
#undef MF8
#undef EX
#undef EX4
#undef EX6
#undef QK_RD
}

typedef int i32x8 __attribute__((ext_vector_type(8)));
DI void mla_phase(const Params& p, char* smem) {
  const int tid = threadIdx.x, wid = __builtin_amdgcn_readfirstlane(tid >> 6), lane = tid & 63, r32 = lane & 31, hi = lane >> 5;
#ifndef MLA_REPS
#define MLA_REPS 1
#endif
  for (int kk = blockIdx.x; kk < 256 * MLA_REPS; kk += gridDim.x) {
    const int k = kk & 255;
#pragma unroll 1
    for (int half = 0; half < 2; ++half) {
      const int b = k & 1, i0 = k >> 1, i = half ? (255 - i0) : i0;
      const int head = wid >> 1, tq = i * 64 + (wid & 1) * 32 + r32;
      const size_t trow = (size_t)b * SEQ + tq;
      i32x8 q8[3];
      const bf16_t* qrow = p.qcat + trow * 768 + head * 192;
      auto pack4 = [](float a, float b, float c, float d) -> int { int w = 0; w = __builtin_amdgcn_cvt_pk_fp8_f32(a, b, w, false); w = __builtin_amdgcn_cvt_pk_fp8_f32(c, d, w, true); return w; };
#pragma unroll
      for (int pb = 0; pb < 2; ++pb) {
        const bf16_t* qp = qrow + 64 * pb + 32 * hi;
#pragma unroll
        for (int c = 0; c < 4; ++c) { const bf16x8 x = *(const bf16x8*)(qp + 8 * c);
          q8[pb][2 * c] = pack4(bf2f((bf16_t)x[0]), bf2f((bf16_t)x[1]), bf2f((bf16_t)x[2]), bf2f((bf16_t)x[3]));
          q8[pb][2 * c + 1] = pack4(bf2f((bf16_t)x[4]), bf2f((bf16_t)x[5]), bf2f((bf16_t)x[6]), bf2f((bf16_t)x[7])); }
      }
      {
        const float* rp = p.rope + trow * 64;
#pragma unroll
        for (int c = 0; c < 4; ++c) {
          const bf16x8 x1 = *(const bf16x8*)(qrow + 128 + 8 * c), x2 = *(const bf16x8*)(qrow + 160 + 8 * c);
          float v[8];
#pragma unroll
          for (int j = 0; j < 8; ++j) {
            const f32x2 cs = *(const f32x2*)(rp + 2 * (8 * c + j));
            const float a1 = bf2f((bf16_t)x1[j]), a2 = bf2f((bf16_t)x2[j]);
            v[j] = hi ? (a2 * cs[0] + a1 * cs[1]) : (a1 * cs[0] - a2 * cs[1]);
          }
          q8[2][2 * c] = pack4(v[0], v[1], v[2], v[3]); q8[2][2 * c + 1] = pack4(v[4], v[5], v[6], v[7]);
        }
      }
      mla_unit(q8, p.k8 + (size_t)b * SEQ * 192, p.vt8 + (size_t)b * SEQ * 128, i + 1, tq & 63, p.olat + ((size_t)b * SEQ + i * 64 + (wid & 1) * 32) * 512 + head * 128, smem);
    }
  }
}

DI void swa_phase(const Params& p, char* smem) {
  constexpr int KSTR = 144, KBUF = 64 * KSTR, VBUF = 64 * 64 * 2, BUF = KBUF + VBUF, NDB = 2;
  const int tid = threadIdx.x, wid = __builtin_amdgcn_readfirstlane(tid >> 6), lane = tid & 63, r32 = lane & 31, hi = lane >> 5;
  float* wsf = (float*)(smem + 6 * BUF) + wid * 64; float* li_l = wsf; float* al_l = wsf + 32;
  const int srow = tid >> 3, c8 = tid & 7;
  const int vb0 = (int)(uintptr_t)smem + v_rd_base(lane);
  for (int u = blockIdx.x; u < 256; u += gridDim.x) {
    const int kvh = u & 1, i = (u >> 1) & 63, b = u >> 7;
    const int jt0 = (i == 0) ? 0 : (4 * i - 2), NT = 4 * i + 4 - jt0;
    const bf16_t* Kb = p.ks + (size_t)b * SEQ * 128 + kvh * 64; const bf16_t* Vb = p.vs + (size_t)b * SEQ * 128 + kvh * 64;
    {
      bf16x8 kst[6], vst[6];
#pragma unroll
      for (int j = 0; j < 6; ++j) if (j < NT) { const size_t krow = (size_t)((jt0 + j) * 64 + srow) * 128 + 8 * c8; kst[j] = *(const bf16x8*)(Kb + krow); vst[j] = *(const bf16x8*)(Vb + krow); }
#pragma unroll
      for (int j = 0; j < 6; ++j) if (j < NT) { char* bp = smem + j * BUF; *(bf16x8*)(bp + VBUF + srow * KSTR + 16 * c8) = kst[j]; *(bf16x8*)(bp + v_st<NDB>(srow, 8 * c8)) = vst[j]; }
    }
    __syncthreads();
    const int tw0 = i * 256 + wid * 32, tq = tw0 + r32;
    const size_t trow = (size_t)b * SEQ + tq;
#pragma unroll 1
    for (int g = 0; g < 4; ++g) {
      const int h = kvh * 4 + g;
      bf16x8 qr[4];
      const bf16_t* qp = p.qs + trow * 512 + h * 64 + hi * 8;
#pragma unroll
      for (int s = 0; s < 4; ++s) qr[s] = *(const bf16x8*)(qp + s * 16);
      const float slope2 = exp2f(-(float)(h + 1)) * LOG2E, sink2 = p.swa_sinks[h] * LOG2E;
      float m_reg = -1e30f, l_reg = 0.f; f32x16 o[NDB];
#pragma unroll
      for (int d = 0; d < NDB; ++d) o[d] = f32x16{};
      for (int j = 0; j < NT; ++j) {
        const int jt = jt0 + j;
        if (!((jt * 64 + 63 >= tw0 - 127) && (jt * 64 <= tw0 + 31))) continue;
        f32x16 p0 = f32x16{}, p1 = f32x16{};
        const char* Kc = smem + j * BUF + VBUF + r32 * KSTR + hi * 16;
#pragma unroll
        for (int s = 0; s < 4; ++s) {
          const bf16x8 b0 = *(const bf16x8*)(Kc + s * 32), b1 = *(const bf16x8*)(Kc + 32 * KSTR + s * 32);
          p0 = MFMA32(b0, qr[s], p0); p1 = MFMA32(b1, qr[s], p1);
        }
#pragma unroll
        for (int r = 0; r < 16; ++r) {
          const int d0 = tq - (jt * 64 + crow(r, hi)), d1 = d0 - 32;
          p0[r] = (d0 >= 0 && d0 < 128) ? p0[r] - slope2 * (float)d0 : -INFINITY;
          p1[r] = (d1 >= 0 && d1 < 128) ? p1[r] - slope2 * (float)d1 : -INFINITY;
        }
        float pmax = p0[0];
#pragma unroll
        for (int r = 1; r < 16; ++r) pmax = fmaxf(pmax, p0[r]);
#pragma unroll
        for (int r = 0; r < 16; ++r) pmax = fmaxf(pmax, p1[r]);
        { auto rr = __builtin_amdgcn_permlane32_swap(__float_as_uint(pmax), __float_as_uint(pmax), false, false); pmax = fmaxf(__uint_as_float(rr[0]), __uint_as_float(rr[1])); }
        float mn, alpha;
        if (__all(pmax - m_reg <= SM_THR)) { mn = m_reg; alpha = 1.f; }
        else { mn = fmaxf(m_reg, pmax); alpha = __builtin_amdgcn_exp2f(m_reg - mn); m_reg = mn; }
#pragma unroll
        for (int r = 0; r < 16; ++r) { p0[r] = __builtin_amdgcn_exp2f(p0[r] - mn); p1[r] = __builtin_amdgcn_exp2f(p1[r] - mn); }
        float ps = 0.f;
#pragma unroll
        for (int r = 0; r < 16; ++r) ps += p0[r] + p1[r];
        { auto rr = __builtin_amdgcn_permlane32_swap(__float_as_uint(ps), __float_as_uint(ps), false, false); ps = __uint_as_float(rr[0]) + __uint_as_float(rr[1]); }
        l_reg = l_reg * alpha + ps;
        if (__any(alpha < 1.f)) {
          if (hi == 0) al_l[r32] = alpha;
          asm volatile("s_waitcnt lgkmcnt(0)" ::: "memory");
#pragma unroll
          for (int r = 0; r < 16; ++r) { const float al = al_l[crow(r, hi)];
#pragma unroll
            for (int d = 0; d < NDB; ++d) o[d][r] *= al; }
        }
        bf16x8 pa0, pa1, pa2, pa3;
#define PK4(P, BASE, OUT) do { const unsigned a0 = pk2(P[BASE + 0], P[BASE + 1]), a1 = pk2(P[BASE + 2], P[BASE + 3]);   \
        const unsigned b0_ = pk2(P[BASE + 4], P[BASE + 5]), b1_ = pk2(P[BASE + 6], P[BASE + 7]);                          \
        auto r0 = __builtin_amdgcn_permlane32_swap(a0, b0_, false, false); auto r1 = __builtin_amdgcn_permlane32_swap(a1, b1_, false, false); \
        u32x4 w = {r0[0], r1[0], r0[1], r1[1]}; OUT = __builtin_bit_cast(bf16x8, w); } while (0)
        PK4(p0, 0, pa0); PK4(p0, 8, pa1); PK4(p1, 0, pa2); PK4(p1, 8, pa3);
#undef PK4
        const int vb = vb0 + j * BUF;
        pv_one<NDB, 0>(o[0], vb, pa0, pa1, pa2, pa3);
        pv_one<NDB, 1>(o[1], vb, pa0, pa1, pa2, pa3);
      }
      l_reg += __builtin_amdgcn_exp2f(sink2 - m_reg);
      if (hi == 0) li_l[r32] = l_reg;
      asm volatile("s_waitcnt lgkmcnt(0)" ::: "memory");
      bf16_t* Ow = p.ob + ((size_t)b * SEQ + tw0) * 512 + h * 64;
#pragma unroll
      for (int r = 0; r < 16; ++r) {
        const int orow = crow(r, hi); const float rl = __builtin_amdgcn_rcpf(li_l[orow]);
#pragma unroll
        for (int d = 0; d < NDB; ++d) Ow[(size_t)orow * 512 + d * 32 + r32] = f2bf(o[d][r] * rl);
      }
      asm volatile("s_waitcnt lgkmcnt(0)" ::: "memory");
    }
    __syncthreads();
  }
}

DI void xattn_phase(const Params& p, char* smem) {
  const int tid = threadIdx.x, wid = __builtin_amdgcn_readfirstlane(tid >> 6), lane = tid & 63, r32 = lane & 31, hi = lane >> 5;
  for (int u = blockIdx.x; u < 512; u += gridDim.x) {
    const int h = u & 3, i = (u >> 2) & 63, b = u >> 8;
    const int tq = i * 256 + wid * 32 + r32;
    const size_t trow = (size_t)b * SEQ + tq;
    bf16x8 qr[8];
    const bf16_t* qp = p.qx + trow * 512 + h * 128 + hi * 8;
#pragma unroll
    for (int s = 0; s < 8; ++s) qr[s] = *(const bf16x8*)(qp + s * 16);
    AttnArgs<128, 128, 1> a;
    a.Kb = p.kvc + (size_t)b * 256 * 1024 + h * 128; a.ldk = 1024; a.Vb = a.Kb + 512; a.ldv = 1024;
    a.jt0 = 0; a.NT = 4; a.tq = tq; a.diag_tile = -1; a.tw0 = 0; a.slope2 = 0.f; a.sink2 = 0.f;
    a.Ow = p.ox + ((size_t)b * SEQ + i * 256 + wid * 32) * 512 + h * 128; a.ldo = 512;
    attn_unit<128, 128, 1, 0>(qr, a, smem);
  }
}

DI void norm_rows_1024(const float* in, const float* gain, bf16_t* out, int nrows) {
  const int gt_ = GTID(), lane = gt_ & 63, gw = gt_ >> 6, nw = gridDim.x * (NTHREADS / 64);
  for (int t = gw; t < nrows; t += nw) {
    const float* xr = in + (size_t)t * 1024;
    f32x4 v[4]; float ss = 0.f;
#pragma unroll
    for (int i = 0; i < 4; ++i) { v[i] = *(const f32x4*)(xr + 256 * i + 4 * lane); ss += v[i][0] * v[i][0] + v[i][1] * v[i][1] + v[i][2] * v[i][2] + v[i][3] * v[i][3]; }
    ss = wave_sum(ss);
    const float rstd = rsqrtf(ss * (1.0f / 1024.0f) + EPS);
#pragma unroll
    for (int i = 0; i < 4; ++i) {
      const f32x4 g = *(const f32x4*)(gain + 256 * i + 4 * lane);
      u32x2 w = {pk2(v[i][0] * rstd * g[0], v[i][1] * rstd * g[1]), pk2(v[i][2] * rstd * g[2], v[i][3] * rstd * g[3])};
      *(u32x2*)(out + (size_t)t * 1024 + 256 * i + 4 * lane) = w;
    }
  }
}

DI void norm_rows_bf16(const bf16_t* in, const float* gain, bf16_t* out, int nrows) {
  const int gt_ = GTID(), lane = gt_ & 63, gw = gt_ >> 6, nw = gridDim.x * (NTHREADS / 64);
  for (int t = gw; t < nrows; t += nw) {
    const bf16_t* xr = in + (size_t)t * 1024 + 8 * lane;
    float v[16]; float ss = 0.f;
#pragma unroll
    for (int i = 0; i < 2; ++i) { const u32x4 w = *(const u32x4*)(xr + 512 * i);
#pragma unroll
      for (int j = 0; j < 4; ++j) { v[8 * i + 2 * j] = bflo(w[j]); v[8 * i + 2 * j + 1] = bfhi(w[j]); } }
#pragma unroll
    for (int j = 0; j < 16; ++j) ss += v[j] * v[j];
    ss = wave_sum(ss);
    const float rstd = rsqrtf(ss * (1.0f / 1024.0f) + EPS);
#pragma unroll
    for (int i = 0; i < 2; ++i) {
      const f32x4 g0 = *(const f32x4*)(gain + 512 * i + 8 * lane), g1 = *(const f32x4*)(gain + 512 * i + 8 * lane + 4);
      *(u32x4*)(out + (size_t)t * 1024 + 512 * i + 8 * lane) = u32x4{pk2(v[8 * i] * rstd * g0[0], v[8 * i + 1] * rstd * g0[1]), pk2(v[8 * i + 2] * rstd * g0[2], v[8 * i + 3] * rstd * g0[3]),
                                                                    pk2(v[8 * i + 4] * rstd * g1[0], v[8 * i + 5] * rstd * g1[1]), pk2(v[8 * i + 6] * rstd * g1[2], v[8 * i + 7] * rstd * g1[3])};
    }
  }
}

DI void latent_pass(const Params& p, char* smem) {
  const int tid = threadIdx.x, lane = tid & 63, wid = __builtin_amdgcn_readfirstlane(tid >> 6);
  unsigned char* st = (unsigned char*)smem;
  for (int tile = blockIdx.x; tile < T / 64; tile += gridDim.x) {
#pragma unroll 2
    for (int i = 0; i < 8; ++i) {
      const int tk = wid * 8 + i, t = tile * 64 + tk;
      const bf16_t* lr = p.lat + (size_t)t * 448;
      const u32x2 cq = *(const u32x2*)(lr + 4 * lane);
      const float q0 = bflo(cq[0]), q1 = bfhi(cq[0]), q2 = bflo(cq[1]), q3 = bfhi(cq[1]);
      const float ssq = wave_sum(q0 * q0 + q1 * q1 + q2 * q2 + q3 * q3);
      const float rq = rsqrtf(ssq * (1.0f / 256.0f) + EPS);
      const f32x4 gq = *(const f32x4*)(p.q_a_norm + 4 * lane);
      *(u32x2*)(p.cqn + (size_t)t * 256 + 4 * lane) = u32x2{pk2(q0 * rq * gq[0], q1 * rq * gq[1]), pk2(q2 * rq * gq[2], q3 * rq * gq[3])};
      const unsigned ck = *(const unsigned*)(lr + 256 + 2 * lane);
      const float k0 = bflo(ck), k1 = bfhi(ck);
      const float ssk = wave_sum(k0 * k0 + k1 * k1);
      const float rk = rsqrtf(ssk * (1.0f / 128.0f) + EPS);
      const f32x2 gk = *(const f32x2*)(p.kv_a_norm + 2 * lane);
      const float kn0 = k0 * rk * gk[0], kn1 = k1 * rk * gk[1];
      unsigned char* k8r = p.k8 + (size_t)t * 192;
      *(unsigned short*)(k8r + 2 * lane) = (unsigned short)__builtin_amdgcn_cvt_pk_fp8_f32(kn0 * 0.125f, kn1 * 0.125f, 0, false);
      *(unsigned short*)(st + tk * 128 + 2 * lane) = (unsigned short)__builtin_amdgcn_cvt_pk_fp8_f32(kn0, kn1, 0, false);
      if (lane < 32) {
        const float x1 = bf2f(lr[384 + lane]), x2 = bf2f(lr[416 + lane]);
        const f32x2 cs = *(const f32x2*)(p.rope + (size_t)t * 64 + 2 * lane);
        const float r1 = x1 * cs[0] - x2 * cs[1], r2 = x2 * cs[0] + x1 * cs[1];
        const int pk = __builtin_amdgcn_cvt_pk_fp8_f32(r1 * 0.125f, r2 * 0.125f, 0, false);
        k8r[128 + lane] = (unsigned char)(pk & 0xff); k8r[160 + lane] = (unsigned char)((pk >> 8) & 0xff);
      }
    }
    __syncthreads();
    {
      const int d = tid >> 2, part = tid & 3, k0 = 32 * (part >> 1) + 4 * (part & 1);
      unsigned w[4];
#pragma unroll
      for (int c = 0; c < 4; ++c) {
        unsigned v = 0;
#pragma unroll
        for (int e = 0; e < 4; ++e) v |= (unsigned)st[(k0 + e + 8 * c) * 128 + d] << (8 * e);
        w[c] = v;
      }
      const int t0 = tile * 64, b = t0 / SEQ, s0 = t0 - b * SEQ;
      *(u32x4*)(p.vt8 + ((size_t)b * 128 + d) * SEQ + s0 + 16 * part) = u32x4{w[0], w[1], w[2], w[3]};
    }
    __syncthreads();
  }
}

DI void mix_pass(const Params& p) {
  const int gt_ = GTID(), lane = gt_ & 63, gw = gt_ >> 6, nw = gridDim.x * (NTHREADS / 64);
  for (int t = gw; t < T; t += nw) {
#pragma unroll
    for (int part = 0; part < 2; ++part) {
      const bf16_t* src = (part ? p.ob : p.oa) + (size_t)t * 512 + 8 * lane;
      const float* g = (part ? p.out_norm_swa : p.out_norm_mla) + 8 * lane;
      const u32x4 w = *(const u32x4*)src;
      float v[8] = {bflo(w[0]), bfhi(w[0]), bflo(w[1]), bfhi(w[1]), bflo(w[2]), bfhi(w[2]), bflo(w[3]), bfhi(w[3])};
      float ss = 0.f;
#pragma unroll
      for (int j = 0; j < 8; ++j) ss += v[j] * v[j];
      ss = wave_sum(ss);
      const float rs = rsqrtf(ss * (1.0f / 512.0f) + EPS);
      const f32x4 g0 = *(const f32x4*)g, g1 = *(const f32x4*)(g + 4);
      u32x4 o = {pk2(v[0] * rs * g0[0], v[1] * rs * g0[1]), pk2(v[2] * rs * g0[2], v[3] * rs * g0[3]), pk2(v[4] * rs * g1[0], v[5] * rs * g1[1]), pk2(v[6] * rs * g1[2], v[7] * rs * g1[3])};
      *(u32x4*)(p.xn + (size_t)t * 1024 + part * 512 + 8 * lane) = o;
    }
  }
}

DI float gelu_exact(float x) { return 0.5f * x * (1.0f + erff(x * 0.70710678118654752f)); }
DI float wave_max(float v) {
#pragma unroll
  for (int o = 32; o >= 1; o >>= 1) v = fmaxf(v, __shfl_xor(v, o));
  return v;
}
DI void peer_pass(const Params& p, float* outbuf, int rowmask) {
  const int gt_ = GTID(), lane = gt_ & 63, gw = gt_ >> 6, nw = gridDim.x * (NTHREADS / 64);
  const int b5 = (lane >> 5) & 1, b4 = (lane >> 4) & 1, b3 = (lane >> 3) & 1, b2 = (lane >> 2) & 1, kL = (lane >> 2) & 15;
  for (int t = gw; t < T; t += nw) {
    const bf16_t* hr = p.xn + (size_t)t * 1024 + 16 * lane;
    const u32x4 ha = *(const u32x4*)hr, hb = *(const u32x4*)(hr + 8);
    float hv[16];
#pragma unroll
    for (int j = 0; j < 4; ++j) { const unsigned wa = ha[j], wb = hb[j]; hv[2 * j] = bflo(wa); hv[2 * j + 1] = bfhi(wa); hv[8 + 2 * j] = bflo(wb); hv[8 + 2 * j + 1] = bfhi(wb); }
    float hm = 0.f;
#pragma unroll
    for (int j = 0; j < 16; ++j) hm = fmaxf(hm, fabsf(hv[j]));
    hm = fmaxf(wave_max(hm), 1e-20f);
    const float sh = hm * (1.0f / 127.0f), ih = 127.0f / hm;
    int hq[4];
#pragma unroll
    for (int q = 0; q < 4; ++q) {
      const int q0 = (int)rintf(hv[4 * q] * ih), q1 = (int)rintf(hv[4 * q + 1] * ih), q2 = (int)rintf(hv[4 * q + 2] * ih), q3 = (int)rintf(hv[4 * q + 3] * ih);
      hq[q] = (q0 & 255) | ((q1 & 255) << 8) | ((q2 & 255) << 16) | (q3 << 24);
    }
    const int e0 = p.pidx[(size_t)t * 128 + lane], e1 = p.pidx[(size_t)t * 128 + 64 + lane];
    const float su0 = p.su[2 * e0] * sh, su1 = p.su[2 * e1] * sh;
    const float gv0 = p.pg[(size_t)t * 128 + lane] * p.su[2 * e0 + 1], gv1 = p.pg[(size_t)t * 128 + 64 + lane] * p.su[2 * e1 + 1];
    float acc[16];
#pragma unroll
    for (int j = 0; j < 16; ++j) acc[j] = 0.f;
    float csum = 0.f;
#pragma unroll 1
    for (int hd = 0; hd < 8; ++hd) {
      const int esel = (hd < 4) ? e0 : e1;
      const int lbase = (hd & 3) * 16;
      u32x4 ub[16], vb[16];
#pragma unroll
      for (int k = 0; k < 16; ++k) {
        const int idx = __builtin_amdgcn_readlane(esel, lbase + k);
        ub[k] = *(const u32x4*)(p.u_q + (size_t)idx * 1024 + 16 * lane);
        vb[k] = *(const u32x4*)(p.v_q + (size_t)idx * 1024 + 16 * lane);
      }
      int pd[16];
#pragma unroll
      for (int k = 0; k < 16; ++k) {
        int d = 0;
#pragma unroll
        for (int q = 0; q < 4; ++q) { const int a = (int)ub[k][q]; d = __builtin_amdgcn_sdot4(a, hq[q], d, false); }
        pd[k] = d;
      }
      int q8[8], q4[4], q2[2], q1;
#pragma unroll
      for (int k = 0; k < 8; ++k) { const int keep = b5 ? pd[k + 8] : pd[k], send = b5 ? pd[k] : pd[k + 8]; q8[k] = keep + __shfl_xor(send, 32); }
#pragma unroll
      for (int k = 0; k < 4; ++k) { const int keep = b4 ? q8[k + 4] : q8[k], send = b4 ? q8[k] : q8[k + 4]; q4[k] = keep + __shfl_xor(send, 16); }
#pragma unroll
      for (int k = 0; k < 2; ++k) { const int keep = b3 ? q4[k + 2] : q4[k], send = b3 ? q4[k] : q4[k + 2]; q2[k] = keep + __shfl_xor(send, 8); }
      { const int keep = b2 ? q2[1] : q2[0], send = b2 ? q2[0] : q2[1]; q1 = keep + __shfl_xor(send, 4); }
      q1 += __shfl_xor(q1, 2); q1 += __shfl_xor(q1, 1);
      const float suk = __shfl((hd < 4) ? su0 : su1, lbase + kL), gvk = __shfl((hd < 4) ? gv0 : gv1, lbase + kL);
      const float dtot = (float)q1 * suk;
      const float c = DBG_PEER * gvk * gelu_exact(dtot);
#pragma unroll
      for (int k = 0; k < 16; ++k) {
        const float ck = __uint_as_float(__builtin_amdgcn_readlane(__float_as_uint(c), 4 * k));
        csum += ck;
#pragma unroll
        for (int q = 0; q < 4; ++q) {
          const unsigned w = vb[k][q];
          acc[4 * q] += ck * (float)(w & 0xff); acc[4 * q + 1] += ck * (float)((w >> 8) & 0xff); acc[4 * q + 2] += ck * (float)((w >> 16) & 0xff); acc[4 * q + 3] += ck * (float)(w >> 24);
        }
      }
    }
    const float* xr = p.X + (size_t)t * 1024 + 16 * lane; float* orow = outbuf + (size_t)(t & rowmask) * 1024 + 16 * lane;
    float y[16]; float ss = 0.f;
#pragma unroll
    for (int q = 0; q < 4; ++q) {
      const f32x4 xv = *(const f32x4*)(xr + 4 * q);
#pragma unroll
      for (int j = 0; j < 4; ++j) { const float v = xv[j] + (acc[4 * q + j] - 128.0f * csum); y[4 * q + j] = v; ss += v * v; }
    }
    ss = wave_sum(ss);
    const float rstd = rsqrtf(ss * (1.0f / 1024.0f) + EPS);
#pragma unroll
    for (int q = 0; q < 4; ++q) {
      const f32x4 g = *(const f32x4*)(p.norm_final + 16 * lane + 4 * q);
      f32x4 ov;
#pragma unroll
      for (int j = 0; j < 4; ++j) ov[j] = y[4 * q + j] * rstd * g[j];
      *(f32x4*)(orow + 4 * q) = ov;
    }
  }
}

DI void norm_rows_ffn(const Params& p) {
  const int gt_ = GTID(), lane = gt_ & 63, gw = gt_ >> 6, nw = gridDim.x * (NTHREADS / 64);
  for (int t = gw; t < T; t += nw) {
    const bf16_t* xr = p.X16 + (size_t)t * 1024;
    f32x4 v[4]; float ss = 0.f;
#pragma unroll
    for (int i = 0; i < 4; ++i) { const u32x2 w = *(const u32x2*)(xr + 256 * i + 4 * lane); v[i] = f32x4{bflo(w[0]), bfhi(w[0]), bflo(w[1]), bfhi(w[1])};
      ss += v[i][0] * v[i][0] + v[i][1] * v[i][1] + v[i][2] * v[i][2] + v[i][3] * v[i][3]; }
    ss = wave_sum(ss);
    const float rstd = rsqrtf(ss * (1.0f / 1024.0f) + EPS);
    float hm = 0.f;
#pragma unroll
    for (int i = 0; i < 4; ++i) {
      const f32x4 g = *(const f32x4*)(p.norm_ffn + 256 * i + 4 * lane);
#pragma unroll
      for (int j = 0; j < 4; ++j) { v[i][j] = v[i][j] * rstd * g[j]; hm = fmaxf(hm, fabsf(v[i][j])); }
      *(u32x2*)(p.xn + (size_t)t * 1024 + 256 * i + 4 * lane) = u32x2{pk2(v[i][0], v[i][1]), pk2(v[i][2], v[i][3])};
    }
    hm = fmaxf(wave_max(hm), 1e-20f);
    const float ih = 127.0f / hm;
#pragma unroll
    for (int i = 0; i < 4; ++i) {
      const int q0 = (int)rintf(v[i][0] * ih), q1 = (int)rintf(v[i][1] * ih), q2 = (int)rintf(v[i][2] * ih), q3 = (int)rintf(v[i][3] * ih);
      *(unsigned*)(p.hq + (size_t)t * 1024 + 256 * i + 4 * lane) = (unsigned)(q0 & 255) | ((unsigned)(q1 & 255) << 8) | ((unsigned)(q2 & 255) << 16) | ((unsigned)q3 << 24);
    }
    if (lane == 0) p.sh[t] = hm * (1.0f / 127.0f);
  }
}
DI void peer_dots(const Params& p) {
  const int lane = threadIdx.x & 63, wid = threadIdx.x >> 6, xs = (blockIdx.x & 7) >> 1, r = lane >> 3, ch = lane & 7;
  const int wp = ((blockIdx.x >> 3) * 2 + (blockIdx.x & 1)) * (NTHREADS / 64) + wid, nwp = (gridDim.x >> 2) * (NTHREADS / 64);
  const int b0 = lane & 1, b1 = (lane >> 1) & 1, b2 = (lane >> 2) & 1;
  int* dp = p.dpartA + (size_t)xs * T * 128;
  const unsigned char* ub = p.u_q + 128 * xs + 16 * ch;
  typedef int i32x2 __attribute__((ext_vector_type(2)));
  i32x4 iv[4]; u32x4 hlo, hhi;
  if (wp < T) {
    const int* ip = p.pidx + (size_t)wp * 128 + 16 * r;
#pragma unroll
    for (int q = 0; q < 4; ++q) iv[q] = *(const i32x4*)(ip + 4 * q);
    const unsigned char* hp = p.hq + (size_t)wp * 1024 + 256 * xs + 32 * ch;
    hlo = *(const u32x4*)hp; hhi = *(const u32x4*)(hp + 16);
  }
  for (int t = wp; t < T; t += nwp) {
    u32x4 uv[16];
#pragma unroll
    for (int g = 0; g < 16; ++g) uv[g] = *(const u32x4*)(ub + (size_t)iv[g >> 2][g & 3] * 512);
    int hl[4], hh[4];
#pragma unroll
    for (int q = 0; q < 4; ++q) { hl[q] = (int)hlo[q]; hh[q] = (int)hhi[q]; }
    int hsum = 0;
#pragma unroll
    for (int q = 0; q < 4; ++q) { hsum = __builtin_amdgcn_sdot4(hl[q], 0x01010101, hsum, false); hsum = __builtin_amdgcn_sdot4(hh[q], 0x01010101, hsum, false); }
    const int tn = (t + nwp < T) ? t + nwp : t;
    {
      const int* ip = p.pidx + (size_t)tn * 128 + 16 * r;
#pragma unroll
      for (int q = 0; q < 4; ++q) iv[q] = *(const i32x4*)(ip + 4 * q);
      const unsigned char* hp = p.hq + (size_t)tn * 1024 + 256 * xs + 32 * ch;
      hlo = *(const u32x4*)hp; hhi = *(const u32x4*)(hp + 16);
    }
    int v[16];
#pragma unroll
    for (int g = 0; g < 16; ++g) {
      int d = -8 * hsum;
#pragma unroll
      for (int q = 0; q < 4; ++q) {
        const unsigned w = uv[g][q]; const int lo = (int)(w & 0x0F0F0F0Fu), hi = (int)((w >> 4) & 0x0F0F0F0Fu);
        d = __builtin_amdgcn_sdot4(lo, hl[q], d, false); d = __builtin_amdgcn_sdot4(hi, hh[q], d, false);
      }
      v[g] = d;
    }
    int w8[8], w4[4], w2[2];
#pragma unroll
    for (int k = 0; k < 8; ++k) { const int keep = b2 ? v[k + 8] : v[k], send = b2 ? v[k] : v[k + 8]; w8[k] = keep + __shfl_xor(send, 4); }
#pragma unroll
    for (int k = 0; k < 4; ++k) { const int keep = b1 ? w8[k + 4] : w8[k], send = b1 ? w8[k] : w8[k + 4]; w4[k] = keep + __shfl_xor(send, 2); }
#pragma unroll
    for (int k = 0; k < 2; ++k) { const int keep = b0 ? w4[k + 2] : w4[k], send = b0 ? w4[k] : w4[k + 2]; w2[k] = keep + __shfl_xor(send, 1); }
    *(i32x2*)(dp + (size_t)t * 128 + 16 * r + 2 * ch) = i32x2{w2[0], w2[1]};
  }
}
DI void peer_coef(const Params& p) {
  const size_t n = (size_t)T * 128;
  for (size_t it = (size_t)GTID(); it < n; it += (size_t)gridDim.x * NTHREADS) {
    int d = 0;
#pragma unroll
    for (int x = 0; x < 4; ++x) d += p.dpartA[(size_t)x * n + it];
    const int e = p.pidx[it];
    const f32x2 sc2 = *(const f32x2*)(p.su + 2 * (size_t)e);
    const float dt = (float)d * sc2[0] * p.sh[it >> 7];
    p.cbuf[it] = DBG_PEER * p.pg[it] * gelu_exact(dt) * sc2[1];
  }
}
DI void peer_accum(const Params& p, bf16_t* Xout, int rowmask) {
  const int lane = threadIdx.x & 63, wid = threadIdx.x >> 6, xs = (blockIdx.x & 7) >> 1, r = lane >> 3, ch = lane & 7;
  const int wp = ((blockIdx.x >> 3) * 2 + (blockIdx.x & 1)) * (NTHREADS / 64) + wid, nwp = (gridDim.x >> 2) * (NTHREADS / 64);
  const int b3 = (lane >> 3) & 1, b4 = (lane >> 4) & 1, b5 = (lane >> 5) & 1;
  const unsigned char* vbp = p.v_q + 128 * xs + 16 * ch;
  const size_t xoff = (size_t)256 * xs + 32 * ch + 4 * r;
  if (wp >= T) return;
  i32x4 ivA[2], ivB[2]; f32x4 cvA[4], cvN[4]; i32x4 ivN[4];
  u32x4 ra[8], rb[8];
  u32x2 xv, xvN;
#define LOAD_META(tt, IV, CV) do { const int* ip_ = p.pidx + (size_t)(tt) * 128 + 16 * r; const float* cp_ = p.cbuf + (size_t)(tt) * 128 + 16 * r; \
    _Pragma("unroll") for (int q_ = 0; q_ < 4; ++q_) { IV[q_] = *(const i32x4*)(ip_ + 4 * q_); CV[q_] = *(const f32x4*)(cp_ + 4 * q_); } } while (0)
#define LOAD_ROWS(R, I0, I1) do { _Pragma("unroll") for (int g_ = 0; g_ < 4; ++g_) { R[g_] = *(const u32x4*)(vbp + (size_t)I0[g_] * 512); R[4 + g_] = *(const u32x4*)(vbp + (size_t)I1[g_] * 512); } } while (0)
#define ACCUM(R, C0, C1) do { _Pragma("unroll") for (int g_ = 0; g_ < 8; ++g_) { const float cg_ = (g_ < 4) ? C0[g_ & 3] : C1[g_ & 3]; const f32x2 cgv_ = {cg_, cg_}; \
    _Pragma("unroll") for (int q_ = 0; q_ < 4; ++q_) { const unsigned w_ = R[g_][q_]; \
      acc2[4 * q_] += cgv_ * __builtin_amdgcn_cvt_scalef32_pk_f32_fp4(w_, 1.0f, 0); acc2[4 * q_ + 1] += cgv_ * __builtin_amdgcn_cvt_scalef32_pk_f32_fp4(w_, 1.0f, 1); \
      acc2[4 * q_ + 2] += cgv_ * __builtin_amdgcn_cvt_scalef32_pk_f32_fp4(w_, 1.0f, 2); acc2[4 * q_ + 3] += cgv_ * __builtin_amdgcn_cvt_scalef32_pk_f32_fp4(w_, 1.0f, 3); } \
    SBAR(); } } while (0)
  LOAD_META(wp, ivN, cvN);
  ivA[0] = ivN[0]; ivA[1] = ivN[1]; ivB[0] = ivN[2]; ivB[1] = ivN[3];
#pragma unroll
  for (int q = 0; q < 4; ++q) cvA[q] = cvN[q];
  LOAD_ROWS(ra, ivA[0], ivA[1]);
  xv = *(const u32x2*)(p.X16 + (size_t)wp * 1024 + xoff);
  for (int t = wp; t < T; t += nwp) {
    const int tn = (t + nwp < T) ? t + nwp : t;
    f32x2 acc2[16];
#pragma unroll
    for (int j = 0; j < 16; ++j) acc2[j] = f32x2{0.f, 0.f};
    LOAD_ROWS(rb, ivB[0], ivB[1]);
    LOAD_META(tn, ivN, cvN);
    xvN = *(const u32x2*)(p.X16 + (size_t)tn * 1024 + xoff);
    ACCUM(ra, cvA[0], cvA[1]);
    ivA[0] = ivN[0]; ivA[1] = ivN[1]; ivB[0] = ivN[2]; ivB[1] = ivN[3];
    LOAD_ROWS(ra, ivA[0], ivA[1]);
    ACCUM(rb, cvA[2], cvA[3]);
#pragma unroll
    for (int q = 0; q < 4; ++q) cvA[q] = cvN[q];
    float acc[32];
#pragma unroll
    for (int j = 0; j < 16; ++j) { acc[2 * j] = acc2[j][0]; acc[2 * j + 1] = acc2[j][1]; }
    float w16[16], w8[8], w4[4];
#pragma unroll
    for (int k = 0; k < 16; ++k) { const float keep = b5 ? acc[k + 16] : acc[k], send = b5 ? acc[k] : acc[k + 16]; w16[k] = keep + __shfl_xor(send, 32); }
#pragma unroll
    for (int k = 0; k < 8; ++k) { const float keep = b4 ? w16[k + 8] : w16[k], send = b4 ? w16[k] : w16[k + 8]; w8[k] = keep + __shfl_xor(send, 16); }
#pragma unroll
    for (int k = 0; k < 4; ++k) { const float keep = b3 ? w8[k + 4] : w8[k], send = b3 ? w8[k] : w8[k + 4]; w4[k] = keep + __shfl_xor(send, 8); }
    *(u32x2*)(Xout + (size_t)(t & rowmask) * 1024 + xoff) = u32x2{pk2(bflo(xv[0]) + w4[0], bfhi(xv[0]) + w4[1]), pk2(bflo(xv[1]) + w4[2], bfhi(xv[1]) + w4[3])};
    xv = xvN;
  }
#undef LOAD_META
#undef LOAD_ROWS
#undef ACCUM
}
DI void final_norm(const Params& p) {
  const int gt_ = GTID(), lane = gt_ & 63, gw = gt_ >> 6, nw = gridDim.x * (NTHREADS / 64);
  for (int t = gw; t < T; t += nw) {
    const bf16_t* xr = p.X16 + (size_t)t * 1024;
    f32x4 v[4]; float ss = 0.f;
#pragma unroll
    for (int i = 0; i < 4; ++i) { const u32x2 w = *(const u32x2*)(xr + 256 * i + 4 * lane); v[i] = f32x4{bflo(w[0]), bfhi(w[0]), bflo(w[1]), bfhi(w[1])};
      ss += v[i][0] * v[i][0] + v[i][1] * v[i][1] + v[i][2] * v[i][2] + v[i][3] * v[i][3]; }
    ss = wave_sum(ss);
    const float rstd = rsqrtf(ss * (1.0f / 1024.0f) + EPS);
    float* orow = p.X + (size_t)t * 1024;
#pragma unroll
    for (int i = 0; i < 4; ++i) {
      const f32x4 g = *(const f32x4*)(p.norm_final + 256 * i + 4 * lane);
      *(f32x4*)(orow + 256 * i + 4 * lane) = f32x4{v[i][0] * rstd * g[0], v[i][1] * rstd * g[1], v[i][2] * rstd * g[2], v[i][3] * rstd * g[3]};
    }
  }
}

DI void quant_fp8(const float* src, unsigned char* dst, size_t n4) {
  for (size_t i = (size_t)GTID(); i < n4; i += (size_t)gridDim.x * NTHREADS) {
    const f32x4 v = *(const f32x4*)(src + i * 4);
    int pk = 0;
    pk = __builtin_amdgcn_cvt_pk_fp8_f32(v[0] * V_FP8_SCALE, v[1] * V_FP8_SCALE, pk, false);
    pk = __builtin_amdgcn_cvt_pk_fp8_f32(v[2] * V_FP8_SCALE, v[3] * V_FP8_SCALE, pk, true);
    *(unsigned*)(dst + i * 4) = (unsigned)pk;
  }
}
DI void quant_u4(const float* src, unsigned char* dst, float* scale, int nrows) {
  const int gt_ = GTID(), lane = gt_ & 63, gw = gt_ >> 6, nw = gridDim.x * (NTHREADS / 64);
  const int c = lane >> 1, hf = lane & 1;
  for (int r = gw; r < nrows; r += nw) {
    const float* xr = src + (size_t)r * 1024 + 32 * c + 8 * hf;
    const f32x4 a0 = *(const f32x4*)xr, a1 = *(const f32x4*)(xr + 4), b0 = *(const f32x4*)(xr + 16), b1 = *(const f32x4*)(xr + 20);
    float ss = 0.f;
#pragma unroll
    for (int j = 0; j < 4; ++j) ss += a0[j] * a0[j] + a1[j] * a1[j] + b0[j] * b0[j] + b1[j] * b1[j];
    ss = wave_sum(ss);
    const float sc = fmaxf(2.45f * sqrtf(ss * (1.0f / 1024.0f)) * (1.0f / 7.0f), 1e-30f), inv = 1.0f / sc;
    unsigned w[2];
#pragma unroll
    for (int q = 0; q < 2; ++q) {
      const f32x4 lo = q ? a1 : a0, hi = q ? b1 : b0;
      unsigned ww = 0;
#pragma unroll
      for (int j = 0; j < 4; ++j) {
        const int ql = (int)fminf(fmaxf(rintf(lo[j] * inv), -7.f), 7.f) + 8, qh = (int)fminf(fmaxf(rintf(hi[j] * inv), -7.f), 7.f) + 8;
        ww |= (unsigned)(ql | (qh << 4)) << (8 * j);
      }
      w[q] = ww;
    }
    *(u32x2*)(dst + (size_t)r * 512 + 16 * c + 8 * hf) = u32x2{w[0], w[1]};
    if (lane == 0) scale[2 * r] = sc;
  }
}
DI void quant_v4(const float* src, unsigned char* dst, float* scale, int nrows) {
  const int gt_ = GTID(), lane = gt_ & 63, gw = gt_ >> 6, nw = gridDim.x * (NTHREADS / 64);
  for (int r = gw; r < nrows; r += nw) {
    const float* xr = src + (size_t)r * 1024 + 16 * lane;
    f32x4 a[4]; float ss = 0.f;
#pragma unroll
    for (int q = 0; q < 4; ++q) { a[q] = *(const f32x4*)(xr + 4 * q); ss += a[q][0] * a[q][0] + a[q][1] * a[q][1] + a[q][2] * a[q][2] + a[q][3] * a[q][3]; }
    ss = wave_sum(ss);
    const float sc = fmaxf(sqrtf(ss * (1.0f / 1024.0f)) * (1.0f / 2.1f), 1e-30f), inv = 1.0f / sc;
    unsigned w0 = 0, w1 = 0;
    w0 = __builtin_amdgcn_cvt_scalef32_pk_fp4_f32(w0, a[0][0] * inv, a[0][1] * inv, 1.0f, 0);
    w0 = __builtin_amdgcn_cvt_scalef32_pk_fp4_f32(w0, a[0][2] * inv, a[0][3] * inv, 1.0f, 1);
    w0 = __builtin_amdgcn_cvt_scalef32_pk_fp4_f32(w0, a[1][0] * inv, a[1][1] * inv, 1.0f, 2);
    w0 = __builtin_amdgcn_cvt_scalef32_pk_fp4_f32(w0, a[1][2] * inv, a[1][3] * inv, 1.0f, 3);
    w1 = __builtin_amdgcn_cvt_scalef32_pk_fp4_f32(w1, a[2][0] * inv, a[2][1] * inv, 1.0f, 0);
    w1 = __builtin_amdgcn_cvt_scalef32_pk_fp4_f32(w1, a[2][2] * inv, a[2][3] * inv, 1.0f, 1);
    w1 = __builtin_amdgcn_cvt_scalef32_pk_fp4_f32(w1, a[3][0] * inv, a[3][1] * inv, 1.0f, 2);
    w1 = __builtin_amdgcn_cvt_scalef32_pk_fp4_f32(w1, a[3][2] * inv, a[3][3] * inv, 1.0f, 3);
    *(u32x2*)(dst + (size_t)r * 512 + 8 * lane) = u32x2{w0, w1};
    if (lane == 0) scale[2 * r] = sc;
  }
}
template <bool OFFS>
DI void quant_rows(const float* src, unsigned char* dst, float* scale, int nrows) {
  const int gt_ = GTID(), lane = gt_ & 63, gw = gt_ >> 6, nw = gridDim.x * (NTHREADS / 64);
  for (int r = gw; r < nrows; r += nw) {
    const float* xr = src + (size_t)r * 1024 + 4 * lane;
    f32x4 v[4]; float m = 0.f;
#pragma unroll
    for (int q = 0; q < 4; ++q) { v[q] = *(const f32x4*)(xr + 256 * q); m = fmaxf(m, fmaxf(fmaxf(fabsf(v[q][0]), fabsf(v[q][1])), fmaxf(fabsf(v[q][2]), fabsf(v[q][3])))); }
    m = fmaxf(wave_max(m), 1e-30f);
    const float inv = 127.0f / m;
#pragma unroll
    for (int q = 0; q < 4; ++q) {
      int a0 = (int)rintf(v[q][0] * inv), a1 = (int)rintf(v[q][1] * inv), a2 = (int)rintf(v[q][2] * inv), a3 = (int)rintf(v[q][3] * inv);
      if (OFFS) { a0 += 128; a1 += 128; a2 += 128; a3 += 128; }
      *(unsigned*)(dst + (size_t)r * 1024 + 4 * lane + 256 * q) = (unsigned)(a0 & 255) | ((unsigned)(a1 & 255) << 8) | ((unsigned)(a2 & 255) << 16) | ((unsigned)a3 << 24);
    }
    if (lane == 0) scale[r] = m * (1.0f / 127.0f);
  }
}

DI void transpose_cvt(const float* W, int ldw, int K, int N, bf16_t* Wt, int ldt, char* smem, int& job, int jobstride) {
  float* tile = (float*)smem;
  const int tk = K / 64, tn = N / 64, total = tk * tn;
  const int tid = threadIdx.x;
  for (; job < total; job += jobstride) {
    const int k0 = (job / tn) * 64, n0 = (job % tn) * 64;
    __syncthreads();
#pragma unroll
    for (int i = 0; i < 8; ++i) { const int e = tid + i * NTHREADS, kk = e >> 6, nn = e & 63; tile[kk * 65 + nn] = W[(size_t)(k0 + kk) * ldw + n0 + nn]; }
    __syncthreads();
#pragma unroll
    for (int i = 0; i < 8; ++i) { const int e = tid + i * NTHREADS, nn = e >> 6, kk = e & 63; Wt[(size_t)(n0 + nn) * ldt + k0 + kk] = f2bf(tile[kk * 65 + nn]); }
  }
  job -= total;
}
DI void cvt_elems(const float* src, bf16_t* dst, size_t n8) {
  for (size_t i = (size_t)GTID(); i < n8; i += (size_t)gridDim.x * NTHREADS) {
    const f32x4 a = *(const f32x4*)(src + i * 8), b = *(const f32x4*)(src + i * 8 + 4);
    *(u32x4*)(dst + i * 8) = u32x4{pk2(a[0], a[1]), pk2(a[2], a[3]), pk2(b[0], b[1]), pk2(b[2], b[3])};
  }
}
DI void prep_phase(const Params& p, char* smem) {
  int job = blockIdx.x; const int js = gridDim.x;
  transpose_cvt(p.w_in, IN_COLS, 1024, IN_COLS, p.wt_in, 1024, smem, job, js);
  transpose_cvt(p.w_out, 1024, 1024, 1024, p.wt_out, 1024, smem, job, js);
  transpose_cvt(p.w_cq, 512, 1024, 512, p.wt_cq, 1024, smem, job, js);
  transpose_cvt(p.w_ck, 512, 1024, 512, p.wt_ckv, 1024, smem, job, js);
  transpose_cvt(p.w_cv, 512, 1024, 512, p.wt_ckv + (size_t)512 * 1024, 1024, smem, job, js);
  transpose_cvt(p.w_co, 1024, 512, 1024, p.wt_co, 512, smem, job, js);
  for (int h = 0; h < 4; ++h) transpose_cvt(p.w_kv_b + h * 256 + 128, 1024, 128, 128, p.wt_uv + (size_t)h * 128 * 128, 128, smem, job, js);
  __syncthreads();
  const size_t gtid = (size_t)GTID(), gn = (size_t)gridDim.x * NTHREADS;
  for (size_t i = gtid; i < (size_t)64 * 1024 / 8; i += gn) *(u32x4*)(p.wt_in + (size_t)IN_COLS * 1024 + i * 8) = u32x4{0, 0, 0, 0};
  for (size_t i = gtid; i < (size_t)768 * 256; i += gn) {
    const int n = (int)(i >> 8), k = (int)(i & 255), h = n / 192, j = n - h * 192;
    float v;
    if (j < 128) {
      const float* a = p.w_q_b + (size_t)k * 768 + h * 192; const float* b = p.w_kv_b + (size_t)j * 1024 + h * 256;
      float s = 0.f;
      for (int d = 0; d < 128; d += 4) { const f32x4 av = *(const f32x4*)(a + d), bv = *(const f32x4*)(b + d); s += av[0] * bv[0] + av[1] * bv[1] + av[2] * bv[2] + av[3] * bv[3]; }
      v = s;
    } else v = p.w_q_b[(size_t)k * 768 + n];
    p.wt_qc[i] = f2bf(v);
  }
  cvt_elems(p.peer_w_q, p.a_pq, (size_t)1024 * 2048 / 8);
  cvt_elems(p.peer_keys, p.keys_bf, (size_t)2048 * 128 / 8);
  quant_u4(p.peer_u, p.u_q, p.su, 16384);
  quant_v4(p.peer_v, p.v_q, p.su + 1, 16384);
  for (size_t i = gtid; i < (size_t)T * 32; i += gn) {
    const int t = (int)(i >> 5), ii = (int)(i & 31);
    const float inv = exp2f(-(float)ii * (13.287712379549449f / 32.0f));
    const float ang = (float)p.positions[t] * inv;
    float sn, cs; sincosf(ang, &sn, &cs);
    *(f32x2*)(p.rope + i * 2) = f32x2{cs, sn};
  }
  norm_rows_1024(p.mem, p.norm_mem, p.mn, NB * 256);
  norm_rows_1024(p.x, p.norm_mix, p.xn, T);
}

struct KArgs { const void* in[25]; float* out; char* ws; };
__host__ __device__ __forceinline__ size_t align_up(size_t v) { return (v + 255) & ~(size_t)255; }
__host__ __device__ __forceinline__ Params build_params(const KArgs& k, size_t* total) {
  Params p{};
  p.x = (const float*)k.in[0]; p.mem = (const float*)k.in[1]; p.positions = (const int*)k.in[2]; p.norm_mix = (const float*)k.in[3]; p.w_in = (const float*)k.in[4];
  p.q_a_norm = (const float*)k.in[5]; p.w_q_b = (const float*)k.in[6]; p.kv_a_norm = (const float*)k.in[7]; p.w_kv_b = (const float*)k.in[8]; p.swa_sinks = (const float*)k.in[9];
  p.out_norm_mla = (const float*)k.in[10]; p.out_norm_swa = (const float*)k.in[11]; p.w_out = (const float*)k.in[12]; p.norm_cross = (const float*)k.in[13]; p.norm_mem = (const float*)k.in[14];
  p.w_cq = (const float*)k.in[15]; p.w_ck = (const float*)k.in[16]; p.w_cv = (const float*)k.in[17]; p.w_co = (const float*)k.in[18]; p.norm_ffn = (const float*)k.in[19];
  p.peer_w_q = (const float*)k.in[20]; p.peer_keys = (const float*)k.in[21]; p.peer_u = (const float*)k.in[22]; p.peer_v = (const float*)k.in[23]; p.norm_final = (const float*)k.in[24];
  p.X = k.out;
  char* ws = k.ws; size_t off = 0;
#define TAKE(bytes) (ws + ((off += align_up(bytes)) - align_up(bytes)))
  p.wt_in = (bf16_t*)TAKE((size_t)IN_COLS_PAD * 1024 * 2);
  p.wt_qc = (bf16_t*)TAKE((size_t)768 * 256 * 2);
  p.wt_uv = (bf16_t*)TAKE((size_t)512 * 128 * 2);
  p.wt_out = (bf16_t*)TAKE((size_t)1024 * 1024 * 2);
  p.wt_cq = (bf16_t*)TAKE((size_t)512 * 1024 * 2);
  p.wt_ckv = (bf16_t*)TAKE((size_t)1024 * 1024 * 2);
  p.wt_co = (bf16_t*)TAKE((size_t)1024 * 512 * 2);
  p.a_pq = (bf16_t*)TAKE((size_t)1024 * 2048 * 2);
  p.keys_bf = (bf16_t*)TAKE((size_t)2048 * 128 * 2);
  p.wt_sc = (bf16_t*)TAKE((size_t)2048 * 1024 * 2);
  p.bar = (unsigned*)TAKE((size_t)XCD_BAR_WORDS * 4);
  p.u_q = (unsigned char*)TAKE((size_t)16384 * 512);
  p.v_q = (unsigned char*)TAKE((size_t)16384 * 512);
  p.k8 = (unsigned char*)TAKE((size_t)T * 192);
  p.vt8 = (unsigned char*)TAKE((size_t)T * 128);
  p.su = (float*)TAKE((size_t)16384 * 8);
  p.sv = p.su + 1;
  p.mn = (bf16_t*)TAKE((size_t)512 * 1024 * 2);
  p.kvc = (bf16_t*)TAKE((size_t)512 * 1024 * 2);
  p.rope = (float*)TAKE((size_t)T * 64 * 4);
  p.xn = (bf16_t*)TAKE((size_t)T * 1024 * 2);
  const size_t offR = off;
  p.lat = (bf16_t*)TAKE((size_t)T * 448 * 2);
  p.cqn = (bf16_t*)TAKE((size_t)T * 256 * 2);
  p.qcat = (bf16_t*)TAKE((size_t)T * 768 * 2);
  p.kcat = (bf16_t*)TAKE((size_t)T * 192 * 2);
  p.qs = (bf16_t*)TAKE((size_t)T * 512 * 2);
  p.ks = (bf16_t*)TAKE((size_t)T * 128 * 2);
  p.vs = (bf16_t*)TAKE((size_t)T * 128 * 2);
  p.olat = (bf16_t*)TAKE((size_t)T * 512 * 2);
  p.ob = (bf16_t*)TAKE((size_t)T * 512 * 2);
  p.oa = (bf16_t*)TAKE((size_t)T * 512 * 2);
  const size_t offEnd = off;
  off = offR;
  p.qx = (bf16_t*)TAKE((size_t)T * 512 * 2);
  p.ox = (bf16_t*)TAKE((size_t)T * 512 * 2);
  p.top1 = (int*)TAKE((size_t)T * 256 * 4);
  p.pidx = (int*)TAKE((size_t)T * 128 * 4);
  p.pg = (float*)TAKE((size_t)T * 128 * 4);
  p.dpartA = (int*)(ws + offR);
  p.dpartB = (int*)TAKE((size_t)4 * T * 128 * 4);
  p.X16 = (bf16_t*)p.dpartB;
  p.hq = (unsigned char*)TAKE((size_t)T * 1024);
  p.sh = (float*)TAKE((size_t)T * 4);
  p.cbuf = (float*)TAKE((size_t)T * 128 * 4);
#undef TAKE
  if (total) *total = (off > offEnd) ? off : offEnd;
  return p;
}

constexpr int N_PHASES = 19;
template <int PH> DI void run_phase(const Params& p, char* smem) {
  if constexpr (PH == 0) prep_phase(p, smem);
  else if constexpr (PH == 1) {
    g8::run(p.xn, p.wt_in, T, IN_COLS_PAD, DM, g8::EpiInproj{p.lat, p.qs, p.ks, p.vs}, smem);
    { const int G = (int)gridDim.x, n3 = 640 - 2 * G;
      if (n3 > 0 && G - n3 >= 72) {
        if ((int)blockIdx.x >= n3) {
          const int c = (int)blockIdx.x - n3;
          if (c < 8) g8::run_on(p.mn, p.wt_ckv, NB * 256, 1024, DM, g8::EpiBf16{p.kvc, 1024, 1.0f}, smem, c, 8);
          else if (c < 72) gemm_phase(p.a_pq, 2048, 128, p.keys_bf, 128, 1024, 2048, 128, EpiBf16T{p.wt_sc, 1024}, smem, c - 8, 64);
        }
      } else {
        g8::run(p.mn, p.wt_ckv, NB * 256, 1024, DM, g8::EpiBf16{p.kvc, 1024, 1.0f}, smem);
        gemm_phase(p.a_pq, 2048, 128, p.keys_bf, 128, 1024, 2048, 128, EpiBf16T{p.wt_sc, 1024}, smem);
      } }
  }
  else if constexpr (PH == 2) latent_pass(p, smem);
  else if constexpr (PH == 3) g8::run(p.cqn, p.wt_qc, T, 768, 256, g8::EpiBf16{p.qcat, 768, MLA_QSCALE}, smem);
  else if constexpr (PH == 4) { mla_phase(p, smem); swa_phase(p, smem); }
  else if constexpr (PH == 5) gemm_phase(p.olat, 512, 128, p.wt_uv, 128, T, 512, 128, EpiBf16{p.oa, 512, 1.0f}, smem);
  else if constexpr (PH == 6) mix_pass(p);
  else if constexpr (PH == 7) g8::run(p.xn, p.wt_out, T, DM, DM, g8::EpiResid16<true>{p.x, p.X16, DM, DBG_MIX}, smem);
  else if constexpr (PH == 8) norm_rows_bf16(p.X16, p.norm_cross, p.xn, T);
  else if constexpr (PH == 9) g8::run(p.xn, p.wt_cq, T, 512, DM, g8::EpiBf16{p.qx, 512, X_QSCALE}, smem);
  else if constexpr (PH == 10) xattn_phase(p, smem);
  else if constexpr (PH == 11) g8::run(p.ox, p.wt_co, T, DM, 512, g8::EpiResid16<false>{p.X16, p.X16, DM, DBG_XAT}, smem);
  else if constexpr (PH == 12) norm_rows_ffn(p);
  else if constexpr (PH == 13) score_phase(p, smem);
  else if constexpr (PH == 14) topk2_phase(p);
  else if constexpr (PH == 15) peer_dots(p);
  else if constexpr (PH == 16) peer_coef(p);
  else if constexpr (PH == 17) peer_accum(p, p.X16, -1);
  else if constexpr (PH == 18) final_norm(p);
}

template <int PB, int PE>
__global__ void __launch_bounds__(NTHREADS) mega_kernel(KArgs ka) {
  const Params p = build_params(ka, nullptr);
  if (ka.ws == nullptr) cg::this_grid().sync();
  __shared__ __attribute__((aligned(16))) char smem[SMEM_BYTES];
  XcdBarrier xb;
  if constexpr (PE - PB > 1) {
    volatile LAS unsigned* xbw = (volatile LAS unsigned*)(smem + SMEM_BYTES - 256);
    if (threadIdx.x == 0) { xbw[0] = 0u; xbw[1] = 0u; }
    __syncthreads();
    xb = xcd_barrier_post(p.bar, xbw);
  }
#define RUN(n) if constexpr (PB <= n && n < PE) { if constexpr (n == DUP) { if constexpr (n == 17) peer_accum(p, p.oa, 1023); else run_phase<n>(p, smem); xcd_barrier(xb); } run_phase<n>(p, smem); if constexpr (n + 1 < PE) { xcd_barrier(xb); } }
  RUN(0) RUN(1) RUN(2) RUN(3) RUN(4) RUN(5) RUN(6) RUN(7) RUN(8) RUN(9) RUN(10) RUN(11) RUN(12) RUN(13) RUN(14) RUN(15) RUN(16) RUN(17) RUN(18)
#undef RUN
}


extern "C" void kernel_launch(void* const* d_in, const int* in_sizes, int n_in, void* d_out, int out_size, void* d_ws, size_t ws_size, hipStream_t stream) {
  (void)in_sizes; (void)n_in; (void)out_size;
  KArgs ka{};
  for (int i = 0; i < 25; ++i) ka.in[i] = d_in[i];
  ka.out = (float*)d_out; ka.ws = (char*)d_ws;
  size_t need = 0;
  const Params hp = build_params(ka, &need);
  if (need > ws_size) { fprintf(stderr, "kernel_launch: workspace too small (%zu > %zu)\n", need, ws_size); return; }

  static int grid_blocks = 0;
  if (!grid_blocks) {
    int dev = 0, cus = 0;
    (void)hipGetDevice(&dev);
    (void)hipDeviceGetAttribute(&cus, hipDeviceAttributeMultiprocessorCount, dev);
    grid_blocks = cus > 0 ? cus : 256;
  }
#if MK_SINGLE_LAUNCH
  {
    (void)hipMemsetAsync(hp.bar, 0, (size_t)XCD_BAR_WORDS * 4, stream);
    int per_cu = 0;
    (void)hipOccupancyMaxActiveBlocksPerMultiprocessor(&per_cu, mega_kernel<0, N_PHASES>, NTHREADS, 0);
    if (per_cu < 1) fprintf(stderr, "occupancy query returned %d\n", per_cu);
    void* args[] = {&ka};
    hipError_t e = hipLaunchCooperativeKernel((void*)mega_kernel<0, N_PHASES>, dim3(grid_blocks), dim3(NTHREADS), args, 0, stream);
    if (e != hipSuccess) fprintf(stderr, "cooperative launch failed: %s (grid %d)\n", hipGetErrorString(e), grid_blocks);
  }
#else
#define LAUNCH(n) hipLaunchKernelGGL((mega_kernel<n, n + 1>), dim3(grid_blocks), dim3(NTHREADS), 0, stream, ka);
  LAUNCH(0) LAUNCH(1) LAUNCH(2) LAUNCH(3) LAUNCH(4) LAUNCH(5) LAUNCH(6) LAUNCH(7) LAUNCH(8) LAUNCH(9) LAUNCH(10) LAUNCH(11) LAUNCH(12) LAUNCH(13) LAUNCH(14) LAUNCH(15) LAUNCH(16) LAUNCH(17) LAUNCH(18)
#undef LAUNCH
#endif
}
```

```cpp
#include <hip/hip_runtime.h>
#include <hip/hip_cooperative_groups.h>
#include <cstdint>
#include <cstdio>
namespace cg = cooperative_groups;

#ifndef MK_SINGLE_LAUNCH
#define MK_SINGLE_LAUNCH 1
#endif

#ifndef DUP
#define DUP -1
#endif
#ifndef DBG
#define DBG 0
#endif
#define DBG_MIX ((DBG == 1) ? 0.0f : 1.0f)
#define DBG_XAT ((DBG == 1 || DBG == 2) ? 0.0f : 1.0f)
#define DBG_PEER ((DBG >= 1 && DBG <= 3) ? 0.0f : (DBG == 4 ? -0.5f : 1.0f))
#define DI __device__ __forceinline__
typedef unsigned short bf16_t;
typedef short bf16x8 __attribute__((ext_vector_type(8)));
typedef short s16x4 __attribute__((ext_vector_type(4)));
typedef float f32x16 __attribute__((ext_vector_type(16)));
typedef float f32x4 __attribute__((ext_vector_type(4)));
typedef float f32x2 __attribute__((ext_vector_type(2)));
typedef unsigned u32x4 __attribute__((ext_vector_type(4)));
typedef unsigned u32x2 __attribute__((ext_vector_type(2)));
typedef int i32x4 __attribute__((ext_vector_type(4)));
typedef __bf16 bf2_t __attribute__((ext_vector_type(2)));

constexpr int NB = 2, SEQ = 16384, DM = 1024, T = NB * SEQ;
constexpr int NTHREADS = 512;
constexpr float LOG2E = 1.4426950408889634f;
constexpr float EPS = 1e-6f;
constexpr int IN_COLS = 1216, IN_COLS_PAD = 1280;
constexpr float MLA_QSCALE = 0.07216878364870322f * LOG2E * 8.0f;
constexpr float SWA_QSCALE = 0.125f * LOG2E;
constexpr float X_QSCALE = 0.08838834764831845f * LOG2E;
constexpr float SM_THR = 8.0f;
constexpr float V_FP8_SCALE = 64.0f;

#define XB_TMO      128
#define XB_XCNT(j)  (256  + 64 * (j))
#define XB_XSUB(j)  (1280 + 64 * (j))
#define XB_XGEN(j)  (2304 + 64 * (j))
#define XB_TOP      3328
#define XB_TOPGEN   3392
#define XCD_BAR_WORDS 3456
#define XB_SPIN_CAP (1u << 22)
#define LAS __attribute__((address_space(3)))
DI unsigned xb_ld(unsigned* p)              { return __hip_atomic_load(p, __ATOMIC_RELAXED, __HIP_MEMORY_SCOPE_AGENT); }
DI unsigned xb_add(unsigned* p, unsigned v) { return __hip_atomic_fetch_add(p, v, __ATOMIC_RELAXED, __HIP_MEMORY_SCOPE_AGENT); }
DI unsigned xb_xcc_id() { return (unsigned)__builtin_amdgcn_s_getreg((3 << 11) | 20) & 0xFu; }
#define XB_SPIN(cond, bar) do { unsigned _sp = 0; while (cond) { __builtin_amdgcn_s_sleep(1); \
    if ((++_sp & 255u) == 0u) { if (xb_ld(&(bar)[XB_TMO])) break; if (_sp > XB_SPIN_CAP) { atomicAdd(&(bar)[XB_TMO], 1u); break; } } } } while (0)
struct XcdBarrier { unsigned* bar; unsigned x; volatile LAS unsigned* st; };
DI XcdBarrier xcd_barrier_post(unsigned* bar, volatile LAS unsigned* st) {
  XcdBarrier b; b.bar = bar; b.x = xb_xcc_id(); b.st = st;
  if (threadIdx.x == 0) (void)xb_add(&bar[XB_XCNT(b.x)], 1u);
  return b;
}
DI void xcd_barrier_complete(unsigned* bar, unsigned x, unsigned& nloc, unsigned& nx) {
  const unsigned G = gridDim.x * gridDim.y * gridDim.z;
  unsigned sum, cnt, mine, sp = 0u;
  for (;;) {
    sum = 0u; cnt = 0u; mine = 0u;
#pragma unroll
    for (unsigned j = 0; j < 16; ++j) { const unsigned c = xb_ld(&bar[XB_XCNT(j)]); sum += c; cnt += (c > 0u) ? 1u : 0u; mine = (j == x) ? c : mine; }
    if (sum == G) break;
    __builtin_amdgcn_s_sleep(1);
    if ((++sp & 255u) == 0u) { if (xb_ld(&bar[XB_TMO])) break; if (sp > XB_SPIN_CAP) { atomicAdd(&bar[XB_TMO], 1u); break; } }
  }
  nloc = mine > 0u ? mine : 1u; nx = cnt > 0u ? cnt : 1u;
}
DI void xcd_barrier(const XcdBarrier& b) {
  asm volatile("s_waitcnt vmcnt(0)" ::: "memory");
  __syncthreads();
  if (threadIdx.x == 0) {
    unsigned* bar = b.bar;
    __builtin_amdgcn_s_waitcnt(0);
    unsigned nloc = b.st[0], nx = b.st[1];
    if (nloc == 0u) { xcd_barrier_complete(bar, b.x, nloc, nx); b.st[0] = nloc; b.st[1] = nx; }
    const unsigned old = xb_add(&bar[XB_XSUB(b.x)], 1u);
    const unsigned gen = old / nloc;
    if (old + 1u == (gen + 1u) * nloc) {
      __builtin_amdgcn_fence(__ATOMIC_RELEASE, "agent");
      asm volatile("s_waitcnt vmcnt(0)" ::: "memory");
      (void)xb_add(&bar[XB_TOP], 1u);
    }
    const unsigned target = (gen + 1u) * nx;
    XB_SPIN((int)(xb_ld(&bar[XB_TOP]) - target) < 0, bar);
    __builtin_amdgcn_fence(__ATOMIC_ACQUIRE, "agent");
    asm volatile("s_waitcnt vmcnt(0)" ::: "memory");
  }
  __syncthreads();
}

struct Params {
  const float* x; const float* mem; const int* positions; const float* norm_mix; const float* w_in; const float* q_a_norm; const float* w_q_b;
  const float* kv_a_norm; const float* w_kv_b; const float* swa_sinks; const float* out_norm_mla; const float* out_norm_swa; const float* w_out;
  const float* norm_cross; const float* norm_mem; const float* w_cq; const float* w_ck; const float* w_cv; const float* w_co; const float* norm_ffn;
  const float* peer_w_q; const float* peer_keys; const float* peer_u; const float* peer_v; const float* norm_final;
  float* X;
  bf16_t* wt_in; bf16_t* wt_qc; bf16_t* wt_uv; bf16_t* wt_out; bf16_t* wt_cq; bf16_t* wt_ckv; bf16_t* wt_co; bf16_t* a_pq; bf16_t* keys_bf; bf16_t* wt_sc;
  unsigned char* u_q; unsigned char* v_q; unsigned char* k8; unsigned char* vt8; float* su; float* sv; unsigned* bar; bf16_t* mn; bf16_t* kvc; float* rope; bf16_t* xn; bf16_t* lat; bf16_t* cqn; bf16_t* qcat; bf16_t* kcat;
  bf16_t* qs; bf16_t* ks; bf16_t* vs; bf16_t* olat; bf16_t* ob; bf16_t* oa; bf16_t* qx; bf16_t* ox; int* top1; unsigned short* pidx; float* pg; unsigned char* hq; float* sh; float* rs3; float* rsx; float* rsq; float* ssx; bf16_t* x16; float* rs0; int* dpartA; int* dpartB; float* cbuf; bf16_t* X16;
};

DI unsigned pk2(float lo, float hi) { f32x2 v = {lo, hi}; bf2_t b = __builtin_convertvector(v, bf2_t); return __builtin_bit_cast(unsigned, b); }
DI bf16_t f2bf(float x) { __bf16 b = (__bf16)x; return __builtin_bit_cast(bf16_t, b); }
DI float bf2f(bf16_t b) { return __uint_as_float(((unsigned)b) << 16); }
DI float bflo(unsigned w) { return __uint_as_float(w << 16); }
DI float bfhi(unsigned w) { return __uint_as_float(w & 0xffff0000u); }
DI float dot2bf(unsigned a, unsigned b, float c) { return __builtin_amdgcn_fdot2_f32_bf16(__builtin_bit_cast(bf2_t, a), __builtin_bit_cast(bf2_t, b), c, false); }
constexpr size_t PEER_SLICE_BYTES = (size_t)16384 * 128;
DI int GTID() { int t = threadIdx.x; asm volatile("" : "+v"(t)); return (int)blockIdx.x * NTHREADS + t; }
DI bf16x8 scale8(bf16x8 v, float s) { const u32x4 w = __builtin_bit_cast(u32x4, v);
  const u32x4 r = {pk2(bflo(w[0]) * s, bfhi(w[0]) * s), pk2(bflo(w[1]) * s, bfhi(w[1]) * s), pk2(bflo(w[2]) * s, bfhi(w[2]) * s), pk2(bflo(w[3]) * s, bfhi(w[3]) * s)};
  return __builtin_bit_cast(bf16x8, r); }
DI void unpack_idx16(const unsigned short* ip, i32x4 (&iv)[4]) {
  const u32x4 a = *(const u32x4*)ip, b = *(const u32x4*)(ip + 8);
  iv[0] = i32x4{(int)(a[0] & 0xffffu), (int)(a[0] >> 16), (int)(a[1] & 0xffffu), (int)(a[1] >> 16)}; iv[1] = i32x4{(int)(a[2] & 0xffffu), (int)(a[2] >> 16), (int)(a[3] & 0xffffu), (int)(a[3] >> 16)};
  iv[2] = i32x4{(int)(b[0] & 0xffffu), (int)(b[0] >> 16), (int)(b[1] & 0xffffu), (int)(b[1] >> 16)}; iv[3] = i32x4{(int)(b[2] & 0xffffu), (int)(b[2] >> 16), (int)(b[3] & 0xffffu), (int)(b[3] >> 16)}; }
DI int crow(int r, int hi) { return (r & 3) + 8 * (r >> 2) + 4 * hi; }
#define WAVE_DPP(v, ctrl) __builtin_bit_cast(float, __builtin_amdgcn_update_dpp(0, __builtin_bit_cast(int, (v)), (ctrl), 0xF, 0xF, true))
#define WAVE_DPP_I(v, ctrl) __builtin_amdgcn_update_dpp(0, (int)(v), (ctrl), 0xF, 0xF, true)
DI float wave_sum(float v) {
  v += WAVE_DPP(v, 0xB1); v += WAVE_DPP(v, 0x4E); v += WAVE_DPP(v, 0x141); v += WAVE_DPP(v, 0x140);
  { auto rr = __builtin_amdgcn_permlane16_swap(__float_as_uint(v), __float_as_uint(v), false, false); v = __uint_as_float(rr[0]) + __uint_as_float(rr[1]); }
  { auto rr = __builtin_amdgcn_permlane32_swap(__float_as_uint(v), __float_as_uint(v), false, false); v = __uint_as_float(rr[0]) + __uint_as_float(rr[1]); }
  return v;
}
DI float wave_max_dpp(float v) {
  v = fmaxf(v, WAVE_DPP(v, 0xB1)); v = fmaxf(v, WAVE_DPP(v, 0x4E)); v = fmaxf(v, WAVE_DPP(v, 0x141)); v = fmaxf(v, WAVE_DPP(v, 0x140));
  { auto rr = __builtin_amdgcn_permlane16_swap(__float_as_uint(v), __float_as_uint(v), false, false); v = fmaxf(__uint_as_float(rr[0]), __uint_as_float(rr[1])); }
  { auto rr = __builtin_amdgcn_permlane32_swap(__float_as_uint(v), __float_as_uint(v), false, false); v = fmaxf(__uint_as_float(rr[0]), __uint_as_float(rr[1])); }
  return v;
}
#define MFMA32(a, b, c) __builtin_amdgcn_mfma_f32_32x32x16_bf16((a), (b), (c), 0, 0, 0)
#define SBAR() __builtin_amdgcn_sched_barrier(0)

constexpr int G_BM = 256, G_BN = 128, G_BK = 64;
constexpr int G_A_BYTES = G_BM * 128, G_B_BYTES = G_BN * 128, G_STAGE = G_A_BYTES + G_B_BYTES;
constexpr int G_NSTAGE = 3;
constexpr int SMEM_BYTES = 160768 + 256;
#define LDSP(p) ((__attribute__((address_space(3))) unsigned*)(p))

template <int V>
DI void gemm_mainloop(const bf16_t* __restrict__ A, int lda, const bf16_t* __restrict__ Bt, int ldb, int K, int row0, int col0, f32x16 (&acc)[4], char* smem) {
  int tid_ = threadIdx.x; asm volatile("" : "+v"(tid_));
  const int tid = tid_, lane = tid & 63, wid = tid >> 6, r32 = lane & 31, hi = lane >> 5;
  const int srow = tid >> 3, spc = tid & 7, slc = spc ^ ((srow >> 1) & 7);
  const bf16_t* Ag = A + (size_t)(row0 + srow) * lda + slc * 8;
  const bf16_t* Bg = Bt + (size_t)(col0 + srow) * ldb + slc * 8;
  const size_t a64 = (size_t)64 * lda, b64 = (size_t)64 * ldb;
#pragma unroll
  for (int i = 0; i < 4; ++i) acc[i] = f32x16{};
  const int nk = K / G_BK;
  auto stage = [&](int kt, int slot) {
    char* sa = smem + slot * G_STAGE + tid * 16;
    const bf16_t* ag = Ag + kt * G_BK; const bf16_t* bg = Bg + kt * G_BK;
#pragma unroll
    for (int i = 0; i < 4; ++i) __builtin_amdgcn_global_load_lds((const unsigned*)(ag + i * a64), LDSP(sa + i * 8192), 16, 0, 0);
#pragma unroll
    for (int i = 0; i < 2; ++i) __builtin_amdgcn_global_load_lds((const unsigned*)(bg + i * b64), LDSP(sa + G_A_BYTES + i * 8192), 16, 0, 0);
  };
  stage(0, 0);
  if (nk > 1) stage(1, 1);
  const int x = (r32 >> 1) & 7;
  int so[4];
#pragma unroll
  for (int s = 0; s < 4; ++s) so[s] = ((2 * s + hi) ^ x) * 16;
  int aoff, boff;
  if (V == 0) { aoff = ((wid >> 1) * 64 + r32) * 128; boff = G_A_BYTES + ((wid & 1) * 64 + r32) * 128; }
  else        { aoff = ((wid >> 2) * 128 + r32) * 128; boff = G_A_BYTES + ((wid & 3) * 32 + r32) * 128; }
  int slot = 0;
  for (int kt = 0; kt < nk; ++kt) {
    if (kt + 1 < nk) asm volatile("s_waitcnt vmcnt(6) lgkmcnt(0)" ::: "memory"); else asm volatile("s_waitcnt vmcnt(0) lgkmcnt(0)" ::: "memory");
    __builtin_amdgcn_s_barrier();
    if (kt + 2 < nk) { int ns = slot + 2; if (ns >= G_NSTAGE) ns -= G_NSTAGE; stage(kt + 2, ns); }
    const char* cs = smem + slot * G_STAGE;
    if (V == 0) {
      bf16x8 af[4][2], bf[4][2];
#pragma unroll
      for (int s = 0; s < 4; ++s) {
        af[s][0] = *(const bf16x8*)(cs + aoff + so[s]); af[s][1] = *(const bf16x8*)(cs + aoff + 32 * 128 + so[s]);
        bf[s][0] = *(const bf16x8*)(cs + boff + so[s]); bf[s][1] = *(const bf16x8*)(cs + boff + 32 * 128 + so[s]);
      }
#pragma unroll
      for (int s = 0; s < 4; ++s) {
        acc[0] = MFMA32(af[s][0], bf[s][0], acc[0]); acc[1] = MFMA32(af[s][0], bf[s][1], acc[1]);
        acc[2] = MFMA32(af[s][1], bf[s][0], acc[2]); acc[3] = MFMA32(af[s][1], bf[s][1], acc[3]);
      }
    } else {
      bf16x8 af[4][4], bf[4];
#pragma unroll
      for (int s = 0; s < 4; ++s) {
        bf[s] = *(const bf16x8*)(cs + boff + so[s]);
#pragma unroll
        for (int mi = 0; mi < 4; ++mi) af[s][mi] = *(const bf16x8*)(cs + aoff + mi * 32 * 128 + so[s]);
      }
#pragma unroll
      for (int s = 0; s < 4; ++s)
#pragma unroll
        for (int mi = 0; mi < 4; ++mi) acc[mi] = MFMA32(af[s][mi], bf[s], acc[mi]);
    }
    slot = (slot + 1 == G_NSTAGE) ? 0 : slot + 1;
  }
  __syncthreads();
}

constexpr int EP_STR = 132;
template <class Epi>
DI void gemm_epi_rows(const f32x16 (&acc)[4], int row0, int col0, const Epi& epi, char* smem) {
  int tid_ = threadIdx.x; asm volatile("" : "+v"(tid_));
  const int tid = tid_, lane = tid & 63, wid = tid >> 6, r32 = lane & 31, hi = lane >> 5;
  float* tile = (float*)smem;
  const int rb = (wid >> 1) * 64, cb = (wid & 1) * 64 + r32;
  const int rr = tid >> 5, c4 = (tid & 31) * 4;
  if constexpr (Epi::HAS_BASE) {
    f32x4 bs[16];
#pragma unroll
    for (int it = 0; it < 16; ++it) bs[it] = epi.load_base(row0 + it * 16 + rr, col0 + c4);
#pragma unroll
    for (int mi = 0; mi < 2; ++mi)
#pragma unroll
      for (int ni = 0; ni < 2; ++ni)
#pragma unroll
        for (int r = 0; r < 16; ++r) tile[(rb + mi * 32 + crow(r, hi)) * EP_STR + cb + ni * 32] = acc[mi * 2 + ni][r];
    __syncthreads();
#pragma unroll
    for (int it = 0; it < 16; ++it) {
      const int row = it * 16 + rr;
      const f32x4 v = *(const f32x4*)(tile + row * EP_STR + c4);
      epi.store(row0 + row, col0 + c4, v, bs[it]);
    }
  } else {
#pragma unroll
    for (int mi = 0; mi < 2; ++mi)
#pragma unroll
      for (int ni = 0; ni < 2; ++ni)
#pragma unroll
        for (int r = 0; r < 16; ++r) tile[(rb + mi * 32 + crow(r, hi)) * EP_STR + cb + ni * 32] = acc[mi * 2 + ni][r];
    __syncthreads();
#pragma unroll 4
    for (int it = 0; it < 16; ++it) {
      const int row = it * 16 + rr;
      const f32x4 v = *(const f32x4*)(tile + row * EP_STR + c4);
      epi(row0 + row, col0 + c4, v);
    }
  }
  __syncthreads();
}

template <class Epi>
DI void gemm_phase(const bf16_t* A, int lda, int a_kstride, const bf16_t* Bt, int ldb, int M, int N, int K, const Epi& epi, char* smem, int bid = -1, int nb = 0) {
  if (bid < 0) { bid = (int)blockIdx.x; nb = (int)gridDim.x; }
  const int ntn = N / G_BN, total = (M / G_BM) * ntn;
  for (int L = bid; L < total; L += nb) {
    const int wg = (L & 7) * (total >> 3) + (L >> 3);
    const int pm = wg / ntn, pn = wg - pm * ntn;
    f32x16 acc[4];
    gemm_mainloop<0>(A + (size_t)pn * a_kstride, lda, Bt, ldb, K, pm * G_BM, pn * G_BN, acc, smem);
    gemm_epi_rows(acc, pm * G_BM, pn * G_BN, epi, smem);
  }
}

DI u32x2 pk4(const f32x4& v, float s) { return u32x2{pk2(v[0] * s, v[1] * s), pk2(v[2] * s, v[3] * s)}; }
struct EpiInproj {
  static constexpr bool HAS_BASE = false;
  bf16_t* lat; bf16_t* qs; bf16_t* ks; bf16_t* vs;
  DI void operator()(int row, int col, const f32x4& v) const {
    if (col < 448) *(u32x2*)(lat + (size_t)row * 448 + col) = pk4(v, 1.0f);
    else if (col < 960) *(u32x2*)(qs + (size_t)row * 512 + (col - 448)) = pk4(v, SWA_QSCALE);
    else if (col < 1088) *(u32x2*)(ks + (size_t)row * 128 + (col - 960)) = pk4(v, 1.0f);
    else if (col < 1216) *(u32x2*)(vs + (size_t)row * 128 + (col - 1088)) = pk4(v, 1.0f);
  }
};
struct EpiBf16 { static constexpr bool HAS_BASE = false; bf16_t* out; int ld; float scale; DI void operator()(int row, int col, const f32x4& v) const { *(u32x2*)(out + (size_t)row * ld + col) = pk4(v, scale); } };
struct EpiBf16T { static constexpr bool HAS_BASE = false; bf16_t* out; int ld; DI void operator()(int row, int col, const f32x4& v) const {
#pragma unroll
  for (int j = 0; j < 4; ++j) out[(size_t)(col + j) * ld + row] = f2bf(v[j]); } };
struct EpiResid { static constexpr bool HAS_BASE = true; const float* base; float* out; int ld; float scale;
  DI f32x4 load_base(int row, int col) const { return *(const f32x4*)(base + (size_t)row * ld + col); }
  DI void store(int row, int col, const f32x4& v, const f32x4& b) const { *(f32x4*)(out + (size_t)row * ld + col) = b + v * scale; } };

namespace g8 {
#define PG8_LAS __attribute__((address_space(3)))
constexpr int BM = 256, BK = 64, HALF = 128, HTB = HALF * BK * 2, NXCD = 8, WGM = 8;
DI int lds_byte(int r, int c) { const int st = (r >> 4) * 2 + (c >> 5), rr = r & 15, cc = c & 31, ob = rr * 64 + cc * 2; return st * 1024 + (ob ^ (((ob >> 9) & 1) << 5)); }
DI void stage_rc(int b, int& R, int& C) { const int st = b / 1024, sb = b % 1024, swz = sb ^ (((sb >> 9) & 1) << 5); R = (st >> 1) * 16 + swz / 64; C = (st & 1) * 32 + (swz % 64) / 2; }
DI int perm32(int rho) { const int n = rho >> 4, i = rho & 15; return 8 * (i >> 2) + 4 * n + (i & 3); }
struct Unit { int pm, pn; };
struct Gemm { const bf16_t* A; const bf16_t* Bt; int M, N, K; };
struct StaticOrder {
  int nM, nN, nwg, G, c;
  DI void init(int M, int N, int G_, int c_) { nM = M / BM; nN = N / BM; nwg = nM * nN; G = G_; c = c_; }
  DI bool next(int i, Unit& u) const {
    const long L = (long)i * G + c; if (L >= nwg) return false;
    int wgid = (int)L; { const int q = nwg / NXCD, r = nwg % NXCD, xcd = wgid % NXCD, off = wgid / NXCD; wgid = (xcd < r ? xcd * (q + 1) : r * (q + 1) + (xcd - r) * q) + off; }
    const int nig = WGM * nN, gid = wgid / nig, fm = gid * WGM, gsz = (nM - fm) < WGM ? (nM - fm) : WGM;
    u.pm = fm + ((wgid % nig) % gsz); u.pn = (wgid % nig) / gsz; return true;
  }
};
template <class Epi>
DI void gemm_phase(PG8_LAS unsigned char* lds, const Gemm g, const StaticOrder& S, const Epi& E) {
  int tid = threadIdx.x; asm volatile("" : "+v"(tid));
  const int wid = __builtin_amdgcn_readfirstlane(tid >> 6), lane = tid & 63, wr = wid >> 2, wc = wid & 3, fr = lane & 15, fq = lane >> 4;
  const int K = g.K, nt = K / BK;
  unsigned voffA[2], voffB[2];
#pragma unroll
  for (int i = 0; i < 2; ++i) { int R, C; stage_rc(tid * 16 + i * 8192, R, C); const int Rb = Epi::PERM ? ((R & ~31) + perm32(R & 31)) : R;
    voffA[i] = (unsigned)(R * K + C) * 2u; voffB[i] = (unsigned)(Rb * K + C) * 2u; }
  const size_t kstep = (size_t)(BK * 2), hstep = (size_t)HALF * K * 2, tstep = 2 * hstep;
  const unsigned ldsw = (unsigned)wid * 1024u;
  const int aoff = lds_byte(wr * 64 + fr, fq * 8), boff = lds_byte(wc * 32 + fr, fq * 8);
#define PG8_SA(b, h) (((b) * 2 + (h)) * HTB)
#define PG8_SB(b, h) ((4 + (b) * 2 + (h)) * HTB)
#define PG8_STAGE(bufoff, gbase, voff) do { _Pragma("unroll") for (int _i = 0; _i < 2; ++_i) \
    __builtin_amdgcn_global_load_lds((const unsigned*)((const char*)(gbase) + (voff)[_i]), (PG8_LAS unsigned*)(lds + (bufoff) + ldsw + _i * 8192), 16, 0, 0); } while (0)
#define PG8_LDA(dst, b, h) do { _Pragma("unroll") for (int m = 0; m < 4; ++m) _Pragma("unroll") for (int k = 0; k < 2; ++k) dst[m][k] = *(const PG8_LAS bf16x8*)(lds + PG8_SA(b, h) + aoff + m * 2048 + k * 1024); } while (0)
#define PG8_LDB(dst, b, h) do { _Pragma("unroll") for (int n = 0; n < 2; ++n) _Pragma("unroll") for (int k = 0; k < 2; ++k) dst[n][k] = *(const PG8_LAS bf16x8*)(lds + PG8_SB(b, h) + boff + n * 2048 + k * 1024); } while (0)
#define PG8_MMA(ai, bj, At, Bt) do { __builtin_amdgcn_s_setprio(1); _Pragma("unroll") for (int m = 0; m < 4; ++m) _Pragma("unroll") for (int n = 0; n < 2; ++n) _Pragma("unroll") for (int k = 0; k < 2; ++k) \
    acc[ai][bj][m][n] = __builtin_amdgcn_mfma_f32_16x16x32_bf16(Bt[n][k], At[m][k], acc[ai][bj][m][n], 0, 0, 0); __builtin_amdgcn_s_setprio(0); } while (0)
#define PG8_WAIT_V(n) asm volatile("s_waitcnt vmcnt(" #n ")" ::: "memory")
#define PG8_WAIT_L(n) asm volatile("s_waitcnt lgkmcnt(" #n ")" ::: "memory")
#define PG8_BAR __builtin_amdgcn_s_barrier()
#define PG8_SCHED __builtin_amdgcn_sched_barrier(0)
  Unit cur, nxt; int ui = 0;
  if (!S.next(0, cur)) return;
  f32x4 acc[2][2][4][2];
#pragma unroll
  for (int a = 0; a < 2; ++a)
#pragma unroll
    for (int b = 0; b < 2; ++b)
#pragma unroll
      for (int m = 0; m < 4; ++m)
#pragma unroll
        for (int n = 0; n < 2; ++n) acc[a][b][m][n] = (f32x4){0.f, 0.f, 0.f, 0.f};
  bf16x8 At[4][2], B0[2][2], B1[2][2];
  const char* cA = (const char*)g.A + (size_t)cur.pm * tstep; const char* cB = (const char*)g.Bt + (size_t)cur.pn * tstep;
  PG8_STAGE(PG8_SB(0, 0), cB, voffB); PG8_STAGE(PG8_SA(0, 0), cA, voffA); PG8_STAGE(PG8_SB(0, 1), cB + hstep, voffB); PG8_STAGE(PG8_SA(0, 1), cA + hstep, voffA);
  if (wr == 1) PG8_BAR;
  PG8_WAIT_V(4); PG8_BAR;
  PG8_STAGE(PG8_SB(1, 0), cB + kstep, voffB); PG8_STAGE(PG8_SA(1, 0), cA + kstep, voffA); PG8_STAGE(PG8_SB(1, 1), cB + hstep + kstep, voffB);
  PG8_WAIT_V(6); PG8_BAR;
  for (;;) {
    const bool has_next = S.next(ui + 1, nxt);
    const char* nA = has_next ? (const char*)g.A + (size_t)nxt.pm * tstep : cA; const char* nB = has_next ? (const char*)g.Bt + (size_t)nxt.pn * tstep : cB;
    for (int t = 0; t < nt; t += 2) {
      const bool last = (t == nt - 2);
      const char* a1 = cA + (size_t)(t + 1) * kstep;
      const char* a2 = last ? nA : cA + (size_t)(t + 2) * kstep; const char* b2 = last ? nB : cB + (size_t)(t + 2) * kstep;
      const char* a3 = a2 + kstep; const char* b3 = b2 + kstep;
      PG8_LDB(B0, 0, 0); PG8_SCHED; PG8_LDA(At, 0, 0); PG8_STAGE(PG8_SA(1, 1), a1 + hstep, voffA);
      PG8_WAIT_L(8); PG8_BAR; PG8_WAIT_L(0); PG8_MMA(0, 0, At, B0); PG8_BAR; PG8_SCHED;
      PG8_LDB(B1, 0, 1); PG8_STAGE(PG8_SB(0, 0), b2, voffB);
      PG8_BAR; PG8_WAIT_L(0); PG8_MMA(0, 1, At, B1); PG8_BAR;
      PG8_LDA(At, 0, 1); PG8_STAGE(PG8_SA(0, 0), a2, voffA);
      PG8_BAR; PG8_WAIT_L(0); PG8_MMA(1, 0, At, B0); PG8_BAR; PG8_SCHED;
      PG8_STAGE(PG8_SB(0, 1), b2 + hstep, voffB);
      PG8_WAIT_V(6); PG8_BAR; PG8_MMA(1, 1, At, B1); PG8_BAR;
      PG8_LDB(B0, 1, 0); PG8_SCHED; PG8_LDA(At, 1, 0); PG8_STAGE(PG8_SA(0, 1), a2 + hstep, voffA);
      PG8_WAIT_L(8); PG8_BAR; PG8_WAIT_L(0); PG8_MMA(0, 0, At, B0); PG8_BAR; PG8_SCHED;
      PG8_LDB(B1, 1, 1); PG8_STAGE(PG8_SB(1, 0), b3, voffB);
      PG8_BAR; PG8_WAIT_L(0); PG8_MMA(0, 1, At, B1); PG8_BAR;
      PG8_LDA(At, 1, 1); PG8_STAGE(PG8_SA(1, 0), a3, voffA);
      PG8_BAR; PG8_WAIT_L(0); PG8_MMA(1, 0, At, B0); PG8_BAR; PG8_SCHED;
      PG8_STAGE(PG8_SB(1, 1), b3 + hstep, voffB);
      PG8_WAIT_V(6); PG8_BAR; PG8_MMA(1, 1, At, B1); PG8_BAR;
    }
    E(acc, cur, wr, wc, fr, fq);
    if (!has_next) break;
#pragma unroll
    for (int a = 0; a < 2; ++a)
#pragma unroll
      for (int b = 0; b < 2; ++b)
#pragma unroll
        for (int m = 0; m < 4; ++m)
#pragma unroll
          for (int n = 0; n < 2; ++n) acc[a][b][m][n] = (f32x4){0.f, 0.f, 0.f, 0.f};
    cur = nxt; cA = nA; cB = nB; ++ui;
  }
  PG8_WAIT_V(0);
  if (wr == 0) PG8_BAR;
  PG8_BAR;
#undef PG8_SA
#undef PG8_SB
#undef PG8_STAGE
#undef PG8_LDA
#undef PG8_LDB
#undef PG8_MMA
#undef PG8_WAIT_V
#undef PG8_WAIT_L
#undef PG8_BAR
#undef PG8_SCHED
}
DI u32x4 pk8(const f32x4& v0, const f32x4& v1, float s) { return u32x4{pk2(v0[0] * s, v0[1] * s), pk2(v0[2] * s, v0[3] * s), pk2(v1[0] * s, v1[1] * s), pk2(v1[2] * s, v1[3] * s)}; }
struct EpiBf16 {
  static constexpr bool PERM = true;
  bf16_t* out; int ld; float scale;
  DI void operator()(const f32x4 (&acc)[2][2][4][2], const Unit& u, int wr, int wc, int fr, int fq) const {
    const int row0 = u.pm * BM + wr * 64 + fr, col0 = u.pn * BM + wc * 32 + 8 * fq;
#pragma unroll
    for (int ai = 0; ai < 2; ++ai)
#pragma unroll
      for (int m = 0; m < 4; ++m) { bf16_t* rowp = out + (size_t)(row0 + ai * HALF + m * 16) * ld + col0;
#pragma unroll
        for (int bj = 0; bj < 2; ++bj) *(u32x4*)(rowp + bj * HALF) = pk8(acc[ai][bj][m][0], acc[ai][bj][m][1], scale); }
  }
};
struct EpiInproj {
  static constexpr bool PERM = true;
  bf16_t* lat; bf16_t* qs; bf16_t* ks; bf16_t* vs; bf16_t* cqr;
  DI void operator()(const f32x4 (&acc)[2][2][4][2], const Unit& u, int wr, int wc, int fr, int fq) const {
    const int row0 = u.pm * BM + wr * 64 + fr;
#pragma unroll
    for (int bj = 0; bj < 2; ++bj) {
      const int cw = u.pn * BM + bj * HALF + wc * 32;
      bf16_t* dst; int ld; float sc = 1.0f;
      if (cw < 256) { dst = cqr + cw; ld = 256; } else if (cw < 448) { dst = lat + cw; ld = 448; } else if (cw < 960) { dst = qs + (cw - 448); ld = 512; sc = SWA_QSCALE; }
      else if (cw < 1088) { dst = ks + (cw - 960); ld = 128; } else if (cw < 1216) { dst = vs + (cw - 1088); ld = 128; } else continue;
#pragma unroll
      for (int ai = 0; ai < 2; ++ai)
#pragma unroll
        for (int m = 0; m < 4; ++m) *(u32x4*)(dst + (size_t)(row0 + ai * HALF + m * 16) * ld + 8 * fq) = pk8(acc[ai][bj][m][0], acc[ai][bj][m][1], sc);
    }
  }
};
template <bool BASE_F32>
struct EpiResid16 {
  static constexpr bool PERM = true;
  const void* base; bf16_t* out; int ld; float scale; float* ssqp = nullptr;
  DI void operator()(const f32x4 (&acc)[2][2][4][2], const Unit& u, int wr, int wc, int fr, int fq) const {
    static_assert(!BASE_F32, "bf16 base only");
    const int row0 = u.pm * BM + wr * 64 + fr, col0 = u.pn * BM + wc * 32 + 8 * fq;
#pragma unroll
    for (int ai = 0; ai < 2; ++ai) {
      u32x4 bw[4][2];
#pragma unroll
      for (int m = 0; m < 4; ++m) { const size_t ro = (size_t)(row0 + ai * HALF + m * 16) * ld + col0;
#pragma unroll
        for (int bj = 0; bj < 2; ++bj) bw[m][bj] = *(const u32x4*)((const bf16_t*)base + ro + bj * HALF); }
      asm volatile("" ::: "memory");
#pragma unroll
      for (int m = 0; m < 4; ++m) { const size_t ro = (size_t)(row0 + ai * HALF + m * 16) * ld + col0;
        f32x4 b[2][2];
#pragma unroll
        for (int bj = 0; bj < 2; ++bj) { const u32x4 w = bw[m][bj];
          b[bj][0] = f32x4{bflo(w[0]), bfhi(w[0]), bflo(w[1]), bfhi(w[1])}; b[bj][1] = f32x4{bflo(w[2]), bfhi(w[2]), bflo(w[3]), bfhi(w[3])}; }
#pragma unroll
        for (int bj = 0; bj < 2; ++bj) *(u32x4*)(out + ro + bj * HALF) = pk8(b[bj][0] + acc[ai][bj][m][0] * scale, b[bj][1] + acc[ai][bj][m][1] * scale, 1.0f);
        if (ssqp) {
          float s = 0.f;
#pragma unroll
          for (int bj = 0; bj < 2; ++bj)
#pragma unroll
            for (int h = 0; h < 2; ++h) { const f32x4 v = b[bj][h] + acc[ai][bj][m][h] * scale; s += v[0] * v[0] + v[1] * v[1] + v[2] * v[2] + v[3] * v[3]; }
          s += __shfl_xor(s, 16); s += __shfl_xor(s, 32);
          if (fq == 0) ssqp[(size_t)(row0 + ai * HALF + m * 16) * 16 + u.pn * 4 + wc] = s;
        }
      }
      asm volatile("" ::: "memory");
    }
  }
};
template <class Epi>
DI void run_on(const bf16_t* A, const bf16_t* Bt, int M, int N, int K, const Epi& E, char* smem, int c, int G) {
  StaticOrder S; S.init(M, N, G, c);
  gemm_phase<Epi>((PG8_LAS unsigned char*)smem, Gemm{A, Bt, M, N, K}, S, E);
  __syncthreads();
}
template <class Epi>
DI void run(const bf16_t* A, const bf16_t* Bt, int M, int N, int K, const Epi& E, char* smem) { run_on(A, Bt, M, N, K, E, smem, (int)blockIdx.x, (int)gridDim.x); }
}

DI int tokey(float f) { const int u = __float_as_int(f); return u ^ ((u >> 31) & 0x7fffffff); }
DI float fromkey(int k) { return __int_as_float(k ^ ((k >> 31) & 0x7fffffff)); }
DI void ins16(int (&top)[16], int key) {
#pragma unroll
  for (int j = 0; j < 16; ++j) { const int h = max(top[j], key); key = min(top[j], key); top[j] = h; }
}

DI void score_phase(const Params& p, char* smem) {
  const int ntn = T / G_BN, total = (2048 / G_BM) * ntn;
  for (int L = blockIdx.x; L < total; L += gridDim.x) {
    const int wg = (L & 7) * (total >> 3) + (L >> 3);
    const int pn = wg >> 3, pm = wg & 7;
    f32x16 acc[4];
    gemm_mainloop<1>(p.wt_sc, DM, p.X16, DM, DM, pm * G_BM, pn * G_BN, acc, smem);
    SBAR();
    int tid_ = threadIdx.x; asm volatile("" : "+v"(tid_));
    const int tid = tid_, lane = tid & 63, wid = tid >> 6, r32 = lane & 31, hi = lane >> 5;
    const int group = pm * 2 + (wid >> 2);
    const int tok = pn * G_BN + (wid & 3) * 32 + r32;
    int top[16];
    {
      int g[4][16];
#pragma unroll
      for (int mi = 0; mi < 4; ++mi)
#pragma unroll
        for (int r = 0; r < 16; ++r) { const int n = 32 * mi + crow(r, hi); g[mi][r] = (tokey(acc[mi][r]) & ~127) | (127 - n); }
      auto sort16 = [](int (&a)[16]) {
#define CE_(i, j) { const int x_ = max(a[i], a[j]), y_ = min(a[i], a[j]); a[i] = x_; a[j] = y_; }
        CE_(0, 13) CE_(1, 12) CE_(2, 15) CE_(3, 14) CE_(4, 8) CE_(5, 6) CE_(7, 11) CE_(9, 10)
        CE_(0, 5) CE_(1, 7) CE_(2, 9) CE_(3, 4) CE_(6, 13) CE_(8, 14) CE_(10, 15) CE_(11, 12)
        CE_(0, 1) CE_(2, 3) CE_(4, 5) CE_(6, 8) CE_(7, 9) CE_(10, 11) CE_(12, 13) CE_(14, 15)
        CE_(0, 2) CE_(1, 3) CE_(4, 10) CE_(5, 11) CE_(6, 7) CE_(8, 9) CE_(12, 14) CE_(13, 15)
        CE_(1, 2) CE_(3, 12) CE_(4, 6) CE_(5, 7) CE_(8, 10) CE_(9, 11) CE_(13, 14)
        CE_(1, 4) CE_(2, 6) CE_(5, 8) CE_(7, 10) CE_(9, 13) CE_(11, 14)
        CE_(2, 4) CE_(3, 6) CE_(9, 12) CE_(11, 13)
        CE_(3, 5) CE_(6, 8) CE_(7, 9) CE_(10, 12)
        CE_(3, 4) CE_(5, 6) CE_(7, 8) CE_(9, 10) CE_(11, 12)
        CE_(6, 7) CE_(8, 9)
#undef CE_
      };
      sort16(g[0]); sort16(g[1]); sort16(g[2]); sort16(g[3]);
      auto merge16 = [](int (&a)[16], const int (&b)[16]) {
#pragma unroll
        for (int i = 0; i < 16; ++i) a[i] = max(a[i], b[15 - i]);
#pragma unroll
        for (int d = 8; d >= 1; d >>= 1)
#pragma unroll
          for (int i = 0; i < 16; ++i) if ((i & d) == 0) { const int x = max(a[i], a[i + d]), y = min(a[i], a[i + d]); a[i] = x; a[i + d] = y; }
      };
      merge16(g[0], g[1]); merge16(g[2], g[3]); merge16(g[0], g[2]);
#pragma unroll
      for (int i = 0; i < 16; ++i) top[i] = g[0][i];
    }
    int c[16];
#pragma unroll
    for (int j = 0; j < 16; ++j) {
      auto rr = __builtin_amdgcn_permlane32_swap((unsigned)top[15 - j], (unsigned)top[15 - j], false, false);
      const int other = hi ? (int)rr[0] : (int)rr[1];
      c[j] = max(top[j], other);
    }
#pragma unroll
    for (int d = 8; d >= 1; d >>= 1)
#pragma unroll
      for (int i = 0; i < 16; ++i) if ((i & d) == 0) { const int a = max(c[i], c[i + d]), b = min(c[i], c[i + d]); c[i] = a; c[i + d] = b; }
    int* dst = p.top1 + ((size_t)tok * 16 + group) * 16 + hi * 8;
    if (hi == 0) { *(i32x4*)dst = i32x4{c[0], c[1], c[2], c[3]}; *(i32x4*)(dst + 4) = i32x4{c[4], c[5], c[6], c[7]}; }
    else         { *(i32x4*)dst = i32x4{c[8], c[9], c[10], c[11]}; *(i32x4*)(dst + 4) = i32x4{c[12], c[13], c[14], c[15]}; }
    SBAR();
  }
}

DI void ins16s(int (&top)[16], int key, int s0) {
#pragma unroll
  for (int j = 0; j < 16; ++j) if (j >= s0) { const int h = max(top[j], key); key = min(top[j], key); top[j] = h; }
}
DI void ins16v(float (&bv)[16], int (&bp)[16], float v, int pl) {
#pragma unroll
  for (int j = 0; j < 16; ++j) { const bool c = v > bv[j]; const float nv = c ? bv[j] : v; const int np = c ? bp[j] : pl; bv[j] = c ? v : bv[j]; bp[j] = c ? pl : bp[j]; v = nv; pl = np; }
}
DI void topk2_phase(const Params& p) {
  const int nitems = T * 8;
  for (int it = GTID(); it < nitems; it += gridDim.x * NTHREADS) {
    const int* src = p.top1 + (size_t)it * 32;
    int ka[16], kb[16];
#pragma unroll
    for (int q = 0; q < 4; ++q) { const i32x4 v = *(const i32x4*)(src + 4 * q); ka[4 * q] = v[0]; ka[4 * q + 1] = v[1]; ka[4 * q + 2] = v[2]; ka[4 * q + 3] = v[3]; }
#pragma unroll
    for (int q = 0; q < 4; ++q) { const i32x4 v = *(const i32x4*)(src + 16 + 4 * q); kb[4 * q] = v[0]; kb[4 * q + 1] = v[1]; kb[4 * q + 2] = v[2]; kb[4 * q + 3] = v[3]; }
    float av[16], bvv[16]; int ia[16], ib[16];
#pragma unroll
    for (int i = 0; i < 16; ++i) { av[i] = fromkey(ka[i] & ~127); ia[i] = (127 - (ka[i] & 127)) << 7; bvv[i] = fromkey(kb[i] & ~127); ib[i] = 127 - (kb[i] & 127); }
    int best[16];
#pragma unroll
    for (int j = 0; j < 16; ++j) best[j] = (tokey(av[0] + bvv[j]) & ~0x3fff) | ia[0] | ib[j];
#pragma unroll
    for (int i = 1; i < 16; ++i)
#pragma unroll
      for (int j = 0; j < 16; ++j)
        if ((i + 1) * (j + 1) <= 16) ins16s(best, (tokey(av[i] + bvv[j]) & ~0x3fff) | ia[i] | ib[j], (i + 1) * (j + 1) - 1);
    float bv[16]; int bp[16];
#pragma unroll
    for (int j = 0; j < 16; ++j) { bv[j] = fromkey(best[j] & ~0x3fff); bp[j] = best[j] & 0x3fff; }
    float m = bv[0];
#pragma unroll
    for (int j = 1; j < 16; ++j) m = fmaxf(m, bv[j]);
    const float rsl = p.rs3[it >> 3] * LOG2E;
    float w[16], sum = 0.f;
#pragma unroll
    for (int j = 0; j < 16; ++j) { w[j] = __builtin_amdgcn_exp2f((bv[j] - m) * rsl); sum += w[j]; }
    const float inv = 1.0f / sum;
    unsigned short* di = p.pidx + (size_t)it * 16; float* dg = p.pg + (size_t)it * 16;
#pragma unroll
    for (int q = 0; q < 4; ++q) {
      *(u32x2*)(di + 4 * q) = u32x2{(unsigned)bp[4 * q] | ((unsigned)bp[4 * q + 1] << 16), (unsigned)bp[4 * q + 2] | ((unsigned)bp[4 * q + 3] << 16)};
#if DBG == 5
      *(f32x4*)(dg + 4 * q) = f32x4{0.0625f, 0.0625f, 0.0625f, 0.0625f};
#else
      *(f32x4*)(dg + 4 * q) = f32x4{w[4 * q] * inv, w[4 * q + 1] * inv, w[4 * q + 2] * inv, w[4 * q + 3] * inv};
#endif
    }
  }
}

template <int NDB> DI int v_st(int k, int c) { const int kk = (k & ~0xC) | ((k & 4) << 1) | ((k & 8) >> 1); return ((kk >> 3) * NDB + (c >> 5)) * 512 + ((kk & 7) * 32 + (c & 31)) * 2; }
DI int v_rd_base(int lane) { return ((lane & 3) << 3) | (((lane >> 2) & 3) << 6) | (((lane >> 4) & 1) << 5) | (((lane >> 5) & 1) << 8); }
template <int OFF> DI s16x4 tr_read(int vb) { s16x4 r; asm volatile("ds_read_b64_tr_b16 %0, %1 offset:%2" : "=&v"(r) : "v"(vb), "i"(OFF) : "memory"); return r; }
template <int NDB, int D0> DI void pv_one(f32x16& od, int vb, bf16x8 pa0, bf16x8 pa1, bf16x8 pa2, bf16x8 pa3) {
  constexpr int KS = 2 * NDB * 512, HF = NDB * 512;
  const s16x4 l0 = tr_read<D0 * 512 + 0 * KS>(vb), h0 = tr_read<D0 * 512 + 0 * KS + HF>(vb), l1 = tr_read<D0 * 512 + 1 * KS>(vb), h1 = tr_read<D0 * 512 + 1 * KS + HF>(vb);
  const s16x4 l2 = tr_read<D0 * 512 + 2 * KS>(vb), h2 = tr_read<D0 * 512 + 2 * KS + HF>(vb), l3 = tr_read<D0 * 512 + 3 * KS>(vb), h3 = tr_read<D0 * 512 + 3 * KS + HF>(vb);
  asm volatile("s_waitcnt lgkmcnt(0)" ::: "memory"); SBAR();
#define PKV(L, H) (bf16x8){L[0], L[1], L[2], L[3], H[0], H[1], H[2], H[3]}
  od = MFMA32(pa0, PKV(l0, h0), od); od = MFMA32(pa1, PKV(l1, h1), od); od = MFMA32(pa2, PKV(l2, h2), od); od = MFMA32(pa3, PKV(l3, h3), od);
#undef PKV
}

template <int OFF> DI void pv_rd4(int vb, s16x4 (&l)[2], s16x4 (&h)[2]) {
  constexpr int KS = 2 * 4 * 512, HF = 4 * 512;
  l[0] = tr_read<OFF>(vb); h[0] = tr_read<OFF + HF>(vb); l[1] = tr_read<OFF + KS>(vb); h[1] = tr_read<OFF + KS + HF>(vb);
}
#define PKV(L, H) (bf16x8){L[0], L[1], L[2], L[3], H[0], H[1], H[2], H[3]}
DI void pv_all4(f32x16 (&o)[4], int vb, bf16x8 pa0, bf16x8 pa1, bf16x8 pa2, bf16x8 pa3) {
  constexpr int KS2 = 2 * 2 * 4 * 512;
  s16x4 la[2], ha[2], lb[2], hb[2];
  pv_rd4<0 * 512>(vb, la, ha); pv_rd4<0 * 512 + KS2>(vb, lb, hb);
#define PV_STEP(D, NEXTA, NEXTB) \
  asm volatile("s_waitcnt lgkmcnt(4)" ::: "memory"); SBAR(); \
  o[D] = MFMA32(pa0, PKV(la[0], ha[0]), o[D]); o[D] = MFMA32(pa1, PKV(la[1], ha[1]), o[D]); SBAR(); \
  NEXTA; \
  asm volatile("s_waitcnt lgkmcnt(4)" ::: "memory"); SBAR(); \
  o[D] = MFMA32(pa2, PKV(lb[0], hb[0]), o[D]); o[D] = MFMA32(pa3, PKV(lb[1], hb[1]), o[D]); SBAR(); \
  NEXTB;
  PV_STEP(0, (pv_rd4<1 * 512>(vb, la, ha)), (pv_rd4<1 * 512 + KS2>(vb, lb, hb)))
  PV_STEP(1, (pv_rd4<2 * 512>(vb, la, ha)), (pv_rd4<2 * 512 + KS2>(vb, lb, hb)))
  PV_STEP(2, (pv_rd4<3 * 512>(vb, la, ha)), (pv_rd4<3 * 512 + KS2>(vb, lb, hb)))
  asm volatile("s_waitcnt lgkmcnt(4)" ::: "memory"); SBAR();
  o[3] = MFMA32(pa0, PKV(la[0], ha[0]), o[3]); o[3] = MFMA32(pa1, PKV(la[1], ha[1]), o[3]); SBAR();
  asm volatile("s_waitcnt lgkmcnt(0)" ::: "memory"); SBAR();
  o[3] = MFMA32(pa2, PKV(lb[0], hb[0]), o[3]); o[3] = MFMA32(pa3, PKV(lb[1], hb[1]), o[3]);
#undef PV_STEP
}
#undef PKV

template <int DQK, int DV, int MODE>
struct AttnArgs {
  const bf16_t* Kb; int ldk;
  const bf16_t* Vb; int ldv;
  int jt0, NT;
  int tq;
  int diag_tile;
  int tw0;
  float slope2, sink2;
  bf16_t* Ow; int ldo;
};

template <int DQK, int DV, int MODE, int QL>
DI void attn_unit(const bf16x8 (&qr)[DQK / 16 - QL], const AttnArgs<DQK, DV, MODE>& a, char* smem) {
  constexpr int NKS = DQK / 16, NDB = DV / 32, KSTR = DQK * 2 + 16, KBUF = 64 * KSTR, VBUF = 64 * DV * 2, BUF = KBUF + VBUF, NKC = DQK / 64, NVC = DV / 64;
  const int tid = threadIdx.x, wid = __builtin_amdgcn_readfirstlane(tid >> 6), lane = tid & 63, r32 = lane & 31, hi = lane >> 5;
  const bool rot = (wid >= 4);
  float* wsf = (float*)(smem + 3 * BUF) + wid * 64; float* li_l = wsf; float* al_l = wsf + 32;
  const char* qlds = smem + 3 * BUF + 2048 + wid * 4096 + r32 * 128;
  const int qx = (r32 >> 1) & 7;
  float m_reg = -1e30f, l_reg = 0.f; f32x16 o[NDB];
#pragma unroll
  for (int d = 0; d < NDB; ++d) o[d] = f32x16{};
  const int srow = tid >> 3, c8 = tid & 7;
  const int vb0 = (int)(uintptr_t)smem + v_rd_base(lane);
  bf16x8 kst[NKC], vst[(MODE == 0) ? 1 : NVC];
  auto sload = [&](int jt) {
    const size_t krow = (size_t)(jt * 64 + srow);
#pragma unroll
    for (int i = 0; i < NKC; ++i) kst[i] = *(const bf16x8*)(a.Kb + krow * a.ldk + 64 * i + 8 * c8);
    if (MODE != 0) {
#pragma unroll
      for (int i = 0; i < NVC; ++i) vst[i] = *(const bf16x8*)(a.Vb + krow * a.ldv + 64 * i + 8 * c8);
    }
  };
  auto swrite = [&](int b) {
    char* bp = smem + b * BUF;
#pragma unroll
    for (int i = 0; i < NKC; ++i) *(bf16x8*)(bp + VBUF + srow * KSTR + (64 * i + 8 * c8) * 2) = kst[i];
    if (MODE == 0) {
#pragma unroll
      for (int i = 0; i < NVC; ++i) *(bf16x8*)(bp + v_st<NDB>(srow, 64 * i + 8 * c8)) = kst[i];
    } else {
#pragma unroll
      for (int i = 0; i < NVC; ++i) *(bf16x8*)(bp + v_st<NDB>(srow, 64 * i + 8 * c8)) = vst[i];
    }
  };
  auto tile_active = [&](int jt) -> bool { if (MODE == 2) return (jt * 64 + 63 >= a.tw0 - 127) && (jt * 64 <= a.tw0 + 31); return true; };
  f32x16 p0, p1;
  auto qkt = [&](int b) {
    p0 = f32x16{}; p1 = f32x16{};
    const char* Kc = smem + b * BUF + VBUF + r32 * KSTR + hi * 16;
    __builtin_amdgcn_s_setprio(1);
#pragma unroll
    for (int s = 0; s < NKS - QL; ++s) {
      const bf16x8 b0 = *(const bf16x8*)(Kc + s * 32), b1 = *(const bf16x8*)(Kc + 32 * KSTR + s * 32);
      p0 = MFMA32(b0, qr[s], p0); p1 = MFMA32(b1, qr[s], p1);
    }
#pragma unroll
    for (int s = NKS - QL; s < NKS; ++s) {
      const bf16x8 b0 = *(const bf16x8*)(Kc + s * 32), b1 = *(const bf16x8*)(Kc + 32 * KSTR + s * 32);
      const bf16x8 qf = *(const bf16x8*)(qlds + (((2 * (s - (NKS - QL)) + hi) ^ qx) << 4));
      p0 = MFMA32(b0, qf, p0); p1 = MFMA32(b1, qf, p1);
    }
    __builtin_amdgcn_s_setprio(0);
  };
  sload(a.jt0); swrite(0);
  if (a.NT > 1) { sload(a.jt0 + 1); swrite(1); }
  __syncthreads();
  if (rot && tile_active(a.jt0)) qkt(0);
  int cur = 0;
  for (int j = 0; j < a.NT; ++j) {
    const int jt = a.jt0 + j;
    int nxt = cur + 1; if (nxt == 3) nxt = 0;
    int nx2 = nxt + 1; if (nx2 == 3) nx2 = 0;
    if (j + 2 < a.NT) sload(jt + 2);
    const bool active = tile_active(jt);
    if (active) {
      if (!rot) qkt(cur);
      if (MODE == 0) {
        if (jt == a.diag_tile) {
          const int tl = a.tq & 63;
#pragma unroll
          for (int r = 0; r < 16; ++r) { const int kl = crow(r, hi); if (kl > tl) p0[r] = -INFINITY; if (kl + 32 > tl) p1[r] = -INFINITY; }
        }
      } else if (MODE == 2) {
#pragma unroll
        for (int r = 0; r < 16; ++r) {
          const int d0 = a.tq - (jt * 64 + crow(r, hi)), d1 = d0 - 32;
          p0[r] = (d0 >= 0 && d0 < 128) ? p0[r] - a.slope2 * (float)d0 : -INFINITY;
          p1[r] = (d1 >= 0 && d1 < 128) ? p1[r] - a.slope2 * (float)d1 : -INFINITY;
        }
      }
      float pmax = p0[0];
#pragma unroll
      for (int r = 1; r < 16; ++r) pmax = fmaxf(pmax, p0[r]);
#pragma unroll
      for (int r = 0; r < 16; ++r) pmax = fmaxf(pmax, p1[r]);
      { auto rr = __builtin_amdgcn_permlane32_swap(__float_as_uint(pmax), __float_as_uint(pmax), false, false); pmax = fmaxf(__uint_as_float(rr[0]), __uint_as_float(rr[1])); }
      float mn, alpha;
      if (__all(pmax - m_reg <= SM_THR)) { mn = m_reg; alpha = 1.f; }
      else { mn = fmaxf(m_reg, pmax); alpha = __builtin_amdgcn_exp2f(m_reg - mn); m_reg = mn; }
#pragma unroll
      for (int r = 0; r < 16; ++r) { p0[r] = __builtin_amdgcn_exp2f(p0[r] - mn); p1[r] = __builtin_amdgcn_exp2f(p1[r] - mn); }
      float ps = 0.f;
#pragma unroll
      for (int r = 0; r < 16; ++r) ps += p0[r] + p1[r];
      { auto rr = __builtin_amdgcn_permlane32_swap(__float_as_uint(ps), __float_as_uint(ps), false, false); ps = __uint_as_float(rr[0]) + __uint_as_float(rr[1]); }
      l_reg = l_reg * alpha + ps;
      if (__any(alpha < 1.f)) {
        if (hi == 0) al_l[r32] = alpha;
        asm volatile("s_waitcnt lgkmcnt(0)" ::: "memory");
#pragma unroll
        for (int r = 0; r < 16; ++r) { const float al = al_l[crow(r, hi)];
#pragma unroll
          for (int d = 0; d < NDB; ++d) o[d][r] *= al; }
      }
      bf16x8 pa0, pa1, pa2, pa3;
#define PK4(P, BASE, OUT) do { const unsigned a0 = pk2(P[BASE + 0], P[BASE + 1]), a1 = pk2(P[BASE + 2], P[BASE + 3]);   \
      const unsigned b0_ = pk2(P[BASE + 4], P[BASE + 5]), b1_ = pk2(P[BASE + 6], P[BASE + 7]);                          \
      auto r0 = __builtin_amdgcn_permlane32_swap(a0, b0_, false, false); auto r1 = __builtin_amdgcn_permlane32_swap(a1, b1_, false, false); \
      u32x4 w = {r0[0], r1[0], r0[1], r1[1]}; OUT = __builtin_bit_cast(bf16x8, w); } while (0)
      PK4(p0, 0, pa0); PK4(p0, 8, pa1); PK4(p1, 0, pa2); PK4(p1, 8, pa3);
#undef PK4
      const int vb = vb0 + cur * BUF;
      __builtin_amdgcn_s_setprio(1);
      pv_one<NDB, 0>(o[0], vb, pa0, pa1, pa2, pa3);
      pv_one<NDB, 1>(o[1], vb, pa0, pa1, pa2, pa3);
      if constexpr (NDB > 2) { pv_one<NDB, 2>(o[2], vb, pa0, pa1, pa2, pa3); pv_one<NDB, 3>(o[3], vb, pa0, pa1, pa2, pa3); }
      __builtin_amdgcn_s_setprio(0);
    }
    if (j + 2 < a.NT) swrite(nx2);
    if (rot && j + 1 < a.NT && tile_active(jt + 1)) qkt(nxt);
    __syncthreads();
    cur = nxt;
  }
  if (MODE == 2) l_reg += __builtin_amdgcn_exp2f(a.sink2 - m_reg);
  if (hi == 0) li_l[r32] = l_reg;
  asm volatile("s_waitcnt lgkmcnt(0)" ::: "memory");
#pragma unroll
  for (int r = 0; r < 16; ++r) {
    const int orow = crow(r, hi); const float rl = 1.0f / li_l[orow];
#pragma unroll
    for (int d = 0; d < NDB; ++d) a.Ow[(size_t)orow * a.ldo + d * 32 + r32] = f2bf(o[d][r] * rl);
  }
  __syncthreads();
}

#ifndef P8_SCL_SIGN
#define P8_SCL_SIGN 1
#endif
typedef short s16x2 __attribute__((ext_vector_type(2)));
#define MFMA32F8(a, b, c) __builtin_amdgcn_mfma_f32_32x32x16_fp8_fp8((a), (b), (c), 0, 0, 0)
typedef int i32x8u __attribute__((ext_vector_type(8)));
DI void mla_unit(const i32x8u (&q8)[3], const unsigned char* __restrict__ K8b, const unsigned char* __restrict__ Vt8b, int NT, int tl, const bf16_t* __restrict__ Wh, const float* __restrict__ gh, bf16_t* Xo, char* smem) {
  constexpr int NDB = 4, KSTR = 192, VBUF = 8192, KBUF = 64 * KSTR, BUF = VBUF + KBUF;
  const int tid = threadIdx.x, wid = __builtin_amdgcn_readfirstlane(tid >> 6), lane = tid & 63, r32 = lane & 31, hi = lane >> 5;
  float* li_l = (float*)(smem + 5 * BUF) + wid * 64;
  float* ssq = (float*)(smem + 5 * BUF + 2048);
  float l_reg = 0.f; f32x16 o[NDB];
#pragma unroll
  for (int d = 0; d < NDB; ++d) o[d] = f32x16{};
  unsigned ksrc[2];
#pragma unroll
  for (int i = 0; i < 2; ++i) { const int q = i ? (512 + wid * 32 + (lane & 31)) : tid, row = q / 12, pc = q - 12 * row, c = (pc & 12) | ((pc & 3) ^ ((row >> 2) & 3)); ksrc[i] = (unsigned)(row * 192 + c * 16); }
  const unsigned vsrc = (unsigned)((tid >> 2) * 64 + 16 * ((tid & 3) ^ ((tid >> 4) & 3)));
  const char* K8base = (const char*)K8b; const char* Vbase = (const char*)Vt8b;
  auto stage = [&](int jt, int b) {
    const char* tk = K8base + (size_t)jt * (64 * 192); const char* tv = Vbase + (size_t)jt * 8192; char* bp = smem + b * BUF + tid * 16;
    { unsigned off = vsrc; asm volatile("" : "+v"(off));
      __builtin_amdgcn_global_load_lds((const unsigned*)(tv + off), LDSP(bp), 16, 0, 0); }
    { unsigned off = ksrc[0]; asm volatile("" : "+v"(off)); __builtin_amdgcn_global_load_lds((const unsigned*)(tk + off), LDSP(bp + VBUF), 16, 0, 0); }
    if (lane < 32) { unsigned off = ksrc[1]; asm volatile("" : "+v"(off)); __builtin_amdgcn_global_load_lds((const unsigned*)(tk + off), LDSP(smem + b * BUF + VBUF + 8192 + wid * 512 + lane * 16), 16, 0, 0); }
  };
#define DSR(dst, addr, OFF) asm volatile("ds_read_b128 %0, %1 offset:%2" : "=&v"(dst) : "v"(addr), "i"(OFF) : "memory")
#define QK_WAIT(n) do { asm volatile("s_waitcnt lgkmcnt(" #n ")" ::: "memory"); SBAR(); } while (0)
#define QK_RD(A0, A1, B0, B1, pb) do { DSR(A0, ka0, (pb) * 64); DSR(A1, ka1, (pb) * 64); DSR(B0, ka0, 32 * KSTR + (pb) * 64); DSR(B1, ka1, 32 * KSTR + (pb) * 64); } while (0)
#define CAT8(X, Y) (i32x8u){(int)(X)[0], (int)(X)[1], (int)(X)[2], (int)(X)[3], (int)(Y)[0], (int)(Y)[1], (int)(Y)[2], (int)(Y)[3]}
#define MF8(A, B, C) __builtin_amdgcn_mfma_scale_f32_32x32x64_f8f6f4((A), (B), (C), 0, 0, 0, 0, 0, 0)
#define EX(i) do { if ((i) < 16) c0[(i) & 15] = __builtin_amdgcn_exp2f(c0[(i) & 15]); else c1[(i) & 15] = __builtin_amdgcn_exp2f(c1[(i) & 15]); } while (0)
#define EX4(i) do { EX(i); EX((i) + 1); EX((i) + 2); EX((i) + 3); } while (0)
#define EX6(i) do { EX4(i); EX((i) + 4); EX((i) + 5); } while (0)
  const int swz = (r32 >> 2) & 3;
  const int kofs0 = r32 * KSTR + (((2 * hi) ^ swz) << 4), kofs1 = r32 * KSTR + (((2 * hi + 1) ^ swz) << 4);
  const int vofs0 = r32 * 64 + (((2 * hi) ^ swz) << 4), vofs1 = r32 * 64 + (((2 * hi + 1) ^ swz) << 4);
  const f32x16 zero = f32x16{};
  auto qkt = [&](int b, f32x16& n0, f32x16& n1) {
    const int kb = (int)(uintptr_t)(smem + b * BUF + VBUF), ka0 = kb + kofs0, ka1 = kb + kofs1;
    u32x4 a0, a1, a2, a3, b0, b1, b2, b3;
    QK_RD(a0, a1, a2, a3, 0); QK_RD(b0, b1, b2, b3, 1);
    QK_WAIT(4); n0 = MF8(CAT8(a0, a1), q8[0], zero); n1 = MF8(CAT8(a2, a3), q8[0], zero); SBAR(); QK_RD(a0, a1, a2, a3, 2);
    QK_WAIT(4); n0 = MF8(CAT8(b0, b1), q8[1], n0); n1 = MF8(CAT8(b2, b3), q8[1], n1); SBAR();
    QK_WAIT(0); n0 = MF8(CAT8(a0, a1), q8[2], n0); n1 = MF8(CAT8(a2, a3), q8[2], n1); SBAR();
  };
#define PV_MMA(D, X, Y, PA, SC) o[D] = __builtin_amdgcn_mfma_scale_f32_32x32x64_f8f6f4(PA, CAT8(X, Y), o[D], 0, 0, 0, SC, 0, 0x7f7f7f7f)
#define V_RD(buf) do { const int vbs_ = (int)(uintptr_t)(smem + (buf) * BUF), va0_ = vbs_ + vofs0, va1_ = vbs_ + vofs1; \
    DSR(v0a, va0_, 0); DSR(v0b, va1_, 0); DSR(v1a, va0_, 2048); DSR(v1b, va1_, 2048); DSR(v2a, va0_, 4096); DSR(v2b, va1_, 4096); DSR(v3a, va0_, 6144); DSR(v3b, va1_, 6144); SBAR(); } while (0)
#define CVT_GROUP(c) do { s16x2 w0_ = {0, 0}, w1_ = {0, 0}; \
    w0_ = __builtin_amdgcn_cvt_scalef32_pk_fp8_f32(w0_, c0[4 * (c)], c0[4 * (c) + 1], scl, false); w0_ = __builtin_amdgcn_cvt_scalef32_pk_fp8_f32(w0_, c0[4 * (c) + 2], c0[4 * (c) + 3], scl, true); \
    w1_ = __builtin_amdgcn_cvt_scalef32_pk_fp8_f32(w1_, c1[4 * (c)], c1[4 * (c) + 1], scl, false); w1_ = __builtin_amdgcn_cvt_scalef32_pk_fp8_f32(w1_, c1[4 * (c) + 2], c1[4 * (c) + 3], scl, true); \
    auto rr_ = __builtin_amdgcn_permlane32_swap(__builtin_bit_cast(unsigned, w0_), __builtin_bit_cast(unsigned, w1_), false, false); \
    pa_new[(c)] = (int)rr_[0]; pa_new[4 + (c)] = (int)rr_[1]; } while (0)
#define PACK_PV() do { \
    QK_WAIT(6); PV_MMA(0, v0a, v0b, pa_prev, sc_prev); SBAR(); \
    float ps; \
    { f32x2 s2 = f32x2{c0[0], c0[1]} + f32x2{c0[2], c0[3]}, s3 = f32x2{c0[4], c0[5]} + f32x2{c0[6], c0[7]}, s4 = f32x2{c0[8], c0[9]} + f32x2{c0[10], c0[11]}, s5 = f32x2{c0[12], c0[13]} + f32x2{c0[14], c0[15]}; \
      s2 += f32x2{c1[0], c1[1]}; s3 += f32x2{c1[2], c1[3]}; s4 += f32x2{c1[4], c1[5]}; s5 += f32x2{c1[6], c1[7]}; \
      s2 += f32x2{c1[8], c1[9]}; s3 += f32x2{c1[10], c1[11]}; s4 += f32x2{c1[12], c1[13]}; s5 += f32x2{c1[14], c1[15]}; \
      s2 = (s2 + s3) + (s4 + s5); ps = s2[0] + s2[1]; } \
    l_reg += ps; \
    int ei; \
    { auto rr = __builtin_amdgcn_permlane32_swap(__float_as_uint(ps), __float_as_uint(ps), false, false); \
      ei = __builtin_amdgcn_frexp_expf(__uint_as_float(rr[0]) + __uint_as_float(rr[1])) - 7; } \
    const float scl = __uint_as_float((unsigned)(P8_SCL_SIGN * ei + 127) << 23); \
    sc_new = ei + 127; SBAR(); \
    QK_WAIT(4); PV_MMA(1, v1a, v1b, pa_prev, sc_prev); SBAR(); CVT_GROUP(0); CVT_GROUP(1); SBAR(); \
    QK_WAIT(2); PV_MMA(2, v2a, v2b, pa_prev, sc_prev); SBAR(); CVT_GROUP(2); CVT_GROUP(3); SBAR(); \
    QK_WAIT(0); PV_MMA(3, v3a, v3b, pa_prev, sc_prev); SBAR(); } while (0)
#define MLA_SYNC() do { asm volatile("s_waitcnt vmcnt(0) lgkmcnt(0)" ::: "memory"); __builtin_amdgcn_s_barrier(); asm volatile("" ::: "memory"); } while (0)
  auto body = [&](f32x16& c0, f32x16& c1, f32x16& n0, f32x16& n1, i32x8u& pa_new, int& sc_new, const i32x8u& pa_prev, const int& sc_prev, int j, int cur) {
    const int nxt = (cur == 4) ? 0 : cur + 1, stg = (cur >= 2) ? cur - 2 : cur + 3, prv = (j == 0) ? cur : ((cur == 0) ? 4 : cur - 1);
    stage(min(j + 3, NT - 1), stg);
    u32x4 v0a, v0b, v1a, v1b, v2a, v2b, v3a, v3b;
    {
      const int kb = (int)(uintptr_t)(smem + nxt * BUF + VBUF), ka0 = kb + kofs0, ka1 = kb + kofs1;
      u32x4 a0, a1, a2, a3, b0, b1, b2, b3;
      QK_RD(a0, a1, a2, a3, 0); QK_RD(b0, b1, b2, b3, 1);
      QK_WAIT(4);
      n0 = MF8(CAT8(a0, a1), q8[0], zero); SBAR(); EX6(0); SBAR();
      n1 = MF8(CAT8(a2, a3), q8[0], zero); SBAR(); EX6(6); SBAR();
      QK_RD(a0, a1, a2, a3, 2);
      QK_WAIT(4);
      n0 = MF8(CAT8(b0, b1), q8[1], n0); SBAR(); EX6(12); SBAR();
      n1 = MF8(CAT8(b2, b3), q8[1], n1); SBAR(); EX6(18); SBAR();
      QK_WAIT(0);
      n0 = MF8(CAT8(a0, a1), q8[2], n0); SBAR(); EX4(24); SBAR();
      n1 = MF8(CAT8(a2, a3), q8[2], n1); SBAR();
    }
    V_RD(prv);
    EX4(28); SBAR();
    PACK_PV();
    asm volatile("" : "+v"(n0), "+v"(n1), "+v"(o[0]), "+v"(o[1]), "+v"(o[2]), "+v"(o[3]));
    asm volatile("s_waitcnt vmcnt(3) lgkmcnt(0)" ::: "memory"); __builtin_amdgcn_s_barrier(); asm volatile("" ::: "memory");
  };
  f32x16 A0, A1, B0, B1;
  i32x8u paX = {0, 0, 0, 0, 0, 0, 0, 0}, paY = {0, 0, 0, 0, 0, 0, 0, 0}; int scX = 127, scY = 127;
  stage(0, 0);
  if (NT > 1) stage(1, 1);
  if (NT > 2) stage(2, 2);
  MLA_SYNC();
  qkt(0, A0, A1);
  int j = 0, cur = 0;
  for (; j + 2 < NT; j += 2) {
    body(A0, A1, B0, B1, paX, scX, paY, scY, j, cur); cur = (cur == 4) ? 0 : cur + 1;
    body(B0, B1, A0, A1, paY, scY, paX, scX, j + 1, cur); cur = (cur == 4) ? 0 : cur + 1;
  }
  if (j + 1 < NT) { body(A0, A1, B0, B1, paX, scX, paY, scY, j, cur); cur = (cur == 4) ? 0 : cur + 1; A0 = B0; A1 = B1; paY = paX; scY = scX; ++j; }
  {
    f32x16& c0 = A0; f32x16& c1 = A1;
    const int prv = (j == 0) ? cur : ((cur == 0) ? 4 : cur - 1);
    u32x4 v0a, v0b, v1a, v1b, v2a, v2b, v3a, v3b;
    V_RD(prv);
#pragma unroll
    for (int r = 0; r < 16; ++r) { const int kl = crow(r, hi); if (kl > tl) c0[r] = -INFINITY; if (kl + 32 > tl) c1[r] = -INFINITY; }
#pragma unroll
    for (int r = 0; r < 16; ++r) { c0[r] = __builtin_amdgcn_exp2f(c0[r]); c1[r] = __builtin_amdgcn_exp2f(c1[r]); }
    i32x8u& pa_new = paX; int& sc_new = scX; const i32x8u& pa_prev = paY; const int& sc_prev = scY;
    PACK_PV();
    V_RD(cur);
    QK_WAIT(6); PV_MMA(0, v0a, v0b, paX, scX); QK_WAIT(4); PV_MMA(1, v1a, v1b, paX, scX); QK_WAIT(2); PV_MMA(2, v2a, v2b, paX, scX); QK_WAIT(0); PV_MMA(3, v3a, v3b, paX, scX);
    SBAR();
  }
  asm volatile("s_waitcnt vmcnt(0)" ::: "memory");
  { auto rr = __builtin_amdgcn_permlane32_swap(__float_as_uint(l_reg), __float_as_uint(l_reg), false, false); l_reg = __uint_as_float(rr[0]) + __uint_as_float(rr[1]); }
  if (hi == 0) li_l[r32] = l_reg;
  __syncthreads();
  {
    constexpr int OSTR = 272;
    char* ob = smem + wid * (32 * OSTR);
    int lo = hi * (4 * OSTR) + r32 * 2; asm volatile("" : "+v"(lo));
#pragma unroll
    for (int r = 0; r < 16; ++r) {
      const float rl = __builtin_amdgcn_rcpf(li_l[crow(r, hi)]);
#pragma unroll
      for (int d = 0; d < NDB; ++d) *(bf16_t*)(ob + lo + ((r & 3) + 8 * (r >> 2)) * OSTR + d * 64) = f2bf(o[d][r] * rl);
    }
    asm volatile("s_waitcnt lgkmcnt(0)" ::: "memory");
    bf16x8 af[8];
#pragma unroll
    for (int s = 0; s < 8; ++s) af[s] = *(const bf16x8*)(ob + r32 * OSTR + (16 * s + 8 * hi) * 2);
    SBAR();
    int wo = r32 * 128 + 8 * hi; asm volatile("" : "+v"(wo));
    const bf16_t* wbase = Wh + wo;
    f32x16 acc[4];
#pragma unroll
    for (int N = 0; N < 4; ++N) {
      acc[N] = f32x16{};
      const bf16_t* wr = wbase + N * (32 * 128);
      bf16x8 wf[8];
#pragma unroll
      for (int s = 0; s < 8; ++s) wf[s] = *(const bf16x8*)(wr + 16 * s);
#pragma unroll
      for (int s = 0; s < 8; ++s) acc[N] = MFMA32(af[s], wf[s], acc[N]);
      SBAR();
    }
    float s16[16];
#pragma unroll
    for (int r = 0; r < 16; ++r) s16[r] = acc[0][r] * acc[0][r] + acc[1][r] * acc[1][r] + acc[2][r] * acc[2][r] + acc[3][r] * acc[3][r];
    const int b4 = (lane >> 4) & 1, b3 = (lane >> 3) & 1, b2 = (lane >> 2) & 1, b1 = (lane >> 1) & 1;
    float w8[8], w4[4], w2[2];
#pragma unroll
    for (int k = 0; k < 8; ++k) { const float keep = b4 ? s16[k + 8] : s16[k], send = b4 ? s16[k] : s16[k + 8]; w8[k] = keep + __shfl_xor(send, 16); }
#pragma unroll
    for (int k = 0; k < 4; ++k) { const float keep = b3 ? w8[k + 4] : w8[k], send = b3 ? w8[k] : w8[k + 4]; w4[k] = keep + __shfl_xor(send, 8); }
#pragma unroll
    for (int k = 0; k < 2; ++k) { const float keep = b2 ? w4[k + 2] : w4[k], send = b2 ? w4[k] : w4[k + 2]; w2[k] = keep + __shfl_xor(send, 4); }
    float w1 = (b1 ? w2[1] : w2[0]) + __shfl_xor(b1 ? w2[0] : w2[1], 2);
    w1 += __shfl_xor(w1, 1);
    if ((lane & 1) == 0) ssq[(wid >> 1) * 64 + (wid & 1) * 32 + crow(8 * b4 + 4 * b3 + 2 * b2 + b1, hi)] = w1;
    __syncthreads();
    float gl[4];
    { int go = r32; asm volatile("" : "+v"(go));
#pragma unroll
      for (int N = 0; N < 4; ++N) gl[N] = gh[go + 32 * N]; }
    int xo = hi * (4 * 1024) + r32; asm volatile("" : "+v"(xo));
    bf16_t* Xp = Xo + xo;
#pragma unroll
    for (int r = 0; r < 16; ++r) {
      const int qi = (wid & 1) * 32 + crow(r, hi);
      const float rs = rsqrtf((((ssq[qi] + ssq[64 + qi]) + ssq[128 + qi]) + ssq[192 + qi]) * (1.0f / 512.0f) + EPS);
#pragma unroll
      for (int N = 0; N < 4; ++N) Xp[((r & 3) + 8 * (r >> 2)) * 1024 + N * 32] = f2bf(acc[N][r] * rs * gl[N]);
    }
  }
  __syncthreads();
#undef MLA_SYNC
#undef PACK_PV
#undef CVT_GROUP
#undef V_RD
#undef PV_MMA
#undef DSR
#undef QK_WAIT
#undef CAT8
#undef MF8
#undef EX
#undef EX4
#undef EX6
#undef QK_RD
}

typedef int i32x8 __attribute__((ext_vector_type(8)));
DI void mla_phase(const Params& p, char* smem) {
  const int tid = threadIdx.x, wid = __builtin_amdgcn_readfirstlane(tid >> 6), lane = tid & 63, r32 = lane & 31, hi = lane >> 5;
#ifndef MLA_REPS
#define MLA_REPS 1
#endif
  for (int kk = blockIdx.x; kk < 256 * MLA_REPS; kk += gridDim.x) {
    const int k = kk & 255;
#pragma unroll 1
    for (int half = 0; half < 2; ++half) {
      const int b = k & 1, i0 = k >> 1, i = half ? (255 - i0) : i0;
      const int head = wid >> 1, tq = i * 64 + (wid & 1) * 32 + r32;
      const size_t trow = (size_t)b * SEQ + tq;
      i32x8 q8[3];
      const bf16_t* qrow = p.qcat + trow * 768 + head * 192;
      const float rqs = p.rsq[trow];
      auto pack4 = [](float a, float b, float c, float d) -> int { int w = 0; w = __builtin_amdgcn_cvt_pk_fp8_f32(a, b, w, false); w = __builtin_amdgcn_cvt_pk_fp8_f32(c, d, w, true); return w; };
#pragma unroll
      for (int pb = 0; pb < 2; ++pb) {
        const bf16_t* qp = qrow + 64 * pb + 32 * hi;
#pragma unroll
        for (int c = 0; c < 4; ++c) { const bf16x8 x = *(const bf16x8*)(qp + 8 * c);
          q8[pb][2 * c] = pack4(bf2f((bf16_t)x[0]) * rqs, bf2f((bf16_t)x[1]) * rqs, bf2f((bf16_t)x[2]) * rqs, bf2f((bf16_t)x[3]) * rqs);
          q8[pb][2 * c + 1] = pack4(bf2f((bf16_t)x[4]) * rqs, bf2f((bf16_t)x[5]) * rqs, bf2f((bf16_t)x[6]) * rqs, bf2f((bf16_t)x[7]) * rqs); }
      }
      {
        const float* rp = p.rope + trow * 64;
#pragma unroll
        for (int c = 0; c < 4; ++c) {
          const bf16x8 x1 = *(const bf16x8*)(qrow + 128 + 8 * c), x2 = *(const bf16x8*)(qrow + 160 + 8 * c);
          float v[8];
#pragma unroll
          for (int j = 0; j < 8; ++j) {
            const f32x2 cs = *(const f32x2*)(rp + 2 * (8 * c + j));
            const float a1 = bf2f((bf16_t)x1[j]) * rqs, a2 = bf2f((bf16_t)x2[j]) * rqs;
            v[j] = hi ? (a2 * cs[0] + a1 * cs[1]) : (a1 * cs[0] - a2 * cs[1]);
          }
          q8[2][2 * c] = pack4(v[0], v[1], v[2], v[3]); q8[2][2 * c + 1] = pack4(v[4], v[5], v[6], v[7]);
        }
      }
      mla_unit(q8, p.k8 + (size_t)b * SEQ * 192, p.vt8 + (size_t)b * SEQ * 128, i + 1, tq & 63, p.wt_uv + (size_t)head * 128 * 128, p.out_norm_mla + head * 128, p.xn + ((size_t)b * SEQ + i * 64 + (wid & 1) * 32) * 1024 + head * 128, smem);
    }
  }
}

DI void swa_phase(const Params& p, char* smem) {
  constexpr int KSTR = 144, KBUF = 64 * KSTR, VBUF = 64 * 64 * 2, BUF = KBUF + VBUF, NDB = 2;
  int tid_ = threadIdx.x; asm volatile("" : "+v"(tid_));
  const int tid = tid_, wid = __builtin_amdgcn_readfirstlane(tid >> 6), lane = tid & 63, r32 = lane & 31, hi = lane >> 5;
  float* wsf = (float*)(smem + 8 * BUF) + wid * 64; float* li_l = wsf; float* al_l = wsf + 32;
  float* ssq = (float*)(smem + 8 * BUF + 2048);
  const int srow = tid >> 3, c8 = tid & 7;
  const int vb0 = (int)(uintptr_t)smem + v_rd_base(lane);
  for (int u = blockIdx.x; u < 256; u += gridDim.x) {
    const int i = u & 127, b = u >> 7, kvh = wid >> 2;
    const int jt0 = (i == 0) ? 0 : (2 * i - 2), NT = 2 * i + 2 - jt0;
#pragma unroll 1
    for (int kh = 0; kh < 2; ++kh) {
      bf16x8 kst[4], vst[4];
      const size_t kbase = (size_t)b * SEQ * 128 + (size_t)(jt0 * 64 + srow) * 128 + kh * 64 + 8 * c8;
#pragma unroll
      for (int q = 0; q < 4; ++q) if (q < NT) { const float rk = p.rs0[(size_t)b * SEQ + (jt0 + q) * 64 + srow];
        kst[q] = scale8(*(const bf16x8*)(p.ks + kbase + (size_t)q * (64 * 128)), rk); vst[q] = scale8(*(const bf16x8*)(p.vs + kbase + (size_t)q * (64 * 128)), rk); }
#pragma unroll
      for (int q = 0; q < 4; ++q) if (q < NT) { char* bp = smem + (kh * 4 + q) * BUF; *(bf16x8*)(bp + VBUF + srow * KSTR + 16 * c8) = kst[q]; *(bf16x8*)(bp + v_st<NDB>(srow, 8 * c8)) = vst[q]; }
    }
    __syncthreads();
    const int tw0 = i * 128 + (wid & 3) * 32, tq = tw0 + r32;
    float s16[16];
#pragma unroll
    for (int r = 0; r < 16; ++r) s16[r] = 0.f;
    const size_t trow = (size_t)b * SEQ + tq;
    const float rq0 = p.rs0[trow];
    bf16x8 qnx[4];
    { const bf16_t* qp0 = p.qs + trow * 512 + kvh * 256 + hi * 8;
#pragma unroll
      for (int s = 0; s < 4; ++s) qnx[s] = *(const bf16x8*)(qp0 + s * 16); }
#pragma unroll 1
    for (int g = 0; g < 4; ++g) {
      const int h = kvh * 4 + g;
      bf16x8 qr[4];
#pragma unroll
      for (int s = 0; s < 4; ++s) qr[s] = scale8(qnx[s], rq0);
      { const int gn = (g < 3) ? g + 1 : g; const bf16_t* qp = p.qs + trow * 512 + (kvh * 4 + gn) * 64 + hi * 8;
#pragma unroll
        for (int s = 0; s < 4; ++s) qnx[s] = *(const bf16x8*)(qp + s * 16); }
      const float slope2 = exp2f(-(float)(h + 1)) * LOG2E, sink2 = p.swa_sinks[h] * LOG2E;
      float l_reg = 0.f; f32x16 o[NDB];
#pragma unroll
      for (int d = 0; d < NDB; ++d) o[d] = f32x16{};
      for (int j = 0; j < NT; ++j) {
        const int jt = jt0 + j;
        if (!((jt * 64 + 63 >= tw0 - 127) && (jt * 64 <= tw0 + 31))) continue;
        f32x16 p0 = f32x16{}, p1 = f32x16{};
        const char* Kc = smem + (kvh * 4 + j) * BUF + VBUF + r32 * KSTR + hi * 16;
#pragma unroll
        for (int s = 0; s < 4; ++s) {
          const bf16x8 b0 = *(const bf16x8*)(Kc + s * 32), b1 = *(const bf16x8*)(Kc + 32 * KSTR + s * 32);
          p0 = MFMA32(b0, qr[s], p0); p1 = MFMA32(b1, qr[s], p1);
        }
#pragma unroll
        for (int r = 0; r < 16; ++r) {
          const int d0 = tq - (jt * 64 + crow(r, hi)), d1 = d0 - 32;
          p0[r] = (d0 >= 0 && d0 < 128) ? p0[r] - slope2 * (float)d0 : -INFINITY;
          p1[r] = (d1 >= 0 && d1 < 128) ? p1[r] - slope2 * (float)d1 : -INFINITY;
        }
#pragma unroll
        for (int r = 0; r < 16; ++r) { p0[r] = __builtin_amdgcn_exp2f(p0[r]); p1[r] = __builtin_amdgcn_exp2f(p1[r]); }
        float ps = 0.f;
#pragma unroll
        for (int r = 0; r < 16; ++r) ps += p0[r] + p1[r];
        l_reg += ps;
        bf16x8 pa0, pa1, pa2, pa3;
#define PK4(P, BASE, OUT) do { const unsigned a0 = pk2(P[BASE + 0], P[BASE + 1]), a1 = pk2(P[BASE + 2], P[BASE + 3]);   \
        const unsigned b0_ = pk2(P[BASE + 4], P[BASE + 5]), b1_ = pk2(P[BASE + 6], P[BASE + 7]);                          \
        auto r0 = __builtin_amdgcn_permlane32_swap(a0, b0_, false, false); auto r1 = __builtin_amdgcn_permlane32_swap(a1, b1_, false, false); \
        u32x4 w = {r0[0], r1[0], r0[1], r1[1]}; OUT = __builtin_bit_cast(bf16x8, w); } while (0)
        PK4(p0, 0, pa0); PK4(p0, 8, pa1); PK4(p1, 0, pa2); PK4(p1, 8, pa3);
#undef PK4
        const int vb = vb0 + (kvh * 4 + j) * BUF;
        pv_one<NDB, 0>(o[0], vb, pa0, pa1, pa2, pa3);
        pv_one<NDB, 1>(o[1], vb, pa0, pa1, pa2, pa3);
      }
      { auto rr = __builtin_amdgcn_permlane32_swap(__float_as_uint(l_reg), __float_as_uint(l_reg), false, false); l_reg = __uint_as_float(rr[0]) + __uint_as_float(rr[1]); }
      l_reg += __builtin_amdgcn_exp2f(sink2);
      if (hi == 0) li_l[r32] = l_reg;
      asm volatile("s_waitcnt lgkmcnt(0)" ::: "memory");
      bf16_t* Ow = p.ob + ((size_t)b * SEQ + tw0) * 512 + h * 64;
#pragma unroll
      for (int r = 0; r < 16; ++r) {
        const int orow = crow(r, hi); const float rl = __builtin_amdgcn_rcpf(li_l[orow]);
#pragma unroll
        for (int d = 0; d < NDB; ++d) { const bf16_t ov = f2bf(o[d][r] * rl); Ow[(size_t)orow * 512 + d * 32 + r32] = ov; const float of = bf2f(ov); s16[r] += of * of; }
      }
      asm volatile("s_waitcnt lgkmcnt(0)" ::: "memory");
    }
    {
      const int b4 = (lane >> 4) & 1, b3 = (lane >> 3) & 1, b2 = (lane >> 2) & 1, b1 = (lane >> 1) & 1;
      float w8[8], w4[4], w2[2];
#pragma unroll
      for (int k = 0; k < 8; ++k) { const float keep = b4 ? s16[k + 8] : s16[k], send = b4 ? s16[k] : s16[k + 8]; w8[k] = keep + __shfl_xor(send, 16); }
#pragma unroll
      for (int k = 0; k < 4; ++k) { const float keep = b3 ? w8[k + 4] : w8[k], send = b3 ? w8[k] : w8[k + 4]; w4[k] = keep + __shfl_xor(send, 8); }
#pragma unroll
      for (int k = 0; k < 2; ++k) { const float keep = b2 ? w4[k + 2] : w4[k], send = b2 ? w4[k] : w4[k + 2]; w2[k] = keep + __shfl_xor(send, 4); }
      float w1 = (b1 ? w2[1] : w2[0]) + __shfl_xor(b1 ? w2[0] : w2[1], 2);
      w1 += __shfl_xor(w1, 1);
      if ((lane & 1) == 0) ssq[kvh * 128 + (wid & 3) * 32 + crow(8 * b4 + 4 * b3 + 2 * b2 + b1, hi)] = w1;
    }
    __syncthreads();
    {
      const int chunk = lane & 31, rsel = lane >> 5;
      const f32x4 g0 = *(const f32x4*)(p.out_norm_swa + kvh * 256 + 8 * chunk), g1 = *(const f32x4*)(p.out_norm_swa + kvh * 256 + 8 * chunk + 4);
      const size_t tbase = (size_t)b * SEQ + tw0;
#pragma unroll 4
      for (int it = 0; it < 16; ++it) {
        const int row = 2 * it + rsel;
        const u32x4 w = *(const u32x4*)(p.ob + (tbase + row) * 512 + kvh * 256 + 8 * chunk);
        const float rs = rsqrtf((ssq[(wid & 3) * 32 + row] + ssq[128 + (wid & 3) * 32 + row]) * (1.0f / 512.0f) + EPS);
        *(u32x4*)(p.xn + (tbase + row) * 1024 + 512 + kvh * 256 + 8 * chunk) = u32x4{pk2(bflo(w[0]) * rs * g0[0], bfhi(w[0]) * rs * g0[1]), pk2(bflo(w[1]) * rs * g0[2], bfhi(w[1]) * rs * g0[3]),
                                                                                  pk2(bflo(w[2]) * rs * g1[0], bfhi(w[2]) * rs * g1[1]), pk2(bflo(w[3]) * rs * g1[2], bfhi(w[3]) * rs * g1[3])};
      }
    }
    __syncthreads();
  }
}

DI void xattn_phase(const Params& p, char* smem) {
  constexpr int KSTR = 272, VBUF = 16384, KBUF = 64 * KSTR, BUF = VBUF + KBUF;
  const int tid = threadIdx.x, wid = __builtin_amdgcn_readfirstlane(tid >> 6), lane = tid & 63, r32 = lane & 31, hi = lane >> 5;
  float* li_l = (float*)(smem + 4 * BUF) + wid * 64;
  const int vb0 = (int)(uintptr_t)smem + v_rd_base(lane);
  int staged = -1;
  for (int c = blockIdx.x; c < 512; c += gridDim.x) {
    const int pair = c & 7, b = pair >> 2, h = pair & 3, grp = c >> 3;
    const int tq = grp * 256 + wid * 32 + r32;
    const size_t trow = (size_t)b * SEQ + tq;
    bf16x8 qr[8];
    const bf16_t* qp = p.qx + trow * 512 + h * 128 + hi * 8;
#pragma unroll
    for (int s = 0; s < 8; ++s) qr[s] = *(const bf16x8*)(qp + s * 16);
    {
      float ssum = 0.f;
      { const f32x4* sp = (const f32x4*)(p.ssx + trow * 16);
#pragma unroll
        for (int i = 0; i < 4; ++i) { const f32x4 v = sp[i]; ssum += (v[0] + v[1]) + (v[2] + v[3]); } }
      const float rsq = rsqrtf(ssum * (1.0f / 1024.0f) + EPS);
#pragma unroll
      for (int s = 0; s < 8; ++s) { const u32x4 w = __builtin_bit_cast(u32x4, qr[s]);
        const u32x4 r = {pk2(bflo(w[0]) * rsq, bfhi(w[0]) * rsq), pk2(bflo(w[1]) * rsq, bfhi(w[1]) * rsq), pk2(bflo(w[2]) * rsq, bfhi(w[2]) * rsq), pk2(bflo(w[3]) * rsq, bfhi(w[3]) * rsq)};
        qr[s] = __builtin_bit_cast(bf16x8, r); }
    }
    if (pair != staged) {
      __syncthreads();
      const bf16_t* Kb = p.kvc + (size_t)b * 256 * 1024 + h * 128; const bf16_t* Vb = Kb + 512;
      const int srow = tid >> 3, c8 = tid & 7;
#pragma unroll
      for (int jt = 0; jt < 4; ++jt) {
        char* bp = smem + jt * BUF; const size_t krow = (size_t)(jt * 64 + srow);
#pragma unroll
        for (int i = 0; i < 2; ++i) {
          const bf16x8 kv = *(const bf16x8*)(Kb + krow * 1024 + 64 * i + 8 * c8), vv = *(const bf16x8*)(Vb + krow * 1024 + 64 * i + 8 * c8);
          *(bf16x8*)(bp + VBUF + srow * KSTR + (64 * i + 8 * c8) * 2) = kv;
          *(bf16x8*)(bp + v_st<4>(srow, 64 * i + 8 * c8)) = vv;
        }
      }
      __syncthreads();
      staged = pair;
    }
    float l_reg = 0.f; f32x16 o[4];
#pragma unroll
    for (int d = 0; d < 4; ++d) o[d] = f32x16{};
#pragma unroll 1
    for (int jt = 0; jt < 4; ++jt) {
      f32x16 p0 = f32x16{}, p1 = f32x16{};
      const char* Kc = smem + jt * BUF + VBUF + r32 * KSTR + hi * 16;
#pragma unroll
      for (int s = 0; s < 8; ++s) {
        const bf16x8 k0 = *(const bf16x8*)(Kc + s * 32), k1 = *(const bf16x8*)(Kc + 32 * KSTR + s * 32);
        p0 = MFMA32(k0, qr[s], p0); p1 = MFMA32(k1, qr[s], p1);
      }
#pragma unroll
      for (int r = 0; r < 16; ++r) { p0[r] = __builtin_amdgcn_exp2f(p0[r]); p1[r] = __builtin_amdgcn_exp2f(p1[r]); }
      float ps = 0.f;
#pragma unroll
      for (int r = 0; r < 16; ++r) ps += p0[r] + p1[r];
      l_reg += ps;
      bf16x8 pa0, pa1, pa2, pa3;
#define PK4(P, BASE, OUT) do { const unsigned a0 = pk2(P[BASE + 0], P[BASE + 1]), a1 = pk2(P[BASE + 2], P[BASE + 3]);   \
      const unsigned b0_ = pk2(P[BASE + 4], P[BASE + 5]), b1_ = pk2(P[BASE + 6], P[BASE + 7]);                          \
      auto r0 = __builtin_amdgcn_permlane32_swap(a0, b0_, false, false); auto r1 = __builtin_amdgcn_permlane32_swap(a1, b1_, false, false); \
      u32x4 w = {r0[0], r1[0], r0[1], r1[1]}; OUT = __builtin_bit_cast(bf16x8, w); } while (0)
      PK4(p0, 0, pa0); PK4(p0, 8, pa1); PK4(p1, 0, pa2); PK4(p1, 8, pa3);
#undef PK4
      pv_all4(o, vb0 + jt * BUF, pa0, pa1, pa2, pa3);
    }
    { auto rr = __builtin_amdgcn_permlane32_swap(__float_as_uint(l_reg), __float_as_uint(l_reg), false, false); l_reg = __uint_as_float(rr[0]) + __uint_as_float(rr[1]); }
    if (hi == 0) li_l[r32] = l_reg;
    asm volatile("s_waitcnt lgkmcnt(0)" ::: "memory");
    bf16_t* Ow = p.ox + ((size_t)b * SEQ + grp * 256 + wid * 32) * 512 + h * 128;
#pragma unroll
    for (int r = 0; r < 16; ++r) {
      const int orow = crow(r, hi); const float rl = __builtin_amdgcn_rcpf(li_l[orow]);
#pragma unroll
      for (int d = 0; d < 4; ++d) Ow[(size_t)orow * 512 + d * 32 + r32] = f2bf(o[d][r] * rl);
    }
    asm volatile("s_waitcnt lgkmcnt(0)" ::: "memory");
  }
  __syncthreads();
}

DI void norm_rows_1024(const float* in, const float* gain, bf16_t* out, int nrows, bf16_t* raw16 = nullptr) {
  const int gt_ = GTID(), lane = gt_ & 63, gw = gt_ >> 6, nw = gridDim.x * (NTHREADS / 64);
  for (int t = gw; t < nrows; t += nw) {
    const float* xr = in + (size_t)t * 1024;
    f32x4 v[4]; float ss = 0.f;
#pragma unroll
    for (int i = 0; i < 4; ++i) { v[i] = *(const f32x4*)(xr + 256 * i + 4 * lane); ss += v[i][0] * v[i][0] + v[i][1] * v[i][1] + v[i][2] * v[i][2] + v[i][3] * v[i][3]; }
    ss = wave_sum(ss);
    const float rstd = rsqrtf(ss * (1.0f / 1024.0f) + EPS);
#pragma unroll
    for (int i = 0; i < 4; ++i) {
      const f32x4 g = *(const f32x4*)(gain + 256 * i + 4 * lane);
      u32x2 w = {pk2(v[i][0] * rstd * g[0], v[i][1] * rstd * g[1]), pk2(v[i][2] * rstd * g[2], v[i][3] * rstd * g[3])};
      *(u32x2*)(out + (size_t)t * 1024 + 256 * i + 4 * lane) = w;
      if (raw16) *(u32x2*)(raw16 + (size_t)t * 1024 + 256 * i + 4 * lane) = u32x2{pk2(v[i][0], v[i][1]), pk2(v[i][2], v[i][3])};
    }
  }
}

DI void norm_rows_bf16(const bf16_t* in, const float* gain, bf16_t* out, int nrows) {
  const int gt_ = GTID(), lane = gt_ & 63, gw = gt_ >> 6, nw = gridDim.x * (NTHREADS / 64);
  for (int t = gw; t < nrows; t += nw) {
    const bf16_t* xr = in + (size_t)t * 1024 + 8 * lane;
    float v[16]; float ss = 0.f;
#pragma unroll
    for (int i = 0; i < 2; ++i) { const u32x4 w = *(const u32x4*)(xr + 512 * i);
#pragma unroll
      for (int j = 0; j < 4; ++j) { v[8 * i + 2 * j] = bflo(w[j]); v[8 * i + 2 * j + 1] = bfhi(w[j]); } }
#pragma unroll
    for (int j = 0; j < 16; ++j) ss += v[j] * v[j];
    ss = wave_sum(ss);
    const float rstd = rsqrtf(ss * (1.0f / 1024.0f) + EPS);
#pragma unroll
    for (int i = 0; i < 2; ++i) {
      const f32x4 g0 = *(const f32x4*)(gain + 512 * i + 8 * lane), g1 = *(const f32x4*)(gain + 512 * i + 8 * lane + 4);
      *(u32x4*)(out + (size_t)t * 1024 + 512 * i + 8 * lane) = u32x4{pk2(v[8 * i] * rstd * g0[0], v[8 * i + 1] * rstd * g0[1]), pk2(v[8 * i + 2] * rstd * g0[2], v[8 * i + 3] * rstd * g0[3]),
                                                                    pk2(v[8 * i + 4] * rstd * g1[0], v[8 * i + 5] * rstd * g1[1]), pk2(v[8 * i + 6] * rstd * g1[2], v[8 * i + 7] * rstd * g1[3])};
    }
  }
}

DI void latent_pass(const Params& p, char* smem) {
  const int tid = threadIdx.x, lane = tid & 63, wid = __builtin_amdgcn_readfirstlane(tid >> 6);
  unsigned char* st = (unsigned char*)smem;
  for (int tile = blockIdx.x; tile < T / 64; tile += gridDim.x) {
    u32x2 cq8[8]; unsigned ck8[8]; float r08[8]; unsigned short xa8[8], xb8[8]; f32x2 cs8[8];
    const f32x2 gk = *(const f32x2*)(p.kv_a_norm + 2 * lane);
#pragma unroll
    for (int i = 0; i < 8; ++i) {
      const int t = tile * 64 + wid * 8 + i; const bf16_t* lr = p.lat + (size_t)t * 448;
      cq8[i] = *(const u32x2*)(p.cqn + (size_t)t * 256 + 4 * lane);
      r08[i] = p.rs0[t];
      ck8[i] = *(const unsigned*)(lr + 256 + 2 * lane);
      xa8[i] = lr[384 + (lane & 31)]; xb8[i] = lr[416 + (lane & 31)];
      cs8[i] = *(const f32x2*)(p.rope + (size_t)t * 64 + 2 * (lane & 31));
    }
#pragma unroll
    for (int i = 0; i < 8; ++i) {
      const int tk = wid * 8 + i, t = tile * 64 + tk;
      const u32x2 cq = cq8[i]; const float r0 = r08[i];
      const float q0 = bflo(cq[0]) * r0, q1 = bfhi(cq[0]) * r0, q2 = bflo(cq[1]) * r0, q3 = bfhi(cq[1]) * r0;
      const float ssq = wave_sum(q0 * q0 + q1 * q1 + q2 * q2 + q3 * q3);
      const float rq = rsqrtf(ssq * (1.0f / 256.0f) + EPS);
      if (lane == 0) p.rsq[t] = rq * r0;
      const unsigned ck = ck8[i];
      const float k0 = bflo(ck) * r0, k1 = bfhi(ck) * r0;
      const float ssk = wave_sum(k0 * k0 + k1 * k1);
      const float rk = rsqrtf(ssk * (1.0f / 128.0f) + EPS);
      const float kn0 = k0 * rk * gk[0], kn1 = k1 * rk * gk[1];
      unsigned char* k8r = p.k8 + (size_t)t * 192;
      *(unsigned short*)(k8r + 2 * lane) = (unsigned short)__builtin_amdgcn_cvt_pk_fp8_f32(kn0 * 0.125f, kn1 * 0.125f, 0, false);
      *(unsigned short*)(st + tk * 128 + 2 * lane) = (unsigned short)__builtin_amdgcn_cvt_pk_fp8_f32(kn0, kn1, 0, false);
      if (lane < 32) {
        const float x1 = bf2f(xa8[i]) * r0, x2 = bf2f(xb8[i]) * r0;
        const f32x2 cs = cs8[i];
        const float r1 = x1 * cs[0] - x2 * cs[1], r2 = x2 * cs[0] + x1 * cs[1];
        const int pk = __builtin_amdgcn_cvt_pk_fp8_f32(r1 * 0.125f, r2 * 0.125f, 0, false);
        k8r[128 + lane] = (unsigned char)(pk & 0xff); k8r[160 + lane] = (unsigned char)((pk >> 8) & 0xff);
      }
    }
    __syncthreads();
    {
      const int d = tid >> 2, part = tid & 3, k0 = 32 * (part >> 1) + 4 * (part & 1);
      unsigned w[4];
#pragma unroll
      for (int c = 0; c < 4; ++c) {
        unsigned v = 0;
#pragma unroll
        for (int e = 0; e < 4; ++e) v |= (unsigned)st[(k0 + e + 8 * c) * 128 + d] << (8 * e);
        w[c] = v;
      }
      *(u32x4*)(p.vt8 + (size_t)tile * 8192 + tid * 16) = u32x4{w[0], w[1], w[2], w[3]};
    }
    __syncthreads();
  }
}

DI void rstd_rows(const bf16_t* in, float* rs, int nrows) {
  const int gt_ = GTID(), lane = gt_ & 63, gw = gt_ >> 6, nw = gridDim.x * (NTHREADS / 64);
  for (int t = gw; t < nrows; t += 2 * nw) {
    const int t1 = t + nw; const bool has1 = t1 < nrows; const int tb = has1 ? t1 : t;
    u32x4 wa[2], wb[2];
#pragma unroll
    for (int i = 0; i < 2; ++i) { wa[i] = *(const u32x4*)(in + (size_t)t * 1024 + 8 * lane + 512 * i); wb[i] = *(const u32x4*)(in + (size_t)tb * 1024 + 8 * lane + 512 * i); }
    float sa = 0.f, sb = 0.f;
#pragma unroll
    for (int i = 0; i < 2; ++i)
#pragma unroll
      for (int j = 0; j < 4; ++j) { const float a0 = bflo(wa[i][j]), a1 = bfhi(wa[i][j]), b0 = bflo(wb[i][j]), b1 = bfhi(wb[i][j]); sa += a0 * a0 + a1 * a1; sb += b0 * b0 + b1 * b1; }
    sa = wave_sum(sa); sb = wave_sum(sb);
    if (lane == 0) { rs[t] = rsqrtf(sa * (1.0f / 1024.0f) + EPS); if (has1) rs[t1] = rsqrtf(sb * (1.0f / 1024.0f) + EPS); }
  }
}
DI void mix_pass(const Params& p) {
  const int gt_ = GTID(), lane = gt_ & 63, gw = gt_ >> 6, nw = gridDim.x * (NTHREADS / 64);
  for (int t = gw; t < T; t += nw) {
#pragma unroll
    for (int part = 1; part < 2; ++part) {
      const bf16_t* src = (part ? p.ob : p.oa) + (size_t)t * 512 + 8 * lane;
      const float* g = (part ? p.out_norm_swa : p.out_norm_mla) + 8 * lane;
      const u32x4 w = *(const u32x4*)src;
      float v[8] = {bflo(w[0]), bfhi(w[0]), bflo(w[1]), bfhi(w[1]), bflo(w[2]), bfhi(w[2]), bflo(w[3]), bfhi(w[3])};
      float ss = 0.f;
#pragma unroll
      for (int j = 0; j < 8; ++j) ss += v[j] * v[j];
      ss = wave_sum(ss);
      const float rs = rsqrtf(ss * (1.0f / 512.0f) + EPS);
      const f32x4 g0 = *(const f32x4*)g, g1 = *(const f32x4*)(g + 4);
      u32x4 o = {pk2(v[0] * rs * g0[0], v[1] * rs * g0[1]), pk2(v[2] * rs * g0[2], v[3] * rs * g0[3]), pk2(v[4] * rs * g1[0], v[5] * rs * g1[1]), pk2(v[6] * rs * g1[2], v[7] * rs * g1[3])};
      *(u32x4*)(p.xn + (size_t)t * 1024 + part * 512 + 8 * lane) = o;
    }
  }
}

DI float gelu_exact(float x) { return 0.5f * x * (1.0f + erff(x * 0.70710678118654752f)); }
DI float wave_max(float v) { return wave_max_dpp(v); }
DI void peer_pass(const Params& p, float* outbuf, int rowmask) {
  const int gt_ = GTID(), lane = gt_ & 63, gw = gt_ >> 6, nw = gridDim.x * (NTHREADS / 64);
  const int b5 = (lane >> 5) & 1, b4 = (lane >> 4) & 1, b3 = (lane >> 3) & 1, b2 = (lane >> 2) & 1, kL = (lane >> 2) & 15;
  for (int t = gw; t < T; t += nw) {
    const bf16_t* hr = p.xn + (size_t)t * 1024 + 16 * lane;
    const u32x4 ha = *(const u32x4*)hr, hb = *(const u32x4*)(hr + 8);
    float hv[16];
#pragma unroll
    for (int j = 0; j < 4; ++j) { const unsigned wa = ha[j], wb = hb[j]; hv[2 * j] = bflo(wa); hv[2 * j + 1] = bfhi(wa); hv[8 + 2 * j] = bflo(wb); hv[8 + 2 * j + 1] = bfhi(wb); }
    float hm = 0.f;
#pragma unroll
    for (int j = 0; j < 16; ++j) hm = fmaxf(hm, fabsf(hv[j]));
    hm = fmaxf(wave_max(hm), 1e-20f);
    const float sh = hm * (1.0f / 127.0f), ih = 127.0f / hm;
    int hq[4];
#pragma unroll
    for (int q = 0; q < 4; ++q) {
      const int q0 = (int)rintf(hv[4 * q] * ih), q1 = (int)rintf(hv[4 * q + 1] * ih), q2 = (int)rintf(hv[4 * q + 2] * ih), q3 = (int)rintf(hv[4 * q + 3] * ih);
      hq[q] = (q0 & 255) | ((q1 & 255) << 8) | ((q2 & 255) << 16) | (q3 << 24);
    }
    const int e0 = p.pidx[(size_t)t * 128 + lane], e1 = p.pidx[(size_t)t * 128 + 64 + lane];
    const float su0 = p.su[2 * e0] * sh, su1 = p.su[2 * e1] * sh;
    const float gv0 = p.pg[(size_t)t * 128 + lane] * p.su[2 * e0 + 1], gv1 = p.pg[(size_t)t * 128 + 64 + lane] * p.su[2 * e1 + 1];
    float acc[16];
#pragma unroll
    for (int j = 0; j < 16; ++j) acc[j] = 0.f;
    float csum = 0.f;
#pragma unroll 1
    for (int hd = 0; hd < 8; ++hd) {
      const int esel = (hd < 4) ? e0 : e1;
      const int lbase = (hd & 3) * 16;
      u32x4 ub[16], vb[16];
#pragma unroll
      for (int k = 0; k < 16; ++k) {
        const int idx = __builtin_amdgcn_readlane(esel, lbase + k);
        ub[k] = *(const u32x4*)(p.u_q + (size_t)idx * 1024 + 16 * lane);
        vb[k] = *(const u32x4*)(p.v_q + (size_t)idx * 1024 + 16 * lane);
      }
      int pd[16];
#pragma unroll
      for (int k = 0; k < 16; ++k) {
        int d = 0;
#pragma unroll
        for (int q = 0; q < 4; ++q) { const int a = (int)ub[k][q]; d = __builtin_amdgcn_sdot4(a, hq[q], d, false); }
        pd[k] = d;
      }
      int q8[8], q4[4], q2[2], q1;
#pragma unroll
      for (int k = 0; k < 8; ++k) { const int keep = b5 ? pd[k + 8] : pd[k], send = b5 ? pd[k] : pd[k + 8]; q8[k] = keep + __shfl_xor(send, 32); }
#pragma unroll
      for (int k = 0; k < 4; ++k) { const int keep = b4 ? q8[k + 4] : q8[k], send = b4 ? q8[k] : q8[k + 4]; q4[k] = keep + __shfl_xor(send, 16); }
#pragma unroll
      for (int k = 0; k < 2; ++k) { const int keep = b3 ? q4[k + 2] : q4[k], send = b3 ? q4[k] : q4[k + 2]; q2[k] = keep + __shfl_xor(send, 8); }
      { const int keep = b2 ? q2[1] : q2[0], send = b2 ? q2[0] : q2[1]; q1 = keep + __shfl_xor(send, 4); }
      q1 += __shfl_xor(q1, 2); q1 += __shfl_xor(q1, 1);
      const float suk = __shfl((hd < 4) ? su0 : su1, lbase + kL), gvk = __shfl((hd < 4) ? gv0 : gv1, lbase + kL);
      const float dtot = (float)q1 * suk;
      const float c = DBG_PEER * gvk * gelu_exact(dtot);
#pragma unroll
      for (int k = 0; k < 16; ++k) {
        const float ck = __uint_as_float(__builtin_amdgcn_readlane(__float_as_uint(c), 4 * k));
        csum += ck;
#pragma unroll
        for (int q = 0; q < 4; ++q) {
          const unsigned w = vb[k][q];
          acc[4 * q] += ck * (float)(w & 0xff); acc[4 * q + 1] += ck * (float)((w >> 8) & 0xff); acc[4 * q + 2] += ck * (float)((w >> 16) & 0xff); acc[4 * q + 3] += ck * (float)(w >> 24);
        }
      }
    }
    const float* xr = p.X + (size_t)t * 1024 + 16 * lane; float* orow = outbuf + (size_t)(t & rowmask) * 1024 + 16 * lane;
    float y[16]; float ss = 0.f;
#pragma unroll
    for (int q = 0; q < 4; ++q) {
      const f32x4 xv = *(const f32x4*)(xr + 4 * q);
#pragma unroll
      for (int j = 0; j < 4; ++j) { const float v = xv[j] + (acc[4 * q + j] - 128.0f * csum); y[4 * q + j] = v; ss += v * v; }
    }
    ss = wave_sum(ss);
    const float rstd = rsqrtf(ss * (1.0f / 1024.0f) + EPS);
#pragma unroll
    for (int q = 0; q < 4; ++q) {
      const f32x4 g = *(const f32x4*)(p.norm_final + 16 * lane + 4 * q);
      f32x4 ov;
#pragma unroll
      for (int j = 0; j < 4; ++j) ov[j] = y[4 * q + j] * rstd * g[j];
      *(f32x4*)(orow + 4 * q) = ov;
    }
  }
}

DI void norm_rows_ffn(const Params& p) {
  const int gt_ = GTID(), lane = gt_ & 63, gw = gt_ >> 6, nw = gridDim.x * (NTHREADS / 64);
  auto proc = [&](int t, const u32x2 (&w)[4]) {
    f32x4 v[4]; float ss = 0.f;
#pragma unroll
    for (int i = 0; i < 4; ++i) { v[i] = f32x4{bflo(w[i][0]), bfhi(w[i][0]), bflo(w[i][1]), bfhi(w[i][1])};
      ss += v[i][0] * v[i][0] + v[i][1] * v[i][1] + v[i][2] * v[i][2] + v[i][3] * v[i][3]; }
    ss = wave_sum(ss);
    const float rstd = rsqrtf(ss * (1.0f / 1024.0f) + EPS);
    float hm = 0.f;
#pragma unroll
    for (int i = 0; i < 4; ++i) {
      const f32x4 g = *(const f32x4*)(p.norm_ffn + 256 * i + 4 * lane);
#pragma unroll
      for (int j = 0; j < 4; ++j) { v[i][j] = v[i][j] * rstd * g[j]; hm = fmaxf(hm, fabsf(v[i][j])); }
    }
    hm = fmaxf(wave_max(hm), 1e-20f);
    const float ih = 119.0f / hm;
    const int par = (lane >> 2) & 1;
#pragma unroll
    for (int i = 0; i < 4; ++i) {
      unsigned ph = 0, pl = 0;
#pragma unroll
      for (int j = 0; j < 4; ++j) {
        const int q = (int)rintf(v[i][j] * ih), dl = ((q + 8) & 15) - 8, dh = (q - dl) >> 4;
        ph |= (unsigned)(dh & 15) << (8 * j); pl |= (unsigned)(dl & 15) << (8 * j);
      }
      ph <<= 4 * par; pl <<= 4 * par;
      auto x4 = [](unsigned v) { int r_ = __builtin_amdgcn_update_dpp(0, (int)v, 0x104, 0xF, 0x5, false); r_ = __builtin_amdgcn_update_dpp(r_, (int)v, 0x114, 0xF, 0xA, false); return (unsigned)r_; };
      const unsigned fh = ph | x4(ph), fl = pl | x4(pl);
      *(unsigned*)(p.hq + (size_t)t * 1024 + 256 * i + 32 * (lane >> 3) + 16 * par + 4 * (lane & 3)) = par ? fl : fh;
    }
    if (lane == 0) { p.sh[t] = hm * (1.0f / 119.0f); p.rs3[t] = rstd; }
  };
  for (int t = gw; t < T; t += 4 * nw) {
    u32x2 w[4][4];
#pragma unroll
    for (int u = 0; u < 4; ++u) { const int tu = (t + u * nw < T) ? t + u * nw : t;
#pragma unroll
      for (int i = 0; i < 4; ++i) w[u][i] = *(const u32x2*)(p.X16 + (size_t)tu * 1024 + 256 * i + 4 * lane); }
#pragma unroll
    for (int u = 0; u < 4; ++u) if (t + u * nw < T) proc(t + u * nw, w[u]);
  }
}
DI void peer_dots(const Params& p) {
  const int lane = threadIdx.x & 63, wid = threadIdx.x >> 6, xs = (blockIdx.x & 7) >> 1, r = lane >> 3, ch = lane & 7;
  const int wp = ((blockIdx.x >> 3) * 2 + (blockIdx.x & 1)) * (NTHREADS / 64) + wid, nwp = (gridDim.x >> 2) * (NTHREADS / 64);
  const int b0 = lane & 1, b1 = (lane >> 1) & 1, b2 = (lane >> 2) & 1;
  int* dp = p.dpartA + (size_t)xs * T * 128;
  const unsigned char* ub = p.u_q + (size_t)xs * PEER_SLICE_BYTES;
  const unsigned chb = 16u * ch;
  typedef int i32x2 __attribute__((ext_vector_type(2)));
  i32x4 iv[4]; u32x4 hlo, hhi;
  if (wp < T) {
    unpack_idx16(p.pidx + (size_t)wp * 128 + 16 * r, iv);
    const unsigned char* hp = p.hq + (size_t)wp * 1024 + 256 * xs + 32 * ch;
    hlo = *(const u32x4*)hp; hhi = *(const u32x4*)(hp + 16);
  }
  for (int t = wp; t < T; t += nwp) {
    u32x4 uv[16];
#pragma unroll
    for (int g = 0; g < 16; ++g) uv[g] = *(const u32x4*)(ub + ((unsigned)iv[g >> 2][g & 3] * 128u + chb));
    int hl[4], hh[4];
#pragma unroll
    for (int q = 0; q < 4; ++q) { hh[q] = (int)hlo[q]; hl[q] = (int)hhi[q]; }
    const int tn = (t + nwp < T) ? t + nwp : t;
    {
      unpack_idx16(p.pidx + (size_t)tn * 128 + 16 * r, iv);
      const unsigned char* hp = p.hq + (size_t)tn * 1024 + 256 * xs + 32 * ch;
      hlo = *(const u32x4*)hp; hhi = *(const u32x4*)(hp + 16);
    }
    int v[16];
#pragma unroll
    for (int g = 0; g < 16; ++g) {
      int dh = 0, dl = 0;
#pragma unroll
      for (int q = 0; q < 4; ++q) { const int w = (int)uv[g][q]; dh = __builtin_amdgcn_sdot8(w, hh[q], dh, false); dl = __builtin_amdgcn_sdot8(w, hl[q], dl, false); }
      v[g] = 16 * dh + dl;
    }
    int w8[8], w4[4], w2[2];
#pragma unroll
    for (int k = 0; k < 8; ++k) { const int keep = b2 ? v[k + 8] : v[k], send = b2 ? v[k] : v[k + 8]; w8[k] = keep + WAVE_DPP_I(send, 0x141); }
#pragma unroll
    for (int k = 0; k < 4; ++k) { const int keep = b1 ? w8[k + 4] : w8[k], send = b1 ? w8[k] : w8[k + 4]; w4[k] = keep + WAVE_DPP_I(send, 0x4E); }
#pragma unroll
    for (int k = 0; k < 2; ++k) { const int keep = b0 ? w4[k + 2] : w4[k], send = b0 ? w4[k] : w4[k + 2]; w2[k] = keep + WAVE_DPP_I(send, 0xB1); }
    *(i32x2*)(dp + (size_t)t * 128 + 16 * r + 2 * ch) = i32x2{w2[0], w2[1]};
  }
}
DI void peer_coef(const Params& p) {
  const size_t n = (size_t)T * 128, stride = (size_t)gridDim.x * NTHREADS;
  for (size_t it0 = (size_t)GTID(); it0 < n; it0 += 8 * stride) {
    int d[8], e[8]; float pgv[8], shv[8]; bool ok[8];
#pragma unroll
    for (int u = 0; u < 8; ++u) {
      const size_t it = it0 + u * stride; ok[u] = it < n; const size_t ic = ok[u] ? it : it0;
      d[u] = p.dpartA[ic] + p.dpartA[n + ic] + p.dpartA[2 * n + ic] + p.dpartA[3 * n + ic];
      e[u] = p.pidx[ic]; pgv[u] = p.pg[ic]; shv[u] = p.sh[ic >> 7];
    }
    f32x2 sc2[8];
#pragma unroll
    for (int u = 0; u < 8; ++u) sc2[u] = *(const f32x2*)(p.su + 2 * (size_t)e[u]);
#pragma unroll
    for (int u = 0; u < 8; ++u) {
      const float dt = (float)d[u] * sc2[u][0] * shv[u];
      if (ok[u]) p.cbuf[it0 + u * stride] = DBG_PEER * pgv[u] * gelu_exact(dt) * sc2[u][1];
    }
  }
}
typedef int i32x8v __attribute__((ext_vector_type(8)));
DI void peer_accum(const Params& p, bf16_t* Xout, int rowmask, char* smem) {
  const int lane = threadIdx.x & 63, wid = __builtin_amdgcn_readfirstlane(threadIdx.x >> 6), xs = (blockIdx.x & 7) >> 1, r = lane >> 3, ch = lane & 7;
  const int wp = ((blockIdx.x >> 3) * 2 + (blockIdx.x & 1)) * (NTHREADS / 64) + wid, nwp = (gridDim.x >> 2) * (NTHREADS / 64);
  const unsigned char* vbp = p.v_q + (size_t)xs * PEER_SLICE_BYTES;
  const size_t xoff = (size_t)256 * xs + 32 * ch + 4 * r;
  if (wp >= T) return;
  constexpr int BSTR = 128, A_OFF = 128 * BSTR, O_OFF = A_OFF + 256, WLDS = O_OFF + 1024;
  char* wl = smem + wid * WLDS;
  const int wlo = (int)(uintptr_t)wl;
#define LDS_AT(T_, off) (*(__attribute__((address_space(3))) T_*)(uintptr_t)(unsigned)(off))
  const int i32 = lane & 31, kh = lane >> 5, i16 = lane & 15, nh = (lane >> 4) & 1;
  const int trb = (int)(uintptr_t)wl + (16 * kh + i16) * BSTR + 8 * nh;
  const int fsw = 16 * (i16 >> 1);
  const int tb0 = trb + (0 ^ fsw), tb1 = trb + (16 ^ fsw), tb2 = trb + (32 ^ fsw), tb3 = trb + (48 ^ fsw), tb4 = trb + (64 ^ fsw), tb5 = trb + (80 ^ fsw), tb6 = trb + (96 ^ fsw), tb7 = trb + (112 ^ fsw);
  const int aoff = (int)(uintptr_t)wl + A_OFF + ((i32 == 1) ? 128 : 0) + 32 * kh;
  const unsigned chbE = 16u * (unsigned)(ch ^ (r >> 1)), chbO = chbE ^ 64u;
  u32x4 iaX, ibX, iaY, ibY;
  f32x2 cX, cY; u32x2 xX, xY;
#define GLD16(dst, ptr, OFFS) asm volatile("global_load_dwordx4 %0, %1, off offset:" OFFS : "=v"(dst) : "v"(ptr) : "memory")
#define GLD8(dst, ptr) asm volatile("global_load_dwordx2 %0, %1, off" : "=v"(dst) : "v"(ptr) : "memory")
#define LOAD_IV(tt, IA, IB) do { const unsigned short* ip_ = p.pidx + (size_t)(tt) * 128 + 16 * r; GLD16(IA, ip_, "0"); GLD16(IB, ip_, "16"); } while (0)
#define LOAD_CV(tt, CV) do { const float* cp_ = p.cbuf + (size_t)(tt) * 128 + 16 * r + 2 * ch; GLD8(CV, cp_); } while (0)
#define LOAD_X(tt, XV) do { const bf16_t* xp_ = p.X16 + (size_t)(tt) * 1024 + xoff; GLD8(XV, xp_); } while (0)
#define DMA_HALF(H, IW) do { _Pragma("unroll") for (int g_ = 0; g_ < 8; ++g_) { const unsigned w_ = IW[g_ >> 1]; const unsigned e_ = (g_ & 1) ? (w_ >> 16) : (w_ & 0xffffu); \
      const unsigned off_ = e_ * 128u + ((g_ & 1) ? chbO : chbE); \
      __builtin_amdgcn_global_load_lds((const unsigned*)(vbp + off_), LDSP(wl + (8 * (H) + g_) * 1024 + lane * 16), 16, 0, 0); } } while (0)
#define MFENCE() do { asm volatile("" ::: "memory"); SBAR(); } while (0)
#define TR4(dst, ADDR, OFF) asm volatile("ds_read_b64_tr_b4 %0, %1 offset:%2" : "=&v"(dst) : "v"(ADDR), "i"(OFF) : "memory")
  auto step = [&](f32x2& cc, u32x2& xc, u32x4& ia, u32x4& ib, f32x2& ccn, u32x2& xn_, u32x4& ian, u32x4& ibn, int t) {
    const int tn = (t + nwp < T) ? t + nwp : t, tn2 = (tn + nwp < T) ? tn + nwp : tn;
    asm volatile("s_waitcnt vmcnt(9)" ::: "memory");
    asm volatile("" : "+v"(cc), "+v"(xc), "+v"(ia), "+v"(ib));
    SBAR();
#define RDA(P, N0) do { TR4(P##N0##a, tb##N0, 0); TR4(P##N0##b, tb##N0, 32 * BSTR); } while (0)
#define RDB(P, N0) do { TR4(P##N0##a, tb##N0, 64 * BSTR); TR4(P##N0##b, tb##N0, 96 * BSTR); } while (0)
#define MM1(AOP, P, N0, D) do { const i32x8v B_ = {(int)P##N0##a[0], (int)P##N0##a[1], (int)P##N0##b[0], (int)P##N0##b[1], 0, 0, 0, 0}; \
      D = __builtin_amdgcn_mfma_scale_f32_32x32x64_f8f6f4(AOP, B_, f32x16{}, 0, 4, 0, 0x7f7f7f7f, 0, 0x7f7f7f7f); } while (0)
#define ST1(D, S, N0) do { float r_ = (D[0] + D[1] + (S)) * sback; asm volatile("" : "+v"(r_));        \
      if (lane < 32) LDS_AT(float, wlo + O_OFF + (32 * (N0) + lane) * 4) = r_; } while (0)
#define WAITL(n) do { asm volatile("s_waitcnt lgkmcnt(" #n ")" ::: "memory"); SBAR(); } while (0)
    u32x2 q0a, q0b, q1a, q1b, q2a, q2b, q3a, q3b, q4a, q4b, q5a, q5b, q6a, q6b, q7a, q7b; f32x16 da, db, dc; float s0, s1, s2, s3, s4, s5, s6, s7;
    RDA(q, 0); RDA(q, 1); RDA(q, 2); RDA(q, 3); RDA(q, 4); RDA(q, 5); RDA(q, 6); RDA(q, 7);
    SBAR();
    float m = wave_max_dpp(fmaxf(fabsf(cc[0]), fabsf(cc[1])));
    m = fmaxf(m, 1e-30f);
    const float inv = 256.0f / m, sback = m * (1.0f / 256.0f);
    {
      const float x0 = cc[0] * inv, x1 = cc[1] * inv;
      const int h = __builtin_amdgcn_cvt_pk_fp8_f32(x0, x1, 0, false);
      const f32x2 h01 = __builtin_amdgcn_cvt_pk_f32_fp8(h, false);
      const int l = __builtin_amdgcn_cvt_pk_fp8_f32(x0 - h01[0], x1 - h01[1], 0, false);
      LDS_AT(unsigned char, wlo + A_OFF + 16 * ch + r) = (unsigned char)(h & 0xff);
      LDS_AT(unsigned char, wlo + A_OFF + 16 * ch + 8 + r) = (unsigned char)((h >> 8) & 0xff);
      LDS_AT(unsigned char, wlo + A_OFF + 128 + 16 * ch + r) = (unsigned char)(l & 0xff);
      LDS_AT(unsigned char, wlo + A_OFF + 128 + 16 * ch + 8 + r) = (unsigned char)((l >> 8) & 0xff);
    }
    WAITL(0);
    u32x4 a0 = LDS_AT(u32x4, aoff), a1 = LDS_AT(u32x4, aoff + 16), a2 = LDS_AT(u32x4, aoff + 64), a3 = LDS_AT(u32x4, aoff + 80);
    DMA_HALF(0, ia);
    MFENCE();
    if (i32 >= 2) { a0 = u32x4{0, 0, 0, 0}; a1 = a0; a2 = a0; a3 = a0; }
    const i32x8v A0 = {(int)a0[0], (int)a0[1], (int)a0[2], (int)a0[3], (int)a1[0], (int)a1[1], (int)a1[2], (int)a1[3]};
    const i32x8v A1 = {(int)a2[0], (int)a2[1], (int)a2[2], (int)a2[3], (int)a3[0], (int)a3[1], (int)a3[2], (int)a3[3]};
#define PIN_(x) asm volatile("" : "+v"(x))
    MM1(A0, q, 0, da); SBAR(); MM1(A0, q, 1, db); SBAR(); MM1(A0, q, 2, dc); SBAR();
    s0 = da[0] + da[1]; PIN_(s0); SBAR(); MM1(A0, q, 3, da); SBAR();
    s1 = db[0] + db[1]; PIN_(s1); SBAR(); MM1(A0, q, 4, db); SBAR();
    s2 = dc[0] + dc[1]; PIN_(s2); SBAR(); MM1(A0, q, 5, dc); SBAR();
    s3 = da[0] + da[1]; PIN_(s3); SBAR(); MM1(A0, q, 6, da); SBAR();
    s4 = db[0] + db[1]; PIN_(s4); SBAR(); MM1(A0, q, 7, db); SBAR();
    s5 = dc[0] + dc[1]; PIN_(s5); s6 = da[0] + da[1]; PIN_(s6); s7 = db[0] + db[1]; PIN_(s7); SBAR();
#undef PIN_
    asm volatile("s_waitcnt vmcnt(8)" ::: "memory");
    SBAR();
    RDB(q, 0); RDB(q, 1); RDB(q, 2); RDB(q, 3); RDB(q, 4); RDB(q, 5); RDB(q, 6); RDB(q, 7);
    WAITL(0);
    LOAD_IV(tn2, ian, ibn); LOAD_CV(tn, ccn); LOAD_X(tn, xn_);
    MFENCE();
    DMA_HALF(1, ib);
    MFENCE();
#define FIN_(S, D) do { S = (D[0] + D[1] + S) * sback; asm volatile("" : "+v"(S)); } while (0)
    MM1(A1, q, 0, da); SBAR(); MM1(A1, q, 1, db); SBAR(); MM1(A1, q, 2, dc); SBAR();
    FIN_(s0, da); SBAR(); MM1(A1, q, 3, da); SBAR();
    FIN_(s1, db); SBAR(); MM1(A1, q, 4, db); SBAR();
    FIN_(s2, dc); SBAR(); MM1(A1, q, 5, dc); SBAR();
    FIN_(s3, da); SBAR(); MM1(A1, q, 6, da); SBAR();
    FIN_(s4, db); SBAR(); MM1(A1, q, 7, db); SBAR();
    FIN_(s5, dc); FIN_(s6, da); FIN_(s7, db); SBAR();
#undef FIN_
    if (lane < 32) {
      const int ob_ = wlo + O_OFF + lane * 4;
      LDS_AT(float, ob_) = s0; LDS_AT(float, ob_ + 128) = s1; LDS_AT(float, ob_ + 256) = s2; LDS_AT(float, ob_ + 384) = s3;
      LDS_AT(float, ob_ + 512) = s4; LDS_AT(float, ob_ + 640) = s5; LDS_AT(float, ob_ + 768) = s6; LDS_AT(float, ob_ + 896) = s7;
    }
#undef RDA
#undef RDB
#undef MM1
#undef ST1
#undef WAITL
    const f32x4 w4 = LDS_AT(f32x4, wlo + O_OFF + (32 * ch + 4 * r) * 4);
    *(u32x2*)(Xout + (size_t)(t & rowmask) * 1024 + xoff) = u32x2{pk2(bflo(xc[0]) + w4[0], bfhi(xc[0]) + w4[1]), pk2(bflo(xc[1]) + w4[2], bfhi(xc[1]) + w4[3])};
    MFENCE();
    asm volatile("s_waitcnt lgkmcnt(0)" ::: "memory");
  };
  {
    const int t1 = (wp + nwp < T) ? wp + nwp : wp;
    LOAD_IV(wp, iaY, ibY); LOAD_IV(t1, iaX, ibX); LOAD_CV(wp, cX); LOAD_X(wp, xX);
    asm volatile("s_waitcnt vmcnt(0)" ::: "memory");
    asm volatile("" : "+v"(iaY), "+v"(ibY), "+v"(iaX), "+v"(ibX), "+v"(cX), "+v"(xX));
    MFENCE();
    DMA_HALF(0, iaY);
    DMA_HALF(1, ibY);
    MFENCE();
    asm volatile("s_waitcnt vmcnt(8)" ::: "memory");
  }
  for (int t = wp; t < T; t += 2 * nwp) {
    step(cX, xX, iaX, ibX, cY, xY, iaY, ibY, t);
    if (t + nwp < T) step(cY, xY, iaY, ibY, cX, xX, iaX, ibX, t + nwp);
  }
  asm volatile("s_waitcnt vmcnt(0)" ::: "memory");
#undef GLD16
#undef GLD8
#undef LOAD_IV
#undef LOAD_CV
#undef LOAD_X
#undef DMA_HALF
#undef MFENCE
#undef TR4
#undef LDS_AT
}
DI void final_norm(const Params& p) {
  const int gt_ = GTID(), lane = gt_ & 63, gw = gt_ >> 6, nw = gridDim.x * (NTHREADS / 64);
  auto proc = [&](int t, const u32x2 (&w)[4]) {
    f32x4 v[4]; float ss = 0.f;
#pragma unroll
    for (int i = 0; i < 4; ++i) { v[i] = f32x4{bflo(w[i][0]), bfhi(w[i][0]), bflo(w[i][1]), bfhi(w[i][1])};
      ss += v[i][0] * v[i][0] + v[i][1] * v[i][1] + v[i][2] * v[i][2] + v[i][3] * v[i][3]; }
    ss = wave_sum(ss);
    const float rstd = rsqrtf(ss * (1.0f / 1024.0f) + EPS);
    float* orow = p.X + (size_t)t * 1024;
#pragma unroll
    for (int i = 0; i < 4; ++i) {
      const f32x4 g = *(const f32x4*)(p.norm_final + 256 * i + 4 * lane);
      *(f32x4*)(orow + 256 * i + 4 * lane) = f32x4{v[i][0] * rstd * g[0], v[i][1] * rstd * g[1], v[i][2] * rstd * g[2], v[i][3] * rstd * g[3]};
    }
  };
  for (int t = gw; t < T; t += 4 * nw) {
    u32x2 w[4][4];
#pragma unroll
    for (int u = 0; u < 4; ++u) { const int tu = (t + u * nw < T) ? t + u * nw : t;
#pragma unroll
      for (int i = 0; i < 4; ++i) w[u][i] = *(const u32x2*)(p.X16 + (size_t)tu * 1024 + 256 * i + 4 * lane); }
#pragma unroll
    for (int u = 0; u < 4; ++u) if (t + u * nw < T) proc(t + u * nw, w[u]);
  }
}

DI void quant_fp8(const float* src, unsigned char* dst, size_t n4) {
  for (size_t i = (size_t)GTID(); i < n4; i += (size_t)gridDim.x * NTHREADS) {
    const f32x4 v = *(const f32x4*)(src + i * 4);
    int pk = 0;
    pk = __builtin_amdgcn_cvt_pk_fp8_f32(v[0] * V_FP8_SCALE, v[1] * V_FP8_SCALE, pk, false);
    pk = __builtin_amdgcn_cvt_pk_fp8_f32(v[2] * V_FP8_SCALE, v[3] * V_FP8_SCALE, pk, true);
    *(unsigned*)(dst + i * 4) = (unsigned)pk;
  }
}
DI void quant_u4(const float* src, unsigned char* dst, float* scale, int nrows) {
  const int gt_ = GTID(), lane = gt_ & 63, gw = gt_ >> 6, nw = gridDim.x * (NTHREADS / 64);
  const int c = lane >> 1, hf = lane & 1;
  for (int r = gw; r < nrows; r += nw) {
    const float* xr = src + (size_t)r * 1024 + 32 * c + 8 * hf;
    const f32x4 a0 = *(const f32x4*)xr, a1 = *(const f32x4*)(xr + 4), b0 = *(const f32x4*)(xr + 16), b1 = *(const f32x4*)(xr + 20);
    float ss = 0.f;
#pragma unroll
    for (int j = 0; j < 4; ++j) ss += a0[j] * a0[j] + a1[j] * a1[j] + b0[j] * b0[j] + b1[j] * b1[j];
    ss = wave_sum(ss);
    const float sc = fmaxf(2.45f * sqrtf(ss * (1.0f / 1024.0f)) * (1.0f / 7.0f), 1e-30f), inv = 1.0f / sc;
    unsigned w[2];
#pragma unroll
    for (int q = 0; q < 2; ++q) {
      const f32x4 lo = q ? a1 : a0, hi = q ? b1 : b0;
      unsigned ww = 0;
#pragma unroll
      for (int j = 0; j < 4; ++j) {
        const int ql = (int)fminf(fmaxf(rintf(lo[j] * inv), -7.f), 7.f) & 15, qh = (int)fminf(fmaxf(rintf(hi[j] * inv), -7.f), 7.f) & 15;
        ww |= (unsigned)(ql | (qh << 4)) << (8 * j);
      }
      w[q] = ww;
    }
    *(u32x2*)(dst + (size_t)(c >> 3) * PEER_SLICE_BYTES + (size_t)r * 128 + 16 * (c & 7) + 8 * hf) = u32x2{w[0], w[1]};
    if (lane == 0) scale[2 * r] = sc;
  }
}
DI void quant_v4(const float* src, unsigned char* dst, float* scale, int nrows) {
  const int gt_ = GTID(), lane = gt_ & 63, gw = gt_ >> 6, nw = gridDim.x * (NTHREADS / 64);
  for (int r = gw; r < nrows; r += nw) {
    const float* xr = src + (size_t)r * 1024 + 16 * lane;
    f32x4 a[4]; float ss = 0.f;
#pragma unroll
    for (int q = 0; q < 4; ++q) { a[q] = *(const f32x4*)(xr + 4 * q); ss += a[q][0] * a[q][0] + a[q][1] * a[q][1] + a[q][2] * a[q][2] + a[q][3] * a[q][3]; }
    ss = wave_sum(ss);
    const float sc = fmaxf(sqrtf(ss * (1.0f / 1024.0f)) * (1.0f / 2.1f), 1e-30f), inv = 1.0f / sc;
    unsigned w0 = 0, w1 = 0;
    w0 = __builtin_amdgcn_cvt_scalef32_pk_fp4_f32(w0, a[0][0] * inv, a[0][1] * inv, 1.0f, 0);
    w0 = __builtin_amdgcn_cvt_scalef32_pk_fp4_f32(w0, a[0][2] * inv, a[0][3] * inv, 1.0f, 1);
    w0 = __builtin_amdgcn_cvt_scalef32_pk_fp4_f32(w0, a[1][0] * inv, a[1][1] * inv, 1.0f, 2);
    w0 = __builtin_amdgcn_cvt_scalef32_pk_fp4_f32(w0, a[1][2] * inv, a[1][3] * inv, 1.0f, 3);
    w1 = __builtin_amdgcn_cvt_scalef32_pk_fp4_f32(w1, a[2][0] * inv, a[2][1] * inv, 1.0f, 0);
    w1 = __builtin_amdgcn_cvt_scalef32_pk_fp4_f32(w1, a[2][2] * inv, a[2][3] * inv, 1.0f, 1);
    w1 = __builtin_amdgcn_cvt_scalef32_pk_fp4_f32(w1, a[3][0] * inv, a[3][1] * inv, 1.0f, 2);
    w1 = __builtin_amdgcn_cvt_scalef32_pk_fp4_f32(w1, a[3][2] * inv, a[3][3] * inv, 1.0f, 3);
    *(u32x2*)(dst + (size_t)(lane >> 4) * PEER_SLICE_BYTES + (size_t)r * 128 + 8 * (lane & 15)) = u32x2{w0, w1};
    if (lane == 0) scale[2 * r] = sc;
  }
}
template <bool OFFS>
DI void quant_rows(const float* src, unsigned char* dst, float* scale, int nrows) {
  const int gt_ = GTID(), lane = gt_ & 63, gw = gt_ >> 6, nw = gridDim.x * (NTHREADS / 64);
  for (int r = gw; r < nrows; r += nw) {
    const float* xr = src + (size_t)r * 1024 + 4 * lane;
    f32x4 v[4]; float m = 0.f;
#pragma unroll
    for (int q = 0; q < 4; ++q) { v[q] = *(const f32x4*)(xr + 256 * q); m = fmaxf(m, fmaxf(fmaxf(fabsf(v[q][0]), fabsf(v[q][1])), fmaxf(fabsf(v[q][2]), fabsf(v[q][3])))); }
    m = fmaxf(wave_max(m), 1e-30f);
    const float inv = 127.0f / m;
#pragma unroll
    for (int q = 0; q < 4; ++q) {
      int a0 = (int)rintf(v[q][0] * inv), a1 = (int)rintf(v[q][1] * inv), a2 = (int)rintf(v[q][2] * inv), a3 = (int)rintf(v[q][3] * inv);
      if (OFFS) { a0 += 128; a1 += 128; a2 += 128; a3 += 128; }
      *(unsigned*)(dst + (size_t)r * 1024 + 4 * lane + 256 * q) = (unsigned)(a0 & 255) | ((unsigned)(a1 & 255) << 8) | ((unsigned)(a2 & 255) << 16) | ((unsigned)a3 << 24);
    }
    if (lane == 0) scale[r] = m * (1.0f / 127.0f);
  }
}

DI void transpose_cvt(const float* W, int ldw, int K, int N, bf16_t* Wt, int ldt, char* smem, int& job, int jobstride, const float* gk = nullptr) {
  float* tile = (float*)smem;
  const int tk = K / 64, tn = N / 64, total = tk * tn;
  const int tid = threadIdx.x;
  for (; job < total; job += jobstride) {
    const int k0 = (job / tn) * 64, n0 = (job % tn) * 64;
    __syncthreads();
#pragma unroll
    for (int i = 0; i < 8; ++i) { const int e = tid + i * NTHREADS, kk = e >> 6, nn = e & 63; tile[kk * 65 + nn] = W[(size_t)(k0 + kk) * ldw + n0 + nn] * (gk ? gk[k0 + kk] : 1.0f); }
    __syncthreads();
#pragma unroll
    for (int i = 0; i < 8; ++i) { const int e = tid + i * NTHREADS, nn = e >> 6, kk = e & 63; Wt[(size_t)(n0 + nn) * ldt + k0 + kk] = f2bf(tile[kk * 65 + nn]); }
  }
  job -= total;
}
DI void cvt_elems(const float* src, bf16_t* dst, size_t n8) {
  for (size_t i = (size_t)GTID(); i < n8; i += (size_t)gridDim.x * NTHREADS) {
    const f32x4 a = *(const f32x4*)(src + i * 8), b = *(const f32x4*)(src + i * 8 + 4);
    *(u32x4*)(dst + i * 8) = u32x4{pk2(a[0], a[1]), pk2(a[2], a[3]), pk2(b[0], b[1]), pk2(b[2], b[3])};
  }
}
DI void prep_phase(const Params& p, char* smem) {
  int job = blockIdx.x; const int js = gridDim.x;
  transpose_cvt(p.w_in, IN_COLS, 1024, IN_COLS, p.wt_in, 1024, smem, job, js, p.norm_mix);
  transpose_cvt(p.w_out, 1024, 1024, 1024, p.wt_out, 1024, smem, job, js);
  transpose_cvt(p.w_cq, 512, 1024, 512, p.wt_cq, 1024, smem, job, js, p.norm_cross);
  transpose_cvt(p.w_ck, 512, 1024, 512, p.wt_ckv, 1024, smem, job, js);
  transpose_cvt(p.w_cv, 512, 1024, 512, p.wt_ckv + (size_t)512 * 1024, 1024, smem, job, js);
  transpose_cvt(p.w_co, 1024, 512, 1024, p.wt_co, 512, smem, job, js);
  for (int h = 0; h < 4; ++h) transpose_cvt(p.w_kv_b + h * 256 + 128, 1024, 128, 128, p.wt_uv + (size_t)h * 128 * 128, 128, smem, job, js);
  __syncthreads();
  const size_t gtid = (size_t)GTID(), gn = (size_t)gridDim.x * NTHREADS;
  for (size_t i = gtid; i < (size_t)64 * 1024 / 8; i += gn) *(u32x4*)(p.wt_in + (size_t)IN_COLS * 1024 + i * 8) = u32x4{0, 0, 0, 0};
  for (size_t i = gtid; i < (size_t)768 * 256; i += gn) {
    const int n = (int)(i >> 8), k = (int)(i & 255), h = n / 192, j = n - h * 192;
    float v;
    if (j < 128) {
      const float* a = p.w_q_b + (size_t)k * 768 + h * 192; const float* b = p.w_kv_b + (size_t)j * 1024 + h * 256;
      float s = 0.f;
      for (int d = 0; d < 128; d += 4) { const f32x4 av = *(const f32x4*)(a + d), bv = *(const f32x4*)(b + d); s += av[0] * bv[0] + av[1] * bv[1] + av[2] * bv[2] + av[3] * bv[3]; }
      v = s;
    } else v = p.w_q_b[(size_t)k * 768 + n];
    p.wt_qc[i] = f2bf(v * p.q_a_norm[k]);
  }
  for (size_t i = (size_t)GTID(); i < (size_t)1024 * 2048 / 8; i += (size_t)gridDim.x * NTHREADS) {
    const float g = p.norm_ffn[i >> 8];
    const f32x4 a = *(const f32x4*)(p.peer_w_q + i * 8), b = *(const f32x4*)(p.peer_w_q + i * 8 + 4);
    *(u32x4*)(p.a_pq + i * 8) = u32x4{pk2(a[0] * g, a[1] * g), pk2(a[2] * g, a[3] * g), pk2(b[0] * g, b[1] * g), pk2(b[2] * g, b[3] * g)};
  }
  cvt_elems(p.peer_keys, p.keys_bf, (size_t)2048 * 128 / 8);
  quant_u4(p.peer_u, p.u_q, p.su, 16384);
  quant_v4(p.peer_v, p.v_q, p.su + 1, 16384);
  for (size_t i = gtid; i < (size_t)T * 32; i += gn) {
    const int t = (int)(i >> 5), ii = (int)(i & 31);
    const float inv = exp2f(-(float)ii * (13.287712379549449f / 32.0f));
    const float ang = (float)p.positions[t] * inv;
    float sn, cs; sincosf(ang, &sn, &cs);
    *(f32x2*)(p.rope + i * 2) = f32x2{cs, sn};
  }
  norm_rows_1024(p.mem, p.norm_mem, p.mn, NB * 256);
  {
    const int gt_ = GTID(), lane = gt_ & 63, gw = gt_ >> 6, nw = gridDim.x * (NTHREADS / 64);
    for (int t = gw; t < T; t += nw) {
      const float* xr = p.x + (size_t)t * 1024;
      f32x4 v[4]; float ss = 0.f;
#pragma unroll
      for (int i = 0; i < 4; ++i) { v[i] = *(const f32x4*)(xr + 256 * i + 4 * lane); ss += v[i][0] * v[i][0] + v[i][1] * v[i][1] + v[i][2] * v[i][2] + v[i][3] * v[i][3]; }
#pragma unroll
      for (int i = 0; i < 4; ++i) *(u32x2*)(p.x16 + (size_t)t * 1024 + 256 * i + 4 * lane) = u32x2{pk2(v[i][0], v[i][1]), pk2(v[i][2], v[i][3])};
      ss = wave_sum(ss);
      if (lane == 0) p.rs0[t] = rsqrtf(ss * (1.0f / 1024.0f) + EPS);
    }
  }
}

struct KArgs { const void* in[25]; float* out; char* ws; };
__host__ __device__ __forceinline__ size_t align_up(size_t v) { return (v + 255) & ~(size_t)255; }
__host__ __device__ __forceinline__ Params build_params(const KArgs& k, size_t* total) {
  Params p{};
  p.x = (const float*)k.in[0]; p.mem = (const float*)k.in[1]; p.positions = (const int*)k.in[2]; p.norm_mix = (const float*)k.in[3]; p.w_in = (const float*)k.in[4];
  p.q_a_norm = (const float*)k.in[5]; p.w_q_b = (const float*)k.in[6]; p.kv_a_norm = (const float*)k.in[7]; p.w_kv_b = (const float*)k.in[8]; p.swa_sinks = (const float*)k.in[9];
  p.out_norm_mla = (const float*)k.in[10]; p.out_norm_swa = (const float*)k.in[11]; p.w_out = (const float*)k.in[12]; p.norm_cross = (const float*)k.in[13]; p.norm_mem = (const float*)k.in[14];
  p.w_cq = (const float*)k.in[15]; p.w_ck = (const float*)k.in[16]; p.w_cv = (const float*)k.in[17]; p.w_co = (const float*)k.in[18]; p.norm_ffn = (const float*)k.in[19];
  p.peer_w_q = (const float*)k.in[20]; p.peer_keys = (const float*)k.in[21]; p.peer_u = (const float*)k.in[22]; p.peer_v = (const float*)k.in[23]; p.norm_final = (const float*)k.in[24];
  p.X = k.out;
  char* ws = k.ws; size_t off = 0;
#define TAKE(bytes) (ws + ((off += align_up(bytes)) - align_up(bytes)))
  p.wt_in = (bf16_t*)TAKE((size_t)IN_COLS_PAD * 1024 * 2);
  p.wt_qc = (bf16_t*)TAKE((size_t)768 * 256 * 2);
  p.wt_uv = (bf16_t*)TAKE((size_t)512 * 128 * 2);
  p.wt_out = (bf16_t*)TAKE((size_t)1024 * 1024 * 2);
  p.wt_cq = (bf16_t*)TAKE((size_t)512 * 1024 * 2);
  p.wt_ckv = (bf16_t*)TAKE((size_t)1024 * 1024 * 2);
  p.wt_co = (bf16_t*)TAKE((size_t)1024 * 512 * 2);
  p.a_pq = (bf16_t*)TAKE((size_t)1024 * 2048 * 2);
  p.keys_bf = (bf16_t*)TAKE((size_t)2048 * 128 * 2);
  p.wt_sc = (bf16_t*)TAKE((size_t)2048 * 1024 * 2);
  p.bar = (unsigned*)TAKE((size_t)XCD_BAR_WORDS * 4);
  p.u_q = (unsigned char*)TAKE((size_t)16384 * 512);
  p.v_q = (unsigned char*)TAKE((size_t)16384 * 512);
  p.k8 = (unsigned char*)TAKE((size_t)T * 192);
  p.vt8 = (unsigned char*)TAKE((size_t)T * 128);
  p.su = (float*)TAKE((size_t)16384 * 8);
  p.sv = p.su + 1;
  p.mn = (bf16_t*)TAKE((size_t)512 * 1024 * 2);
  p.kvc = (bf16_t*)TAKE((size_t)512 * 1024 * 2);
  p.rope = (float*)TAKE((size_t)T * 64 * 4);
  p.rsq = (float*)TAKE((size_t)T * 4);
  p.ssx = (float*)TAKE((size_t)T * 16 * 4);
  p.xn = (bf16_t*)TAKE((size_t)T * 1024 * 2);
  p.x16 = (bf16_t*)TAKE((size_t)T * 1024 * 2);
  p.rs0 = (float*)TAKE((size_t)T * 4);
  const size_t offR = off;
  p.lat = (bf16_t*)TAKE((size_t)T * 448 * 2);
  p.cqn = (bf16_t*)TAKE((size_t)T * 256 * 2);
  p.qcat = (bf16_t*)TAKE((size_t)T * 768 * 2);
  p.kcat = (bf16_t*)TAKE((size_t)T * 192 * 2);
  p.qs = (bf16_t*)TAKE((size_t)T * 512 * 2);
  p.ks = (bf16_t*)TAKE((size_t)T * 128 * 2);
  p.vs = (bf16_t*)TAKE((size_t)T * 128 * 2);
  p.olat = (bf16_t*)TAKE((size_t)T * 512 * 2);
  p.ob = (bf16_t*)TAKE((size_t)T * 512 * 2);
  p.oa = (bf16_t*)TAKE((size_t)T * 512 * 2);
  const size_t offEnd = off;
  off = offR;
  p.qx = (bf16_t*)TAKE((size_t)T * 512 * 2);
  p.ox = (bf16_t*)TAKE((size_t)T * 512 * 2);
  p.top1 = (int*)TAKE((size_t)T * 256 * 4);
  p.pidx = (unsigned short*)TAKE((size_t)T * 128 * 2);
  p.pg = (float*)TAKE((size_t)T * 128 * 4);
  p.dpartA = (int*)(ws + offR);
  p.dpartB = (int*)TAKE((size_t)4 * T * 128 * 4);
  p.X16 = (bf16_t*)p.dpartB;
  p.hq = (unsigned char*)TAKE((size_t)T * 1024);
  p.sh = (float*)TAKE((size_t)T * 4);
  p.rs3 = (float*)TAKE((size_t)T * 4);
  p.rsx = (float*)TAKE((size_t)T * 4);
  p.cbuf = (float*)TAKE((size_t)T * 128 * 4);
#undef TAKE
  if (total) *total = (off > offEnd) ? off : offEnd;
  return p;
}

constexpr int N_PHASES = 19;
template <int PH> DI void run_phase(const Params& p, char* smem) {
  if constexpr (PH == 0) prep_phase(p, smem);
  else if constexpr (PH == 1) {
    g8::run(p.x16, p.wt_in, T, IN_COLS_PAD, DM, g8::EpiInproj{p.lat, p.qs, p.ks, p.vs, p.cqn}, smem);
    { const int G = (int)gridDim.x, n3 = 640 - 2 * G;
      if (n3 > 0 && G - n3 >= 72) {
        if ((int)blockIdx.x >= n3) {
          const int c = (int)blockIdx.x - n3;
          if (c < 8) g8::run_on(p.mn, p.wt_ckv, NB * 256, 1024, DM, g8::EpiBf16{p.kvc, 1024, 1.0f}, smem, c, 8);
          else if (c < 72) gemm_phase(p.a_pq, 2048, 128, p.keys_bf, 128, 1024, 2048, 128, EpiBf16T{p.wt_sc, 1024}, smem, c - 8, 64);
        }
      } else {
        g8::run(p.mn, p.wt_ckv, NB * 256, 1024, DM, g8::EpiBf16{p.kvc, 1024, 1.0f}, smem);
        gemm_phase(p.a_pq, 2048, 128, p.keys_bf, 128, 1024, 2048, 128, EpiBf16T{p.wt_sc, 1024}, smem);
      } }
  }
  else if constexpr (PH == 2) { g8::run(p.cqn, p.wt_qc, T, 768, 256, g8::EpiBf16{p.qcat, 768, MLA_QSCALE}, smem); __syncthreads(); latent_pass(p, smem); }
  else if constexpr (PH == 3) { }
  else if constexpr (PH == 4) { mla_phase(p, smem); swa_phase(p, smem); }
  else if constexpr (PH == 5) { }
  else if constexpr (PH == 6) mix_pass(p);
  else if constexpr (PH == 7) g8::run(p.xn, p.wt_out, T, DM, DM, g8::EpiResid16<false>{p.x16, p.X16, DM, DBG_MIX, p.ssx}, smem);
  else if constexpr (PH == 8) { }
  else if constexpr (PH == 9) { g8::run(p.X16, p.wt_cq, T, 512, DM, g8::EpiBf16{p.qx, 512, X_QSCALE}, smem); }
  else if constexpr (PH == 10) xattn_phase(p, smem);
  else if constexpr (PH == 11) g8::run(p.ox, p.wt_co, T, DM, 512, g8::EpiResid16<false>{p.X16, p.X16, DM, DBG_XAT}, smem);
  else if constexpr (PH == 12) { }
  else if constexpr (PH == 13) { norm_rows_ffn(p); score_phase(p, smem); }
  else if constexpr (PH == 14) topk2_phase(p);
  else if constexpr (PH == 15) peer_dots(p);
  else if constexpr (PH == 16) peer_coef(p);
  else if constexpr (PH == 17) peer_accum(p, p.X16, -1, smem);
  else if constexpr (PH == 18) final_norm(p);
}

template <int PB, int PE>
__global__ void __launch_bounds__(NTHREADS) mega_kernel(KArgs ka) {
  const Params p = build_params(ka, nullptr);
  if (ka.ws == nullptr) cg::this_grid().sync();
  __shared__ __attribute__((aligned(16))) char smem[SMEM_BYTES];
  XcdBarrier xb;
  if constexpr (PE - PB > 1) {
    volatile LAS unsigned* xbw = (volatile LAS unsigned*)(smem + SMEM_BYTES - 256);
    if (threadIdx.x == 0) { xbw[0] = 0u; xbw[1] = 0u; }
    __syncthreads();
    xb = xcd_barrier_post(p.bar, xbw);
  }
#define RUN(n) if constexpr (PB <= n && n < PE && n != 5 && n != 6 && n != 12 && n != 8 && n != 3) { if constexpr (n == DUP) { if constexpr (n == 17) peer_accum(p, p.oa, 1023, smem); else run_phase<n>(p, smem); xcd_barrier(xb); } run_phase<n>(p, smem); if constexpr (n + 1 < PE) { xcd_barrier(xb); } }
  RUN(0) RUN(1) RUN(2) RUN(3) RUN(4) RUN(5) RUN(6) RUN(7) RUN(8) RUN(9) RUN(10) RUN(11) RUN(12) RUN(13) RUN(14) RUN(15) RUN(16) RUN(17) RUN(18)
#undef RUN
}


extern "C" void kernel_launch(void* const* d_in, const int* in_sizes, int n_in, void* d_out, int out_size, void* d_ws, size_t ws_size, hipStream_t stream) {
  (void)in_sizes; (void)n_in; (void)out_size;
  KArgs ka{};
  for (int i = 0; i < 25; ++i) ka.in[i] = d_in[i];
  ka.out = (float*)d_out; ka.ws = (char*)d_ws;
  size_t need = 0;
  const Params hp = build_params(ka, &need);
  if (need > ws_size) { fprintf(stderr, "kernel_launch: workspace too small (%zu > %zu)\n", need, ws_size); return; }

  static int grid_blocks = 0;
  if (!grid_blocks) {
    int dev = 0, cus = 0;
    (void)hipGetDevice(&dev);
    (void)hipDeviceGetAttribute(&cus, hipDeviceAttributeMultiprocessorCount, dev);
    grid_blocks = cus > 0 ? cus : 256;
  }
#if MK_SINGLE_LAUNCH
  {
    (void)hipMemsetAsync(hp.bar, 0, (size_t)XCD_BAR_WORDS * 4, stream);
    int per_cu = 0;
    (void)hipOccupancyMaxActiveBlocksPerMultiprocessor(&per_cu, mega_kernel<0, N_PHASES>, NTHREADS, 0);
    if (per_cu < 1) fprintf(stderr, "occupancy query returned %d\n", per_cu);
    void* args[] = {&ka};
    hipError_t e = hipLaunchCooperativeKernel((void*)mega_kernel<0, N_PHASES>, dim3(grid_blocks), dim3(NTHREADS), args, 0, stream);
    if (e != hipSuccess) fprintf(stderr, "cooperative launch failed: %s (grid %d)\n", hipGetErrorString(e), grid_blocks);
  }
#else
#define LAUNCH(n) hipLaunchKernelGGL((mega_kernel<n, n + 1>), dim3(grid_blocks), dim3(NTHREADS), 0, stream, ka);
  LAUNCH(0) LAUNCH(1) LAUNCH(2) LAUNCH(3) LAUNCH(4) LAUNCH(5) LAUNCH(6) LAUNCH(7) LAUNCH(8) LAUNCH(9) LAUNCH(10) LAUNCH(11) LAUNCH(12) LAUNCH(13) LAUNCH(14) LAUNCH(15) LAUNCH(16) LAUNCH(17) LAUNCH(18)
#undef LAUNCH
#endif
}
```
